# Optimizing an MI355X kernel written in HIP

```python
import math
import jax
import jax.numpy as jnp
from jax import lax
import numpy as np

D_MODEL = 1024
BATCH = 16
SEQ = 2048
DEPTH = 4
DEC_BATCH = 8
DEC_SEQ = 32
PAST_LEN = 2048

CHUNK = 64
Q_BLOCK = 128
DK_A = 128
DV_A = 128
H_A = D_MODEL // DV_A
CONV_W = 4
CONV_CH = 2 * H_A * DK_A + H_A * DV_A
DH_B = 64
DHV_B = 2 * DH_B
H_B = D_MODEL // DHV_B
N_BUCKETS = 32
MAX_DIST = 128
D_FF = -(-8 * D_MODEL // (3 * 256)) * 256
ALPHA = (2 * DEPTH) ** 0.25
BETA_INIT = (8 * DEPTH) ** -0.25
LN_EPS = 1e-5
IN_SIZES = (CONV_CH, H_A * DV_A, H_A, H_A, H_B * 2 * DH_B, H_B * 2 * DH_B, H_B * DHV_B, 2 * D_MODEL)
D_IN = sum(IN_SIZES)
IN_SPLITS = tuple(np.cumsum(IN_SIZES)[:-1].tolist())

kernel_name = 'hybrid_deltanet_diffattn_stream_step'

F32 = jnp.float32


def layer_norm(x, g, b):
    xf = x.astype(F32)
    mu = jnp.mean(xf, axis=-1, keepdims=True)
    var = jnp.mean(jnp.square(xf - mu), axis=-1, keepdims=True)
    return ((xf - mu) * lax.rsqrt(var + LN_EPS) * g.astype(F32) + b.astype(F32)).astype(x.dtype)


def rms_norm(x, g):
    xf = x.astype(F32)
    out = xf * lax.rsqrt(jnp.mean(jnp.square(xf), axis=-1, keepdims=True) + LN_EPS) * g.astype(F32)
    return out.astype(x.dtype)


def l2norm(x):
    return x * lax.rsqrt(jnp.sum(jnp.square(x), axis=-1, keepdims=True) + 1e-6)


def t5_bucket(rel):
    nb = N_BUCKETS // 2
    max_exact = nb // 2
    ret = jnp.where(rel > 0, nb, 0)
    n = jnp.abs(rel)
    nf = jnp.maximum(n, 1).astype(F32)
    large = max_exact + (jnp.log(nf / max_exact) / math.log(MAX_DIST / max_exact) * (nb - max_exact)).astype(jnp.int32)
    large = jnp.minimum(large, nb - 1)
    return ret + jnp.where(n < max_exact, n, large)


def causal_conv(u, buf, w):
    T = u.shape[1]
    cat = jnp.concatenate([buf.astype(u.dtype), u], axis=1)
    out = cat[:, 0:T] * w[0]
    for i in range(1, CONV_W):
        out = out + cat[:, i:i + T] * w[i]
    return out, cat[:, cat.shape[1] - (CONV_W - 1):]


def gated_delta_rule(q, k, v, beta, g, s0, chunk):
    B, T, H, DK = q.shape
    DV = v.shape[-1]
    N = T // chunk

    def to_blocks(a):
        a = a.reshape((B, N, chunk) + a.shape[2:])
        return jnp.moveaxis(a, (1, 2), (0, 3))

    qc, kc, vc = to_blocks(q), to_blocks(k), to_blocks(v)
    bc, gc = to_blocks(beta), to_blocks(g)
    G = jnp.cumsum(gc, axis=-1)
    idx = jnp.arange(chunk)
    causal = idx[:, None] >= idx[None, :]
    strict = idx[:, None] > idx[None, :]
    decay = jnp.exp(jnp.where(causal, G[..., :, None] - G[..., None, :], -jnp.inf))
    kb = kc * bc[..., None]
    a_mat = jnp.where(strict, jnp.einsum('nbhid,nbhjd->nbhij', kb, kc) * decay, 0.0)
    lhs = jnp.eye(chunk, dtype=F32) + a_mat
    u_v = lax.linalg.triangular_solve(lhs, vc * bc[..., None], left_side=True, lower=True, unit_diagonal=True)
    w_k = lax.linalg.triangular_solve(lhs, kb * jnp.exp(G)[..., None], left_side=True, lower=True, unit_diagonal=True)
    qk = jnp.einsum('nbhid,nbhjd->nbhij', qc, kc) * decay
    q_g = qc * jnp.exp(G)[..., None]
    k_tail = kc * jnp.exp(G[..., -1:] - G)[..., None]
    g_last = jnp.exp(G[..., -1])

    def step(S, xs):
        u_v_n, w_n, qk_n, q_n, kt_n, gl_n = xs
        u = u_v_n - jnp.einsum('bhlk,bhkv->bhlv', w_n, S)
        o = jnp.einsum('bhlk,bhkv->bhlv', q_n, S) + jnp.einsum('bhij,bhjv->bhiv', qk_n, u)
        S = gl_n[..., None, None] * S + jnp.einsum('bhlk,bhlv->bhkv', kt_n, u)
        return S, o

    s_final, o = lax.scan(step, s0, (u_v, w_k, qk, q_g, k_tail, g_last))
    o = jnp.moveaxis(o, (0, 3), (1, 2)).reshape(B, T, H, DV)
    return o, s_final


def diff_attend(q, k, v, qpos, kpos, lam_val, rel_bias):
    bias = jnp.take(rel_bias, t5_bucket(kpos[None, :] - qpos[:, None]), axis=0)
    bias = jnp.transpose(bias, (2, 0, 1)).astype(F32)
    mask = (kpos[None, :] // CHUNK) <= (qpos[:, None] // CHUNK)
    s = jnp.einsum('bqhmd,bkhmd->bhmqk', q, k).astype(F32) * (DH_B ** -0.5) + bias[None, :, None]
    s = jnp.where(mask, s, -1e30)
    p = jax.nn.softmax(s, axis=-1)
    w = (p[:, :, 0] - lam_val * p[:, :, 1]).astype(v.dtype)
    return jnp.einsum('bhqk,bkhe->bqhe', w, v)


def prompt_diff_attention(q, k, v, lam_val, rel_bias):
    B, T = q.shape[0], q.shape[1]
    nb = T // Q_BLOCK
    qb = jnp.swapaxes(q.reshape(B, nb, Q_BLOCK, H_B, 2, DH_B), 0, 1)
    kpos = jnp.arange(T)

    def one_block(args):
        q_blk, i = args
        qpos = i * Q_BLOCK + jnp.arange(Q_BLOCK)
        return diff_attend(q_blk, k, v, qpos, kpos, lam_val, rel_bias)

    o = lax.map(one_block, (qb, jnp.arange(nb)))
    return jnp.swapaxes(o, 0, 1).reshape(B, T, H_B, DHV_B)


def trunk_layer(x, c, l, conv_buf, s0, past_k, past_v, P):
    Bn, T, _ = x.shape
    mod = jnp.einsum('bd,de->be', jax.nn.silu(c), P['w_ada'][l]) + P['b_ada'][l]
    sh1, sc1, gt1, sh2, sc2, gt2 = [m[:, None, :] for m in jnp.split(mod, 6, axis=-1)]
    h = x * (1.0 + sc1) + sh1
    proj = jnp.einsum('btd,de->bte', h, P['w_in'][l])
    qkv_a, z_a, b_a, a_a, q_b, k_b, v_b, gates = jnp.split(proj, IN_SPLITS, axis=-1)
    conv_out, new_buf = causal_conv(qkv_a, conv_buf, P['conv_w'][l])
    conv_out = jax.nn.silu(conv_out.astype(F32))
    q_a, k_a, v_a = jnp.split(conv_out, [H_A * DK_A, 2 * H_A * DK_A], axis=-1)
    q_a = l2norm(q_a.reshape(Bn, T, H_A, DK_A)) * (DK_A ** -0.5)
    k_a = l2norm(k_a.reshape(Bn, T, H_A, DK_A))
    v_a = v_a.reshape(Bn, T, H_A, DV_A)
    beta = jax.nn.sigmoid(b_a.astype(F32))
    g = -jnp.exp(P['a_log'][l].astype(F32)) * jax.nn.softplus(a_a.astype(F32) + P['dt_bias'][l].astype(F32))
    chunk = CHUNK if past_k is None else T
    o_a, s_new = gated_delta_rule(q_a, k_a, v_a, beta, g, s0.astype(F32), chunk)
    o_a = rms_norm(o_a, P['norm_a'][l]) * jax.nn.silu(z_a.astype(F32).reshape(Bn, T, H_A, DV_A))
    o_a = o_a.reshape(Bn, T, H_A * DV_A).astype(x.dtype)
    lam_init = 0.8 - 0.6 * math.exp(-0.3 * l)
    lp = P['lam'][l].astype(F32)
    lam_val = jnp.exp(jnp.sum(lp[0] * lp[1])) - jnp.exp(jnp.sum(lp[2] * lp[3])) + lam_init
    q_b = q_b.reshape(Bn, T, H_B, 2, DH_B)
    k_b = k_b.reshape(Bn, T, H_B, 2, DH_B)
    v_b = v_b.reshape(Bn, T, H_B, DHV_B)
    if past_k is None:
        o_b = prompt_diff_attention(q_b, k_b, v_b, lam_val, P['rel_bias'])
    else:
        past = past_k.shape[1]
        k_all = jnp.concatenate([past_k.reshape(Bn, past, H_B, 2, DH_B).astype(x.dtype), k_b], axis=1)
        v_all = jnp.concatenate([past_v.astype(x.dtype), v_b], axis=1)
        o_b = diff_attend(q_b, k_all, v_all, past + jnp.arange(T), jnp.arange(past + T), lam_val, P['rel_bias'])
    o_b = rms_norm(o_b, P['subln_g'][l]) * (1.0 - lam_init)
    o_b = o_b.reshape(Bn, T, H_B * DHV_B).astype(x.dtype)
    g_a, g_b = jnp.split(gates, 2, axis=-1)
    merged = jax.nn.sigmoid(g_a) * o_a + jax.nn.sigmoid(g_b) * o_b
    y = jnp.einsum('btd,de->bte', merged, P['w_o'][l])
    x = layer_norm(ALPHA * x + gt1 * y, P['ln1_g'][l], P['ln1_b'][l])
    h = x * (1.0 + sc2) + sh2
    u, v = jnp.split(jnp.einsum('btd,df->btf', h, P['w_ff_in'][l]), 2, axis=-1)
    y = jnp.einsum('btf,fd->btd', jax.nn.silu(u) * v, P['w_ff_out'][l])
    x = layer_norm(ALPHA * x + gt2 * y, P['ln2_g'][l], P['ln2_b'][l])
    return x, new_buf, s_new.astype(x.dtype), k_b.reshape(Bn, T, H_B, 2 * DH_B), v_b


def setup_inputs(seed: int = 0) -> dict:
    key = jax.random.key(seed)
    ks = jax.random.split(key, 32)

    def nrm(k, shape, s):
        return s * jax.random.normal(k, shape, F32)

    D = D_MODEL
    b_ada = nrm(ks[12], (DEPTH, 6 * D), 0.02)
    b_ada = b_ada.at[:, 2 * D:3 * D].add(1.0).at[:, 5 * D:6 * D].add(1.0)
    dt = jnp.exp(jax.random.uniform(ks[16], (DEPTH, H_A), F32, math.log(1e-3), math.log(1e-1)))
    return {
        'x_prompt': nrm(ks[0], (BATCH, SEQ, D), 1.0),
        'x_sample': nrm(ks[1], (DEC_BATCH, DEC_SEQ, D), 1.0),
        'cache_k': nrm(ks[2], (DEPTH, DEC_BATCH, PAST_LEN, H_B, 2 * DH_B), 1.0),
        'cache_v': nrm(ks[3], (DEPTH, DEC_BATCH, PAST_LEN, H_B, DHV_B), 1.0),
        'state_conv': nrm(ks[4], (DEPTH, DEC_BATCH, CONV_W - 1, CONV_CH), 1.0),
        'state_delta': nrm(ks[5], (DEPTH, DEC_BATCH, H_A, DK_A, DV_A), 0.05),
        'c_prompt': nrm(ks[6], (BATCH, D), 1.0),
        'c_sample': nrm(ks[7], (DEC_BATCH, D), 1.0),
        'ln_in_g': 1.0 + nrm(ks[8], (D,), 0.02),
        'ln_in_b': nrm(ks[9], (D,), 0.02),
        'rel_bias': nrm(ks[10], (N_BUCKETS, H_B), 0.5),
        'w_ada': nrm(ks[11], (DEPTH, D, 6 * D), 0.5 * D ** -0.5),
        'b_ada': b_ada,
        'w_in': nrm(ks[13], (DEPTH, D, D_IN), D ** -0.5),
        'conv_w': nrm(ks[14], (DEPTH, CONV_W, CONV_CH), CONV_W ** -0.5),
        'a_log': jnp.log(jax.random.uniform(ks[15], (DEPTH, H_A), F32, 1.0, 16.0)),
        'dt_bias': dt + jnp.log(-jnp.expm1(-dt)),
        'norm_a': 1.0 + nrm(ks[17], (DEPTH, DV_A), 0.02),
        'lam': nrm(ks[18], (DEPTH, 4, DH_B), 0.1),
        'subln_g': 1.0 + nrm(ks[19], (DEPTH, DHV_B), 0.02),
        'w_o': nrm(ks[20], (DEPTH, D, D), D ** -0.5 * BETA_INIT),
        'ln1_g': 1.0 + nrm(ks[21], (DEPTH, D), 0.02),
        'ln1_b': nrm(ks[22], (DEPTH, D), 0.02),
        'w_ff_in': nrm(ks[23], (DEPTH, D, 2 * D_FF), D ** -0.5),
        'w_ff_out': nrm(ks[24], (DEPTH, D_FF, D), D_FF ** -0.5 * BETA_INIT),
        'ln2_g': 1.0 + nrm(ks[25], (DEPTH, D), 0.02),
        'ln2_b': nrm(ks[26], (DEPTH, D), 0.02),
    }


def reference(x_prompt, x_sample, cache_k, cache_v, state_conv, state_delta, c_prompt, c_sample,
              ln_in_g, ln_in_b, rel_bias, w_ada, b_ada, w_in, conv_w, a_log, dt_bias, norm_a,
              lam, subln_g, w_o, ln1_g, ln1_b, w_ff_in, w_ff_out, ln2_g, ln2_b):
    P = {'rel_bias': rel_bias, 'w_ada': w_ada, 'b_ada': b_ada, 'w_in': w_in, 'conv_w': conv_w,
         'a_log': a_log, 'dt_bias': dt_bias, 'norm_a': norm_a, 'lam': lam, 'subln_g': subln_g,
         'w_o': w_o, 'ln1_g': ln1_g, 'ln1_b': ln1_b, 'w_ff_in': w_ff_in, 'w_ff_out': w_ff_out,
         'ln2_g': ln2_g, 'ln2_b': ln2_b}
    xp = layer_norm(x_prompt, ln_in_g, ln_in_b)
    xs = layer_norm(x_sample, ln_in_g, ln_in_b)
    bp = xp.shape[0]
    conv0 = jnp.zeros((bp, CONV_W - 1, CONV_CH), xp.dtype)
    s0 = jnp.zeros((bp, H_A, DK_A, DV_A), F32)
    kp_l, vp_l, cp_l, sp_l = [], [], [], []
    ks_l, vs_l, cs_l, ss_l = [], [], [], []
    for l in range(DEPTH):
        xp, cbp, sp, kp, vp = trunk_layer(xp, c_prompt, l, conv0, s0, None, None, P)
        xs, cbs, ss, kk, vv = trunk_layer(xs, c_sample, l, state_conv[l], state_delta[l], cache_k[l], cache_v[l], P)
        kp_l.append(kp); vp_l.append(vp); cp_l.append(cbp); sp_l.append(sp)
        ks_l.append(kk); vs_l.append(vv); cs_l.append(cbs); ss_l.append(ss)
    return (xp, xs,
            jnp.stack(kp_l), jnp.stack(vp_l), jnp.stack(cp_l), jnp.stack(sp_l),
            jnp.stack(ks_l), jnp.stack(vs_l), jnp.stack(cs_l), jnp.stack(ss_l))
```

```cpp
#include <hip/hip_runtime.h>
#include <cstdio>
#include <cstdint>

#define LAS __attribute__((address_space(3)))
#define GAS __attribute__((address_space(1)))
typedef _Float16 f16;
typedef _Float16 f16x2 __attribute__((ext_vector_type(2)));
typedef _Float16 f16x4 __attribute__((ext_vector_type(4)));
typedef _Float16 f16x8 __attribute__((ext_vector_type(8)));
typedef float f32x2 __attribute__((ext_vector_type(2)));
typedef float f32x4 __attribute__((ext_vector_type(4)));
typedef float f32x16 __attribute__((ext_vector_type(16)));
typedef unsigned u32x2 __attribute__((ext_vector_type(2)));
typedef unsigned u32x4 __attribute__((ext_vector_type(4)));
typedef short v4i16_t __attribute__((ext_vector_type(4)));

constexpr int D = 1024, NB = 16, SEQ = 2048, MP = NB * SEQ, NSB = 8, SSEQ = 32, MS = NSB * SSEQ, M = MP + MS, PAST = 2048, DEPTH = 4;
constexpr int NH = 8, DK = 128, CONVC = 3072, DFF = 2816, DIN = 9232, NPROJ = 9472;
constexpr int KSROWS = 2112;
constexpr float LN_EPS = 1e-5f;
constexpr float ALPHA = 1.6817928305074290f;
constexpr float LOG2E = 1.4426950408889634f;
constexpr int NBB = NB + NSB;

constexpr size_t OUT_YP = 0;
constexpr size_t OUT_YS = OUT_YP + (size_t)MP * D;
constexpr size_t OUT_KP = OUT_YS + (size_t)MS * D;
constexpr size_t OUT_VP = OUT_KP + (size_t)DEPTH * MP * D;
constexpr size_t OUT_CP = OUT_VP + (size_t)DEPTH * MP * D;
constexpr size_t OUT_DP = OUT_CP + (size_t)DEPTH * NB * 3 * CONVC;
constexpr size_t OUT_KS = OUT_DP + (size_t)DEPTH * NB * NH * DK * DK;
constexpr size_t OUT_VS = OUT_KS + (size_t)DEPTH * MS * D;
constexpr size_t OUT_CS = OUT_VS + (size_t)DEPTH * MS * D;
constexpr size_t OUT_DS = OUT_CS + (size_t)DEPTH * NSB * 3 * CONVC;
constexpr size_t OUT_END = OUT_DS + (size_t)DEPTH * NSB * NH * DK * DK;

constexpr size_t MiB = 1u << 20;
constexpr size_t WS_CTL = 0, CTL_ZERO_BYTES = 1 * MiB;
constexpr size_t WS_MOD = 1 * MiB;
constexpr size_t WS_MISC = 4 * MiB;
constexpr size_t WS_WIN = 5 * MiB;
constexpr size_t WS_WO2 = WS_WIN + 74 * MiB;
constexpr size_t WS_WFI = WS_WO2 + 16 * MiB;
constexpr size_t WS_WFO = WS_WFI + 44 * MiB;
constexpr size_t WS_X = WS_WFO + 22 * MiB;
constexpr size_t WS_H = WS_X + 129 * MiB;
constexpr size_t WS_QKVA = WS_H + 65 * MiB;
constexpr size_t WS_Z = WS_QKVA + 194 * MiB;
constexpr size_t WS_QB = WS_Z + 65 * MiB;
constexpr size_t WS_KB = WS_QB + 65 * MiB;
constexpr size_t WS_VB = WS_KB + 65 * MiB;
constexpr size_t WS_GAB = WS_VB + 65 * MiB;
constexpr size_t WS_BG = WS_GAB + 129 * MiB;
constexpr size_t WS_MAB = WS_BG + 3 * MiB;
constexpr size_t WS_ACT = WS_MAB + 129 * MiB;
constexpr size_t WS_DIMG = WS_ACT + 178 * MiB;
constexpr size_t WS_KS = WS_DIMG + 293 * MiB;
constexpr size_t WS_VS = WS_KS + 132 * MiB;
constexpr size_t WS_END = WS_VS + 132 * MiB;
static_assert(WS_END <= 2048 * MiB, "d_ws map");
constexpr int DIMG_BYTES = 73728, IMG_WK = 0, IMG_QG = 16384, IMG_QK = 32768, IMG_KT = 40960, IMG_UV = 57344, IMG_STAGE = 57344;
constexpr int N_DUNITS = NB * NH * 32 + NSB * NH;
constexpr int CW_BAR = 4096;
constexpr int CW_Q = 16384;

constexpr int RING_BYTES = 155648;
constexpr int LDSCTL_OFF = RING_BYTES;
constexpr int LDS_BYTES = 159 * 1024;
constexpr int NWAVES = 8;

__device__ __forceinline__ unsigned pk2h(float lo, float hi) { f32x2 v = {lo, hi}; f16x2 h = __builtin_convertvector(v, f16x2); return __builtin_bit_cast(unsigned, h); }
__device__ __forceinline__ u32x4 pk8h(f32x4 a, f32x4 b) { u32x4 w; w.x = pk2h(a[0], a[1]); w.y = pk2h(a[2], a[3]); w.z = pk2h(b[0], b[1]); w.w = pk2h(b[2], b[3]); return w; }
__device__ __forceinline__ float sigmoidf_(float x) { return 1.0f / (1.0f + __expf(-x)); }
__device__ __forceinline__ float siluf_(float x) { return x / (1.0f + __expf(-x)); }
__device__ __forceinline__ int crow(int r, int hi) { return (r & 3) + 8 * (r >> 2) + 4 * hi; }
#define LDS_WAIT() asm volatile("s_waitcnt lgkmcnt(0)" ::: "memory")
#define VM_WAIT() asm volatile("s_waitcnt vmcnt(0)" ::: "memory")

namespace pg8 {
#define PG8_LAS __attribute__((address_space(3)))
typedef unsigned short bf16_t;
typedef _Float16 bf16x8 __attribute__((ext_vector_type(8)));
typedef float f32x4 __attribute__((ext_vector_type(4)));
typedef unsigned u32x4 __attribute__((ext_vector_type(4)));
constexpr int BM = 256, BK = 64, HALF = 128, HTB = HALF * BK * 2  , STAGE_BYTES = 8 * HTB, NXCD = 8, WGM = 8;

__host__ __device__ __forceinline__ int lds_byte(int r, int c) { const int st = (r >> 4) * 2 + (c >> 5), rr = r & 15, cc = c & 31, ob = rr * 64 + cc * 2; return st * 1024 + (ob ^ (((ob >> 9) & 1) << 5)); }
__host__ __device__ __forceinline__ void stage_rc(int b, int& R, int& C) { const int st = b / 1024, sb = b % 1024, swz = sb ^ (((sb >> 9) & 1) << 5); R = (st >> 1) * 16 + swz / 64; C = (st & 1) * 32 + (swz % 64) / 2; }
__host__ __device__ __forceinline__ int perm32(int rho) { const int n = rho >> 4, i = rho & 15; return 8 * (i >> 2) + 4 * n + (i & 3); }

struct Unit { int pm, pn; };
struct Gemm { const bf16_t* A; const bf16_t* Bt; int M, N, K; };

struct StaticOrder {
    int nM, nN, nwg, G, c;
    __host__ __device__ void init(int M, int N, int G_, int c_) { nM = M / BM; nN = N / BM; nwg = nM * nN; G = G_; c = c_; }
    __host__ __device__ bool next(int i, Unit& u) const {
        const long L = (long)i * G + c; if (L >= nwg) return false;
        int wgid = (int)L; { const int q = nwg / NXCD, r = nwg % NXCD, xcd = wgid % NXCD, off = wgid / NXCD; wgid = (xcd < r ? xcd * (q + 1) : r * (q + 1) + (xcd - r) * q) + off; }
        const int nig = WGM * nN, gid = wgid / nig, fm = gid * WGM, gsz = (nM - fm) < WGM ? (nM - fm) : WGM;
        u.pm = fm + ((wgid % nig) % gsz); u.pn = (wgid % nig) / gsz; return true;
    }
    __device__ __forceinline__ void a_ready(const Unit&) const {}
    __device__ __forceinline__ void done(const Unit&) const {}
};
template <class Epi, class Sched, bool ALIGN_EPI = false, bool SP2 = false>
__device__ __forceinline__ void gemm_phase(PG8_LAS unsigned char* lds, const Gemm g, const Sched& S, const Epi& E) {
    int tid_ = threadIdx.x; asm volatile("" : "+v"(tid_));
    const int tid = tid_, wid = __builtin_amdgcn_readfirstlane(tid >> 6), lane = tid & 63, wr = wid >> 2, wc = wid & 3, fr = lane & 15, fq = lane >> 4;
    const int K = g.K, nt = K / BK;
    unsigned voffA[2], voffB[2];
#pragma unroll
    for (int i = 0; i < 2; ++i) { int R, C; stage_rc(tid * 16 + i * 8192, R, C); const int Rb = Epi::PERM ? ((R & ~31) + perm32(R & 31)) : R;
        voffA[i] = (unsigned)(R * K + C) * 2u; voffB[i] = (unsigned)(Rb * K + C) * 2u; }
    const size_t kstep = (size_t)(BK * 2);
    const size_t hstep = (size_t)HALF * K * 2;
    const size_t tstep = 2 * hstep;
    const unsigned ldsw = (unsigned)wid * 1024u;
    const int aoff = lds_byte(wr * 64 + fr, fq * 8), boff = lds_byte(wc * 32 + fr, fq * 8);
#define PG8_SA(b, h) (((b) * 2 + (h)) * HTB)
#define PG8_SB(b, h) ((4 + (b) * 2 + (h)) * HTB)
#define PG8_STAGE(bufoff, gbase, voff) do { _Pragma("unroll") for (int _i = 0; _i < 2; ++_i) \
        __builtin_amdgcn_global_load_lds((const unsigned*)((const char*)(gbase) + (voff)[_i]), (PG8_LAS unsigned*)(lds + (bufoff) + ldsw + _i * 8192), 16, 0, 0); } while (0)
#define PG8_LDA(dst, b, h) do { _Pragma("unroll") for (int m = 0; m < 4; ++m) _Pragma("unroll") for (int k = 0; k < 2; ++k) dst[m][k] = *(const PG8_LAS bf16x8*)(lds + PG8_SA(b, h) + aoff + m * 2048 + k * 1024); } while (0)
#define PG8_LDB(dst, b, h) do { _Pragma("unroll") for (int n = 0; n < 2; ++n) _Pragma("unroll") for (int k = 0; k < 2; ++k) dst[n][k] = *(const PG8_LAS bf16x8*)(lds + PG8_SB(b, h) + boff + n * 2048 + k * 1024); } while (0)
#define PG8_MMA(ai, bj, At, Bt) do { __builtin_amdgcn_s_setprio(1); _Pragma("unroll") for (int m = 0; m < 4; ++m) _Pragma("unroll") for (int n = 0; n < 2; ++n) _Pragma("unroll") for (int k = 0; k < 2; ++k) \
        acc[ai][bj][m][n] = __builtin_amdgcn_mfma_f32_16x16x32_f16(Bt[n][k], At[m][k], acc[ai][bj][m][n], 0, 0, 0); __builtin_amdgcn_s_setprio(0); } while (0)
#define PG8_WAIT_V(n) asm volatile("s_waitcnt vmcnt(" #n ")" ::: "memory")
#define PG8_WAIT_L(n) asm volatile("s_waitcnt lgkmcnt(" #n ")" ::: "memory")
#define PG8_BAR __builtin_amdgcn_s_barrier()
#define PG8_SCHED __builtin_amdgcn_sched_barrier(0)
    Unit cur, nxt; int ui = 0;
    if (!S.next(0, cur)) return;
    f32x4 acc[2][2][4][2];
#pragma unroll
    for (int a = 0; a < 2; ++a)
#pragma unroll
        for (int b = 0; b < 2; ++b)
#pragma unroll
            for (int m = 0; m < 4; ++m)
#pragma unroll
                for (int n = 0; n < 2; ++n) acc[a][b][m][n] = (f32x4){0.f, 0.f, 0.f, 0.f};
    bf16x8 At[4][2], B0[2][2], B1[2][2];
    const char* cA = (const char*)g.A + (size_t)cur.pm * tstep; const char* cB = (const char*)g.Bt + (size_t)cur.pn * tstep;
    S.a_ready(cur);
    if constexpr (SP2) {
        PG8_STAGE(PG8_SB(0, 0), cB, voffB); PG8_STAGE(PG8_SB(0, 1), cB + hstep, voffB); PG8_STAGE(PG8_SA(0, 0), cA, voffA); PG8_STAGE(PG8_SA(0, 1), cA + hstep, voffA);
        if (wr == 1) PG8_BAR;
        PG8_WAIT_V(2); PG8_BAR;
        PG8_STAGE(PG8_SB(1, 0), cB + kstep, voffB); PG8_STAGE(PG8_SA(1, 0), cA + kstep, voffA); PG8_STAGE(PG8_SB(1, 1), cB + hstep + kstep, voffB);
        PG8_WAIT_V(6); PG8_BAR;
    } else {
        PG8_STAGE(PG8_SB(0, 0), cB, voffB); PG8_STAGE(PG8_SA(0, 0), cA, voffA); PG8_STAGE(PG8_SB(0, 1), cB + hstep, voffB); PG8_STAGE(PG8_SA(0, 1), cA + hstep, voffA);
        if (wr == 1) PG8_BAR;
        PG8_WAIT_V(4); PG8_BAR;
        PG8_STAGE(PG8_SB(1, 0), cB + kstep, voffB); PG8_STAGE(PG8_SA(1, 0), cA + kstep, voffA); PG8_STAGE(PG8_SB(1, 1), cB + hstep + kstep, voffB);
        PG8_WAIT_V(6); PG8_BAR;
    }
    for (;;) {
        const bool has_next = S.next(ui + 1, nxt);
        const char* nA = has_next ? (const char*)g.A + (size_t)nxt.pm * tstep : cA; const char* nB = has_next ? (const char*)g.Bt + (size_t)nxt.pn * tstep : cB;
        for (int t = 0; t < nt; t += 2) {
            const bool last = (t == nt - 2);
            const char* a1 = cA + (size_t)(t + 1) * kstep;
            const char* a2 = last ? nA : cA + (size_t)(t + 2) * kstep; const char* b2 = last ? nB : cB + (size_t)(t + 2) * kstep;
            const char* a3 = a2 + kstep; const char* b3 = b2 + kstep;
            if (last && has_next) S.a_ready(nxt);
            if constexpr (SP2) {
            PG8_LDB(B0, 0, 0); PG8_LDB(B1, 0, 1); PG8_SCHED; PG8_LDA(At, 0, 0); PG8_STAGE(PG8_SA(1, 1), a1 + hstep, voffA);
            PG8_WAIT_V(8); PG8_WAIT_L(0); PG8_BAR; PG8_MMA(0, 0, At, B0); PG8_MMA(0, 1, At, B1); PG8_BAR; PG8_SCHED;
            PG8_LDA(At, 0, 1); PG8_STAGE(PG8_SB(0, 0), b2, voffB); PG8_STAGE(PG8_SB(0, 1), b2 + hstep, voffB); PG8_STAGE(PG8_SA(0, 0), a2, voffA);
            PG8_WAIT_V(8); PG8_WAIT_L(0); PG8_BAR; PG8_MMA(1, 0, At, B0); PG8_MMA(1, 1, At, B1); PG8_BAR; PG8_SCHED;
            PG8_LDB(B0, 1, 0); PG8_LDB(B1, 1, 1); PG8_SCHED; PG8_LDA(At, 1, 0); PG8_STAGE(PG8_SA(0, 1), a2 + hstep, voffA);
            PG8_WAIT_V(8); PG8_WAIT_L(0); PG8_BAR; PG8_MMA(0, 0, At, B0); PG8_MMA(0, 1, At, B1); PG8_BAR; PG8_SCHED;
            PG8_LDA(At, 1, 1); PG8_STAGE(PG8_SB(1, 0), b3, voffB); PG8_STAGE(PG8_SB(1, 1), b3 + hstep, voffB); PG8_STAGE(PG8_SA(1, 0), a3, voffA);
            PG8_WAIT_V(8); PG8_WAIT_L(0); PG8_BAR; PG8_MMA(1, 0, At, B0); PG8_MMA(1, 1, At, B1); PG8_BAR; PG8_SCHED;
            } else {
            PG8_LDB(B0, 0, 0); PG8_SCHED; PG8_LDA(At, 0, 0); PG8_STAGE(PG8_SA(1, 1), a1 + hstep, voffA);
            PG8_WAIT_L(8); PG8_BAR; PG8_WAIT_L(0); PG8_MMA(0, 0, At, B0); PG8_BAR; PG8_SCHED;
            PG8_LDB(B1, 0, 1); PG8_STAGE(PG8_SB(0, 0), b2, voffB);
            PG8_BAR; PG8_WAIT_L(0); PG8_MMA(0, 1, At, B1); PG8_BAR;
            PG8_LDA(At, 0, 1); PG8_STAGE(PG8_SA(0, 0), a2, voffA);
            PG8_BAR; PG8_WAIT_L(0); PG8_MMA(1, 0, At, B0); PG8_BAR; PG8_SCHED;
            PG8_STAGE(PG8_SB(0, 1), b2 + hstep, voffB);
            PG8_WAIT_V(6); PG8_BAR; PG8_MMA(1, 1, At, B1); PG8_BAR;
            PG8_LDB(B0, 1, 0); PG8_SCHED; PG8_LDA(At, 1, 0); PG8_STAGE(PG8_SA(0, 1), a2 + hstep, voffA);
            PG8_WAIT_L(8); PG8_BAR; PG8_WAIT_L(0); PG8_MMA(0, 0, At, B0); PG8_BAR; PG8_SCHED;
            PG8_LDB(B1, 1, 1); PG8_STAGE(PG8_SB(1, 0), b3, voffB);
            PG8_BAR; PG8_WAIT_L(0); PG8_MMA(0, 1, At, B1); PG8_BAR;
            PG8_LDA(At, 1, 1); PG8_STAGE(PG8_SA(1, 0), a3, voffA);
            PG8_BAR; PG8_WAIT_L(0); PG8_MMA(1, 0, At, B0); PG8_BAR; PG8_SCHED;
            PG8_STAGE(PG8_SB(1, 1), b3 + hstep, voffB);
            PG8_WAIT_V(6); PG8_BAR; PG8_MMA(1, 1, At, B1); PG8_BAR;
            }
        }
        if constexpr (ALIGN_EPI) { if (wr == 0) PG8_BAR; }
        if constexpr (!Epi::AFTER_DRAIN) { E(acc, cur, wr, wc, fr, fq); S.done(cur); }
        if (!has_next) break;
#pragma unroll
        for (int a = 0; a < 2; ++a)
#pragma unroll
            for (int b = 0; b < 2; ++b)
#pragma unroll
                for (int m = 0; m < 4; ++m)
#pragma unroll
                    for (int n = 0; n < 2; ++n) acc[a][b][m][n] = (f32x4){0.f, 0.f, 0.f, 0.f};
        cur = nxt; cA = nA; cB = nB; ++ui;
        if constexpr (ALIGN_EPI) { if (wr == 1) PG8_BAR; }
    }
    PG8_WAIT_V(0);
    if constexpr (!ALIGN_EPI) { if (wr == 0) PG8_BAR; }
    PG8_BAR;
    if constexpr (Epi::AFTER_DRAIN) { E.fused(acc, cur, wr, wc, fr, fq, lds, wid, lane); S.done(cur); }
#undef PG8_SA
#undef PG8_SB
#undef PG8_STAGE
#undef PG8_LDA
#undef PG8_LDB
#undef PG8_MMA
#undef PG8_WAIT_V
#undef PG8_WAIT_L
#undef PG8_BAR
#undef PG8_SCHED
}
}

#define XB_TMO      128
#define XB_XCNT(j)  (256  + 64 * (j))
#define XB_XSUB(j)  (1280 + 64 * (j))
#define XB_XGEN(j)  (2304 + 64 * (j))
#define XB_TOP      3328
#define XB_TOPGEN   3392
#define XCD_BAR_WORDS 3456
#define XB_SPIN_CAP (1u << 18)

__device__ __forceinline__ unsigned xb_ld(unsigned* p)              { return __hip_atomic_load(p, __ATOMIC_RELAXED, __HIP_MEMORY_SCOPE_AGENT); }
__device__ __forceinline__ unsigned xb_add(unsigned* p, unsigned v) { return __hip_atomic_fetch_add(p, v, __ATOMIC_RELAXED, __HIP_MEMORY_SCOPE_AGENT); }
__device__ __forceinline__ unsigned xb_xcc_id() { return (unsigned)__builtin_amdgcn_s_getreg((3 << 11) | 20) & 0xFu; }
#define XB_SPIN(cond, bar) do { unsigned _sp = 0; while (cond) { __builtin_amdgcn_s_sleep(1); \
    if ((++_sp & 255u) == 0u) { if (xb_ld(&(bar)[XB_TMO])) break; if (_sp > XB_SPIN_CAP) { atomicAdd(&(bar)[XB_TMO], 1u); break; } } } } while (0)

struct XcdBarrier {
    unsigned* bar; unsigned x;
    volatile LAS unsigned* st;
};

__device__ __forceinline__ XcdBarrier xcd_barrier_post(unsigned* bar, volatile LAS unsigned* st) {
    XcdBarrier b; b.bar = bar; b.x = xb_xcc_id(); b.st = st;
    if (threadIdx.x == 0) (void)xb_add(&bar[XB_XCNT(b.x)], 1u);
    return b;
}
__device__ __forceinline__ void xcd_barrier_complete(unsigned* bar, unsigned x, unsigned& nloc, unsigned& nx) {
    const unsigned G = gridDim.x * gridDim.y * gridDim.z;
    unsigned sum, cnt, mine, sp = 0u;
    for (;;) {
        sum = 0u; cnt = 0u; mine = 0u;
#pragma unroll
        for (unsigned j = 0; j < 16; ++j) { const unsigned c = xb_ld(&bar[XB_XCNT(j)]); sum += c; cnt += (c > 0u) ? 1u : 0u; mine = (j == x) ? c : mine; }
        if (sum == G) break;
        __builtin_amdgcn_s_sleep(1);
        if ((++sp & 255u) == 0u) { if (xb_ld(&bar[XB_TMO])) break; if (sp > XB_SPIN_CAP) { atomicAdd(&bar[XB_TMO], 1u); break; } }
    }
    nloc = mine > 0u ? mine : 1u; nx = cnt > 0u ? cnt : 1u;
}

__device__ __forceinline__ void xcd_barrier(const XcdBarrier& b) {
    asm volatile("s_waitcnt vmcnt(0)" ::: "memory");
    __syncthreads();
    if (threadIdx.x == 0) {
        unsigned* bar = b.bar;
        __builtin_amdgcn_s_waitcnt(0);
        unsigned nloc = b.st[0], nx = b.st[1];
        if (nloc == 0u) { xcd_barrier_complete(bar, b.x, nloc, nx); b.st[0] = nloc; b.st[1] = nx; }
        const unsigned old = xb_add(&bar[XB_XSUB(b.x)], 1u);
        const unsigned gen = old / nloc;
        if (old + 1u == (gen + 1u) * nloc) {
            __builtin_amdgcn_fence(__ATOMIC_RELEASE, "agent");
            asm volatile("s_waitcnt vmcnt(0)" ::: "memory");
            const unsigned og = xb_add(&bar[XB_TOP], 1u);
            const unsigned tg = og / nx;
            if (og + 1u == (tg + 1u) * nx) xb_add(&bar[XB_TOPGEN], 1u);
            else XB_SPIN(xb_ld(&bar[XB_TOPGEN]) == tg, bar);
            __builtin_amdgcn_fence(__ATOMIC_ACQUIRE, "agent");
            xb_add(&bar[XB_XGEN(b.x)], 1u);
            asm volatile("s_waitcnt vmcnt(0)" ::: "memory");
        } else {
            XB_SPIN(xb_ld(&bar[XB_XGEN(b.x)]) == gen, bar);
            __builtin_amdgcn_fence(__ATOMIC_ACQUIRE, "agent");
            asm volatile("s_waitcnt vmcnt(0)" ::: "memory");
        }
    }
    __syncthreads();
}


struct Frame {
    LAS unsigned char* lds;
    volatile LAS unsigned* MISC;
    unsigned* ctl;
    int tid, lane, wave, vcu, G, bx;
    float* out;
    unsigned char* ws;
};
enum { I_XP = 0, I_XS, I_CK, I_CV, I_SCONV, I_SDELTA, I_CP, I_CS, I_LNG, I_LNB, I_RELB, I_WADA, I_BADA, I_WIN, I_CONVW, I_ALOG, I_DTB, I_NORMA, I_LAM, I_SUBLN, I_WO, I_LN1G, I_LN1B, I_WFI, I_WFO, I_LN2G, I_LN2B };

constexpr int LDS_INP_OFF = LDSCTL_OFF + 256;
__device__ __forceinline__ const float* inp(const Frame& F, int i) {
    const unsigned long long v = *((volatile LAS unsigned long long*)(F.lds + LDS_INP_OFF) + i);
    const unsigned lo = __builtin_amdgcn_readfirstlane((unsigned)v), hi = __builtin_amdgcn_readfirstlane((unsigned)(v >> 32));
    return (const float*)(const GAS float*)(((unsigned long long)hi << 32) | lo);
}
template <class T> __device__ __forceinline__ T* as_global(T* p) { return (T*)(GAS T*)(unsigned long long)p; }
#define PHASE_FRAME(P) Frame P = F; asm volatile("" : "+s"(P.ws), "+s"(P.out), "+s"(P.ctl), "+s"(P.G), "+s"(P.vcu), "+s"(P.bx), "+s"(P.wave), "+v"(P.tid), "+v"(P.lane)); \
    P.ws = as_global(P.ws); P.out = as_global(P.out); P.ctl = as_global(P.ctl)
__device__ __forceinline__ unsigned char* ws_of(const Frame& F) { unsigned char* w = F.ws; asm volatile("" : "+s"(w)); return as_global(w); }
__device__ __forceinline__ float wave_sum(float v) {
#pragma unroll
    for (int o = 1; o < 64; o <<= 1) v += __shfl_xor(v, o);
    return v;
}
__device__ __forceinline__ int bb_of_row(int row) { return row < MP ? (row >> 11) : NB + ((row - MP) >> 5); }

#define EPI_ROWS(BODY) _Pragma("unroll") for (int ai = 0; ai < 2; ++ai) _Pragma("unroll") for (int m = 0; m < 4; ++m) { const int row = u.pm * 256 + ai * 128 + wr * 64 + m * 16 + fr; \
        _Pragma("unroll") for (int bj = 0; bj < 2; ++bj) { const int c = cb0 + bj * 128; const f32x4 v0 = acc[ai][bj][m][0], v1 = acc[ai][bj][m][1]; BODY } }
struct EpiProj {
    static constexpr bool PERM = true, AFTER_DRAIN = false;
    f16 *QKVA, *Z, *QB, *KB, *VB, *GAB; float* BG; f16 *KS, *VS; float* out; int layer;
    __device__ __forceinline__ void operator()(const f32x4 (&acc)[2][2][4][2], const pg8::Unit& u, int wr, int wc, int fr, int fq) const {
        asm volatile("" : "+v"(fr), "+v"(fq));
        const int pn = u.pn; const bool samp = u.pm == MP / 256;
        const int cb0 = (pn * 256 + wc * 32 + 8 * fq) - (pn < 12 ? 0 : pn < 16 ? 3072 : pn < 20 ? 4096 : pn < 24 ? 5120 : pn < 28 ? 6144 : pn < 36 ? 7168 : 9216);
        if (pn < 12) {
            EPI_ROWS( *(u32x4*)(QKVA + (size_t)row * CONVC + c) = pk8h(v0, v1);
                      const int t = samp ? ((row - MP) & 31) - 29 : (row & 2047) - 2045;
                      if (t >= 0) { float* o = out + (samp ? OUT_CS + ((size_t)(layer * NSB + ((row - MP) >> 5)) * 3 + t) * CONVC : OUT_CP + ((size_t)(layer * NB + (row >> 11)) * 3 + t) * CONVC) + c;
                                    *(f32x4*)o = v0; *(f32x4*)(o + 4) = v1; } )
        } else if (pn < 16) {
            EPI_ROWS( *(u32x4*)(Z + (size_t)row * D + c) = pk8h(v0, v1); )
        } else if (pn < 20) {
            const float sc = 0.125f * LOG2E;
            EPI_ROWS( *(u32x4*)(QB + (size_t)row * D + c) = pk8h(v0 * sc, v1 * sc); )
        } else if (pn < 28) {
            const bool isk = pn < 24;
            if (!samp) { f16* dst = isk ? KB : VB; float* ob = out + (isk ? OUT_KP : OUT_VP) + (size_t)layer * MP * D;
                EPI_ROWS( *(u32x4*)(dst + (size_t)row * D + c) = pk8h(v0, v1); float* o = ob + (size_t)row * D + c; *(f32x4*)o = v0; *(f32x4*)(o + 4) = v1; )
            } else { f16* dst = isk ? KS : VS; float* ob = out + (isk ? OUT_KS : OUT_VS) + (size_t)layer * MS * D;
                EPI_ROWS( const int sr = row - MP; *(u32x4*)(dst + ((size_t)(sr >> 5) * KSROWS + PAST + (sr & 31)) * D + c) = pk8h(v0, v1); float* o = ob + (size_t)sr * D + c; *(f32x4*)o = v0; *(f32x4*)(o + 4) = v1; )
            }
        } else if (pn < 36) {
            EPI_ROWS( f32x4 s0; f32x4 s1;
                      _Pragma("unroll") for (int i = 0; i < 4; ++i) { s0[i] = sigmoidf_(v0[i]); s1[i] = sigmoidf_(v1[i]); }
                      *(u32x4*)(GAB + (size_t)row * 2048 + c) = pk8h(s0, s1); )
        } else {
            if (wc == 0 && fq < 2) {
                EPI_ROWS( if (bj == 0) { *(f32x4*)(BG + (size_t)row * 16 + c) = v0; *(f32x4*)(BG + (size_t)row * 16 + c + 4) = v1; } )
            }
        }
    }
};
#undef EPI_ROWS
struct EpiRes {
    static constexpr bool PERM = false, AFTER_DRAIN = false;
    float* X; const float* gate;
    __device__ __forceinline__ void operator()(const f32x4 (&acc)[2][2][4][2], const pg8::Unit& u, int wr, int wc, int fr, int fq) const {
        asm volatile("" : "+v"(fr), "+v"(fq));
#pragma unroll
        for (int ai = 0; ai < 2; ++ai)
#pragma unroll
            for (int m = 0; m < 4; ++m) {
                const int row = u.pm * 256 + ai * 128 + wr * 64 + m * 16 + fr;
                const float* gp = gate + (size_t)bb_of_row(row) * 6144; float* xp = X + (size_t)row * D;
#pragma unroll
                for (int bj = 0; bj < 2; ++bj)
#pragma unroll
                    for (int n = 0; n < 2; ++n) {
                        const int c = u.pn * 256 + bj * 128 + wc * 32 + n * 16 + 4 * fq;
                        const f32x4 g = *(const f32x4*)(gp + c); const f32x4 x = *(const f32x4*)(xp + c);
                        *(f32x4*)(xp + c) = x * ALPHA + g * acc[ai][bj][m][n];
                    }
                asm volatile("" ::: "memory");
            }
    }
};
struct EpiSwiGLU {
    static constexpr bool PERM = true, AFTER_DRAIN = false;
    f16* ACT;
    __device__ __forceinline__ void operator()(const f32x4 (&acc)[2][2][4][2], const pg8::Unit& u, int wr, int wc, int fr, int fq) const {
        asm volatile("" : "+v"(fr), "+v"(fq));
#pragma unroll
        for (int ai = 0; ai < 2; ++ai)
#pragma unroll
            for (int m = 0; m < 4; ++m) {
                const int row = u.pm * 256 + ai * 128 + wr * 64 + m * 16 + fr;
                f32x4 a0, a1;
#pragma unroll
                for (int i = 0; i < 4; ++i) { a0[i] = siluf_(acc[ai][0][m][0][i]) * acc[ai][1][m][0][i]; a1[i] = siluf_(acc[ai][0][m][1][i]) * acc[ai][1][m][1][i]; }
                *(u32x4*)(ACT + (size_t)row * DFF + u.pn * 128 + wc * 32 + 8 * fq) = pk8h(a0, a1);
            }
    }
};

__device__ __forceinline__ int win_src_col(int d) { return d < 4096 ? d : (d < 9216 ? d + 16 : (d < 9232 ? d - 9216 + 4096 : -1)); }
__device__ __forceinline__ int wfi_src_col(int d) { const int t = d >> 8, w = d & 255; return w < 128 ? 128 * t + w : DFF + 128 * t + (w - 128); }
__device__ __forceinline__ void transpose_item(const float* W, int ldw, int ksrc0, int srccol, f16* WT, int ldwt, int drow0, int kdst0, LAS float* scr, int lane) {
#pragma unroll 8
    for (int i = 0; i < 32; ++i) { const int kk = 2 * i + (lane >> 5); scr[kk * 33 + (lane & 31)] = srccol >= 0 ? W[(size_t)(ksrc0 + kk) * ldw + srccol] : 0.f; }
    LDS_WAIT(); asm volatile("" ::: "memory");
    const int c = lane & 7;
#pragma unroll
    for (int j = 0; j < 4; ++j) { const int n = (lane >> 3) + 8 * j; const LAS float* s = scr + (8 * c) * 33 + n;
        u32x4 o; o.x = pk2h(s[0 * 33], s[1 * 33]); o.y = pk2h(s[2 * 33], s[3 * 33]); o.z = pk2h(s[4 * 33], s[5 * 33]); o.w = pk2h(s[6 * 33], s[7 * 33]);
        *(u32x4*)(WT + (size_t)(drow0 + n) * ldwt + kdst0 + 8 * c) = o; }
    LDS_WAIT(); asm volatile("" ::: "memory");
}
__device__ __forceinline__ int t5_bucket(int rel) {
    const int n = rel < 0 ? -rel : rel;
    const int large = 8 + (n >= 12) + (n >= 16) + (n >= 23) + (n >= 32) + (n >= 46) + (n >= 64) + (n >= 91);
    return (rel > 0 ? 16 : 0) + (n < 8 ? n : large);
}
__device__ __forceinline__ void p0a_prologue(Frame& F) {
    const int gw = F.vcu * NWAVES + F.wave, NGW = F.G * NWAVES;
    const int gt = F.vcu * 512 + F.tid, NGT = F.G * 512;
    if (F.vcu < 192) {
        LAS float* sT = (LAS float*)F.lds;
        LAS float* red = (LAS float*)(F.lds + 98304);
        for (int i = F.tid; i < NBB * D; i += 512) { const int bb = i >> 10, d = i & 1023; const float c = bb < NB ? inp(F, I_CP)[bb * D + d] : inp(F, I_CS)[(bb - NB) * D + d]; sT[d * NBB + bb] = siluf_(c); }
        __syncthreads();
        const int cidx = F.vcu * 128 + (F.tid & 127), l = cidx / 6144, e = cidx % 6144, dq = F.tid >> 7;
        float acc[NBB];
#pragma unroll
        for (int b = 0; b < NBB; ++b) acc[b] = 0.f;
        const float* wp = inp(F, I_WADA) + ((size_t)l * D + dq * 256) * 6144 + e;
#pragma unroll 4
        for (int d = 0; d < 256; ++d) {
            const float w = wp[(size_t)d * 6144];
            const LAS f32x4* sp = (const LAS f32x4*)(sT + (dq * 256 + d) * NBB);
#pragma unroll
            for (int q = 0; q < 6; ++q) { const f32x4 s = sp[q]; acc[4 * q] += s[0] * w; acc[4 * q + 1] += s[1] * w; acc[4 * q + 2] += s[2] * w; acc[4 * q + 3] += s[3] * w; }
        }
        for (int r = 0; r < 4; ++r) {
            if (dq == r) {
#pragma unroll
                for (int b = 0; b < NBB; ++b) { LAS float* p = red + b * 128 + (F.tid & 127); *p = (r == 0 ? 0.f : *p) + acc[b]; }
            }
            __syncthreads();
        }
        float* mod = (float*)(F.ws + WS_MOD);
        for (int i = F.tid; i < NBB * 128; i += 512) { const int b = i >> 7, cc = i & 127; const int ci = F.vcu * 128 + cc, ll = ci / 6144, ee = ci % 6144;
            mod[((size_t)ll * NBB + b) * 6144 + ee] = red[b * 128 + cc] + inp(F, I_BADA)[ll * 6144 + ee]; }
        __syncthreads();
    }
    {
        LAS float* scr = (LAS float*)(F.lds + F.wave * 16384);
        constexpr int I_IN = 16 * (NPROJ / 32), I_O = 32 * 32, I_FI = 16 * (2 * DFF / 32), I_FO = (DFF / 64) * 32, I_L = I_IN + I_O + I_FI + I_FO;
        for (int it = gw; it < DEPTH * I_L; it += NGW) {
            const int l = it / I_L; int r = it % I_L;
            if (r < I_IN) { const int kb = r / (NPROJ / 32), nb = r % (NPROJ / 32);
                transpose_item(inp(F, I_WIN) + (size_t)l * D * DIN, DIN, 64 * kb, win_src_col(32 * nb + (F.lane & 31)), (f16*)(F.ws + WS_WIN) + (size_t)l * NPROJ * D, D, 32 * nb, 64 * kb, scr, F.lane); continue; }
            r -= I_IN;
            if (r < I_O) { const int kb = r / 32, nb = r % 32;
                transpose_item(inp(F, I_WO) + (size_t)l * D * D, D, (64 * kb) & 1023, 32 * nb + (F.lane & 31), (f16*)(F.ws + WS_WO2) + (size_t)l * D * 2048, 2048, 32 * nb, 64 * kb, scr, F.lane); continue; }
            r -= I_O;
            if (r < I_FI) { const int kb = r / (2 * DFF / 32), nb = r % (2 * DFF / 32);
                transpose_item(inp(F, I_WFI) + (size_t)l * D * 2 * DFF, 2 * DFF, 64 * kb, wfi_src_col(32 * nb + (F.lane & 31)), (f16*)(F.ws + WS_WFI) + (size_t)l * 2 * DFF * D, D, 32 * nb, 64 * kb, scr, F.lane); continue; }
            r -= I_FI;
            { const int kb = r / 32, nb = r % 32;
                transpose_item(inp(F, I_WFO) + (size_t)l * DFF * D, D, 64 * kb, 32 * nb + (F.lane & 31), (f16*)(F.ws + WS_WFO) + (size_t)l * D * DFF, DFF, 32 * nb, 64 * kb, scr, F.lane); }
        }
    }
    {
        const size_t nchunk = (size_t)DEPTH * NSB * PAST * D / 8;
        for (size_t i = gt; i < 2 * nchunk; i += NGT) {
            const bool isv = i >= nchunk; const size_t j = isv ? i - nchunk : i;
            const float* src = inp(F, isv ? I_CV : I_CK) + j * 8;
            const f32x4 a = *(const f32x4*)src, b = *(const f32x4*)(src + 4);
            const size_t lsb = j / (PAST * D / 8), rem = j % (PAST * D / 8);
            f16* dst = (f16*)(F.ws + (isv ? WS_VS : WS_KS)) + lsb * (size_t)KSROWS * D + rem * 8;
            *(u32x4*)dst = pk8h(a, b);
        }
        const int nz = DEPTH * NSB * 32 * D / 8;
        for (int i = gt; i < 2 * nz; i += NGT) {
            const bool isv = i >= nz; const int j = isv ? i - nz : i;
            const int lsb = j / (32 * D / 8), rem = j % (32 * D / 8);
            f16* dst = (f16*)(F.ws + (isv ? WS_VS : WS_KS)) + ((size_t)lsb * KSROWS + PAST + 32) * D + rem * 8;
            *(u32x4*)dst = (u32x4){0u, 0u, 0u, 0u};
        }
    }
    if (F.vcu == F.G - 1) {
        float* misc = (float*)(F.ws + WS_MISC);
        if (F.wave < DEPTH) {
            const float* lp = inp(F, I_LAM) + F.wave * 4 * 64;
            const float s01 = wave_sum(lp[F.lane] * lp[64 + F.lane]), s23 = wave_sum(lp[128 + F.lane] * lp[192 + F.lane]);
            const float lam_init = 0.8f - 0.6f * expf(-0.3f * (float)F.wave);
            if (F.lane == 0) misc[F.wave] = expf(s01) - expf(s23) + lam_init;
        }
        for (int i = F.tid; i < NH * 256; i += 512) { const int h = i >> 8, rel = (i & 255) - 128; misc[64 + i] = inp(F, I_RELB)[t5_bucket(rel) * NH + h] * LOG2E; }
    }
}
__device__ __forceinline__ void ln_row(const float* src, const float* g, const float* b, float* dst, f16* hrow, const float* sh, const float* sc, int lane) {
    const f32x4* xr = (const f32x4*)src + lane;
    f32x4 v[4]; float s = 0.f;
#pragma unroll
    for (int j = 0; j < 4; ++j) { v[j] = xr[64 * j]; s += (v[j][0] + v[j][1]) + (v[j][2] + v[j][3]); }
    const float mean = wave_sum(s) * (1.f / D); float s2 = 0.f;
#pragma unroll
    for (int j = 0; j < 4; ++j) { v[j] = v[j] - mean; s2 += (v[j][0] * v[j][0] + v[j][1] * v[j][1]) + (v[j][2] * v[j][2] + v[j][3] * v[j][3]); }
    const float rstd = 1.0f / sqrtf(wave_sum(s2) * (1.f / D) + LN_EPS);
#pragma unroll
    for (int j = 0; j < 4; ++j) {
        const int c = 4 * lane + 256 * j;
        const f32x4 x = v[j] * rstd * *(const f32x4*)(g + c) + *(const f32x4*)(b + c);
        *(f32x4*)(dst + c) = x;
        if (hrow) { const f32x4 hh = x * (*(const f32x4*)(sc + c) + 1.0f) + *(const f32x4*)(sh + c);
            u32x2 w; w.x = pk2h(hh[0], hh[1]); w.y = pk2h(hh[2], hh[3]); *(u32x2*)(hrow + c) = w; }
    }
}
__device__ __forceinline__ void ln_phase(Frame& F, bool first, bool last, const float* g, const float* b, const float* modl, int sh_off, int sc_off) {
    const int gw = F.vcu * NWAVES + F.wave, NGW = F.G * NWAVES;
    float* X = (float*)(F.ws + WS_X); f16* H = (f16*)(F.ws + WS_H);
    for (int m = gw; m < M; m += NGW) {
        const float* src = first ? (m < MP ? inp(F, I_XP) + (size_t)m * D : inp(F, I_XS) + (size_t)(m - MP) * D) : X + (size_t)m * D;
        float* dst = last ? (m < MP ? F.out + OUT_YP + (size_t)m * D : F.out + OUT_YS + (size_t)(m - MP) * D) : X + (size_t)m * D;
        const float* mb = modl + (size_t)bb_of_row(m) * 6144;
        ln_row(src, g, b, dst, last ? nullptr : H + (size_t)m * D, mb + sh_off, mb + sc_off, F.lane);
    }
}

constexpr int D1_KN = 0, D1_QN = 17408, D1_RT = 34816, D1_AM = 71680, D1_TM = 89088, D1_SC = 98304, D1_SS = 100352;
struct D1Task { int row0, nvalid, n, unit; const float* hist; };

__device__ __forceinline__ f32x16 mfma32(f16x8 a, f16x8 b, f32x16 c) { return __builtin_amdgcn_mfma_f32_32x32x16_f16(a, b, c, 0, 0, 0); }
__device__ __forceinline__ f16x8 cvt8(const f32x16& v, int o) {
    u32x4 w; w.x = pk2h(v[o], v[o + 1]); w.y = pk2h(v[o + 2], v[o + 3]); w.z = pk2h(v[o + 4], v[o + 5]); w.w = pk2h(v[o + 6], v[o + 7]); return __builtin_bit_cast(f16x8, w);
}

__device__ __forceinline__ void d1_unit(Frame& F, const D1Task& T, int h, int layer) {
    LAS unsigned char* L = F.lds;
    LAS f16* Kn = (LAS f16*)(L + D1_KN); LAS f16* Qn = (LAS f16*)(L + D1_QN); LAS f16* RT = (LAS f16*)(L + D1_RT);
    LAS float* Am = (LAS float*)(L + D1_AM); LAS f16* Tm = (LAS f16*)(L + D1_TM);
    LAS float* sBeta = (LAS float*)(L + D1_SC); LAS float* sG = sBeta + 64; LAS float* sEG = sBeta + 128; LAS float* sEGL = sBeta + 192;
    LAS float* sSS = (LAS float*)(L + D1_SS);
    int lane = F.lane, wave = F.wave; asm volatile("" : "+v"(lane), "+s"(wave));
    const int r32 = lane & 31, hi = lane >> 5;
    const f16* QKVA = (const f16*)(F.ws + WS_QKVA); const float* BG = (const float*)(F.ws + WS_BG);
    unsigned char* img = F.ws + WS_DIMG + (size_t)T.unit * DIMG_BYTES;
    if (wave == 0) {
        const bool valid = lane < T.nvalid;
        float beta = 0.f, g = 0.f;
        if (valid) {
            const float braw = BG[(size_t)(T.row0 + lane) * 16 + h], araw = BG[(size_t)(T.row0 + lane) * 16 + 8 + h];
            beta = 1.0f / (1.0f + expf(-braw));
            const float x = araw + inp(F, I_DTB)[layer * NH + h];
            g = -expf(inp(F, I_ALOG)[layer * NH + h]) * (x > 20.f ? x : log1pf(expf(x)));
        }
#pragma unroll
        for (int o = 1; o < 64; o <<= 1) { const float t = __shfl_up(g, o); if (lane >= o) g += t; }
        const float glast = __shfl(g, 63);
        sBeta[lane] = beta; sG[lane] = g; sEG[lane] = expf(g); sEGL[lane] = expf(glast - g);
        if (lane == 0) ((float*)(F.ws + WS_MISC))[4096 + T.unit] = expf(glast);
    }
    __syncthreads();
    const int l = lane;
    const bool valid = l < T.nvalid;
    const float* cw = inp(F, I_CONVW) + (size_t)layer * 4 * CONVC;
    float xq[16], xk[16];
#pragma unroll
    for (int tz = 0; tz < 3; ++tz) {
        const int col0 = tz * 1024 + h * 128 + 16 * wave;
        float x[16];
#pragma unroll
        for (int e = 0; e < 16; ++e) x[e] = 0.f;
#pragma unroll
        for (int i = 0; i < 4; ++i) {
            const int tr = l - 3 + i;
            float uu[16];
            if (tr >= 0 || T.n > 0) {
                const f16* p = QKVA + (size_t)(T.row0 + tr) * CONVC + col0;
                const f16x8 a = *(const f16x8*)p, b = *(const f16x8*)(p + 8);
#pragma unroll
                for (int e = 0; e < 8; ++e) { uu[e] = (float)a[e]; uu[8 + e] = (float)b[e]; }
            } else if (T.hist) {
                const float* p = T.hist + (size_t)(3 + tr) * CONVC + col0;
#pragma unroll
                for (int e = 0; e < 16; e += 4) { const f32x4 a = *(const f32x4*)(p + e); uu[e] = a[0]; uu[e + 1] = a[1]; uu[e + 2] = a[2]; uu[e + 3] = a[3]; }
            } else {
#pragma unroll
                for (int e = 0; e < 16; ++e) uu[e] = 0.f;
            }
#pragma unroll
            for (int e = 0; e < 16; ++e) x[e] += cw[i * CONVC + col0 + e] * uu[e];
        }
        float ss = 0.f;
#pragma unroll
        for (int e = 0; e < 16; ++e) { x[e] = valid ? siluf_(x[e]) : 0.f; ss += x[e] * x[e]; }
        if (tz == 0) {
#pragma unroll
            for (int e = 0; e < 16; ++e) xq[e] = x[e];
            sSS[(0 * 8 + wave) * 64 + l] = ss;
        } else if (tz == 1) {
#pragma unroll
            for (int e = 0; e < 16; ++e) xk[e] = x[e];
            sSS[(1 * 8 + wave) * 64 + l] = ss;
        } else {
            const float beta = sBeta[l];
#pragma unroll
            for (int e = 0; e < 16; ++e) RT[(16 * wave + e) * 72 + l] = (f16)(x[e] * beta);
        }
    }
    __syncthreads();
    {
        float sq = 0.f, sk = 0.f;
#pragma unroll
        for (int w = 0; w < 8; ++w) { sq += sSS[(0 * 8 + w) * 64 + l]; sk += sSS[(1 * 8 + w) * 64 + l]; }
        const float rq = rsqrtf(sq + 1e-6f) * 0.08838834764831845f, rk = rsqrtf(sk + 1e-6f);
        const float beta = sBeta[l], eg = sEG[l], egl = sEGL[l];
        float qg[16], kt[16];
#pragma unroll
        for (int e = 0; e < 16; ++e) { xq[e] *= rq; xk[e] *= rk; qg[e] = xq[e] * eg; kt[e] = xk[e] * egl; }
        u32x4 w0, w1;
        w0 = (u32x4){pk2h(xq[0], xq[1]), pk2h(xq[2], xq[3]), pk2h(xq[4], xq[5]), pk2h(xq[6], xq[7])}; w1 = (u32x4){pk2h(xq[8], xq[9]), pk2h(xq[10], xq[11]), pk2h(xq[12], xq[13]), pk2h(xq[14], xq[15])};
        *(LAS u32x4*)(Qn + l * 136 + 16 * wave) = w0; *(LAS u32x4*)(Qn + l * 136 + 16 * wave + 8) = w1;
        w0 = (u32x4){pk2h(xk[0], xk[1]), pk2h(xk[2], xk[3]), pk2h(xk[4], xk[5]), pk2h(xk[6], xk[7])}; w1 = (u32x4){pk2h(xk[8], xk[9]), pk2h(xk[10], xk[11]), pk2h(xk[12], xk[13]), pk2h(xk[14], xk[15])};
        *(LAS u32x4*)(Kn + l * 136 + 16 * wave) = w0; *(LAS u32x4*)(Kn + l * 136 + 16 * wave + 8) = w1;
        f16* qgi = (f16*)(img + IMG_QG) + ((size_t)((l >> 5) * 8 + wave) * 64 + (l & 31)) * 8;
        *(u32x4*)qgi = (u32x4){pk2h(qg[0], qg[1]), pk2h(qg[2], qg[3]), pk2h(qg[8], qg[9]), pk2h(qg[10], qg[11])};
        *(u32x4*)(qgi + 32 * 8) = (u32x4){pk2h(qg[4], qg[5]), pk2h(qg[6], qg[7]), pk2h(qg[12], qg[13]), pk2h(qg[14], qg[15])};
        f16* kti = (f16*)(img + IMG_KT) + l * 128 + 16 * wave;
        *(u32x4*)kti = (u32x4){pk2h(kt[0], kt[1]), pk2h(kt[2], kt[3]), pk2h(kt[4], kt[5]), pk2h(kt[6], kt[7])};
        *(u32x4*)(kti + 8) = (u32x4){pk2h(kt[8], kt[9]), pk2h(kt[10], kt[11]), pk2h(kt[12], kt[13]), pk2h(kt[14], kt[15])};
        const float be = beta * eg;
#pragma unroll
        for (int e = 0; e < 16; ++e) RT[(128 + 16 * wave + e) * 72 + l] = (f16)(xk[e] * be);
    }
    __syncthreads();
    if ((wave & 3) < 3) {
        const bool isqk = wave >= 4; const int w3 = wave & 3;
        const int ta = isqk ? (w3 == 2 ? 1 : 0) : (w3 == 0 ? 0 : 1);
        const int tb = isqk ? (w3 == 0 ? 0 : 1) : (w3 == 2 ? 1 : 0);
        const LAS f16* Bm = isqk ? Qn : Kn;
        f32x16 acc = {};
#pragma unroll
        for (int s = 0; s < 8; ++s) {
            const f16x8 a = *(const LAS f16x8*)(Kn + (32 * ta + r32) * 136 + 16 * s + 8 * hi);
            const f16x8 b = *(const LAS f16x8*)(Bm + (32 * tb + r32) * 136 + 16 * s + 8 * hi);
            acc = mfma32(a, b, acc);
        }
        const int cj = 32 * tb + r32;
        const float gj = sG[cj];
        if (!isqk) {
#pragma unroll
            for (int r = 0; r < 16; ++r) { const int i = 32 * ta + crow(r, hi);
                Am[i * 68 + cj] = i > cj ? sBeta[i] * acc[r] * expf(sG[i] - gj) : 0.f; }
        } else {
            f32x16 v;
#pragma unroll
            for (int r = 0; r < 16; ++r) { const int lp = 32 * ta + crow(r, hi);
                v[r] = cj >= lp ? acc[r] * expf(gj - sG[lp]) : 0.f; }
            f16* qki = (f16*)(img + IMG_QK);
#pragma unroll
            for (int sp = 0; sp < 2; ++sp) *(f16x8*)(qki + ((size_t)(tb * 4 + 2 * ta + sp) * 64 + lane) * 8) = cvt8(v, 8 * sp);
        }
    } else if (wave == 7) {
        f16* qki = (f16*)(img + IMG_QK);
#pragma unroll
        for (int ks = 2; ks < 4; ++ks) *(u32x4*)(qki + ((size_t)(0 * 4 + ks) * 64 + lane) * 8) = (u32x4){0u, 0u, 0u, 0u};
    }
    __syncthreads();
    if (wave == 0) {
        float t[64];
        const LAS float* Amo = Am; asm volatile("" : "+v"(Amo));
#pragma unroll
        for (int i = 0; i < 64; ++i) {
            float a0 = (i == lane) ? 1.f : 0.f, a1 = 0.f, a2 = 0.f, a3 = 0.f;
            const LAS float* ar = Amo + i * 68;
#pragma unroll
            for (int j = 0; j + 3 < i; j += 4) { const f32x4 av = *(const LAS f32x4*)(ar + j); a0 -= av[0] * t[j]; a1 -= av[1] * t[j + 1]; a2 -= av[2] * t[j + 2]; a3 -= av[3] * t[j + 3]; }
#pragma unroll
            for (int j = i & ~3; j < i; ++j) a0 -= ar[j] * t[j];
            t[i] = (a0 + a1) + (a2 + a3);
        }
#pragma unroll
        for (int i = 0; i < 64; ++i) Tm[i * 72 + lane] = (f16)t[i];
    }
    __syncthreads();
    {
        const int rt = wave & 1, tq = wave >> 1;
        f32x16 au = {}, aw = {};
        const int ns = rt == 0 ? 2 : 4;
#pragma unroll
        for (int s = 0; s < 4; ++s) if (s < ns) {
            const f16x8 tf = *(const LAS f16x8*)(Tm + (32 * rt + r32) * 72 + 16 * s + 8 * hi);
            const f16x8 bv = *(const LAS f16x8*)(RT + (32 * tq + r32) * 72 + 16 * s + 8 * hi);
            const f16x8 ak = *(const LAS f16x8*)(RT + (128 + 32 * tq + r32) * 72 + 16 * s + 8 * hi);
            au = mfma32(tf, bv, au);
            aw = mfma32(ak, tf, aw);
        }
        f16* uvi = (f16*)(img + IMG_UV) + ((size_t)(tq * 2 + rt) * 64 + lane) * 16;
        *(f16x8*)uvi = cvt8(au, 0); *(f16x8*)(uvi + 8) = cvt8(au, 8);
        f16* wki = (f16*)(img + IMG_WK);
#pragma unroll
        for (int sp = 0; sp < 2; ++sp) *(f16x8*)(wki + ((size_t)(rt * 8 + 2 * tq + sp) * 64 + lane) * 8) = cvt8(aw, 8 * sp);
    }
    __syncthreads();
}

constexpr int SC_BUF = 57344, SC_OB = 2 * SC_BUF, SC_OBB = 16384;
__device__ __forceinline__ int vswz(int row, int ch) { return row * 256 + ((ch ^ (((row & 3) << 2) | ((row >> 2) & 3))) << 4); }
__device__ __forceinline__ f16x4 tr_read(const LAS unsigned char* p) { return __builtin_bit_cast(f16x4, __builtin_amdgcn_ds_read_tr16_b64_v4i16((LAS v4i16_t*)p)); }
struct TrAddr { int a[2][4]; };
__device__ __forceinline__ TrAddr tr_addr(int lane) {
    const int g = lane >> 4, i = lane & 15, q = i >> 2, p = i & 3, hi = g >> 1; TrAddr t;
#pragma unroll
    for (int sec = 0; sec < 2; ++sec)
#pragma unroll
        for (int cb = 0; cb < 4; ++cb)
            t.a[sec][cb] = (4 * hi + q + 8 * sec) * 256 + (((((cb ^ q) << 2) | ((((g & 1) << 1) | (p >> 1)) ^ ((hi + 2 * sec) & 3)))) << 4) + 8 * (p & 1);
    return t;
}
__device__ __forceinline__ f16x8 tr_frag(const LAS unsigned char* base, const TrAddr& t, int k0, int cb) {
    const f16x4 lo = tr_read(base + t.a[0][cb] + k0 * 256);
    const f16x4 hh = tr_read(base + t.a[1][cb] + k0 * 256);
    return (f16x8){lo[0], lo[1], lo[2], lo[3], hh[0], hh[1], hh[2], hh[3]};
}

__device__ __forceinline__ void scan_task(Frame& F, bool samp, int b, int h, int layer) {
    LAS unsigned char* L = F.lds;
    int lane = F.lane, wave = F.wave; asm volatile("" : "+v"(lane), "+s"(wave));
    const int tid = wave * 64 + lane, r32 = lane & 31, hi = lane >> 5;
    const bool cwv = wave < 4; const int w = wave & 3;
    const TrAddr TA = tr_addr(lane);
    const int nch = samp ? 1 : 32, unit0 = samp ? NB * NH * 32 + b * NH + h : (b * NH + h) * 32;
    const int row00 = samp ? MP + b * SSEQ : b * SEQ, nvalid = samp ? SSEQ : 64;
    const unsigned char* img0 = F.ws + WS_DIMG + (size_t)unit0 * DIMG_BYTES;
    const float* glast = (const float*)(F.ws + WS_MISC) + 4096 + unit0;
    f32x16 S[4];
#pragma unroll
    for (int t = 0; t < 4; ++t) S[t] = f32x16{};
    if (samp && cwv) {
        const float* sd = inp(F, I_SDELTA) + ((size_t)(layer * NSB + b) * NH + h) * DK * DK;
#pragma unroll
        for (int t = 0; t < 4; ++t)
#pragma unroll
            for (int r = 0; r < 16; ++r) S[t][r] = sd[(32 * t + crow(r, hi)) * DK + 32 * w + r32];
    }
    const int st = tid - 256;
#define SC_STAGE(nn, bufo) do { const unsigned char* im_ = img0 + (size_t)(nn) * DIMG_BYTES; u32x4 rg_[14]; \
        _Pragma("unroll") for (int i_ = 0; i_ < 14; ++i_) rg_[i_] = *(const u32x4*)(im_ + (size_t)(st + 256 * i_) * 16); \
        _Pragma("unroll") for (int i_ = 0; i_ < 14; ++i_) { const int c_ = st + 256 * i_; \
            const int o_ = c_ < (IMG_KT / 16) ? c_ * 16 : IMG_KT + vswz((c_ - IMG_KT / 16) >> 4, (c_ - IMG_KT / 16) & 15); \
            *(LAS u32x4*)(L + (bufo) + o_) = rg_[i_]; } } while (0)
    if (!cwv) SC_STAGE(0, 0);
    __syncthreads();
    for (int n = 0; n < nch; ++n) {
        const int bo = (n & 1) * SC_BUF;
        if (!cwv) { if (n + 1 < nch) SC_STAGE(n + 1, SC_BUF - bo); }
        else {
            const LAS unsigned char* B = L + bo;
            const f16* uvp = (const f16*)(img0 + (size_t)n * DIMG_BYTES + IMG_UV);
            f16x8 uv[2][2];
#pragma unroll
            for (int rt = 0; rt < 2; ++rt) { const f16* p = uvp + ((size_t)(w * 2 + rt) * 64 + lane) * 16; uv[rt][0] = *(const f16x8*)p; uv[rt][1] = *(const f16x8*)(p + 8); }
            const float gl = glast[n];
            f32x16 up[2] = {f32x16{}, f32x16{}}, o[2] = {f32x16{}, f32x16{}};
#pragma unroll
            for (int t = 0; t < 4; ++t)
#pragma unroll
                for (int sp = 0; sp < 2; ++sp) {
                    const f16x8 bf = cvt8(S[t], 8 * sp); const int ks = 2 * t + sp;
#pragma unroll
                    for (int rt = 0; rt < 2; ++rt) {
                        const f16x8 wk = *(const LAS f16x8*)(B + IMG_WK + ((rt * 8 + ks) * 64 + lane) * 16);
                        const f16x8 qg = *(const LAS f16x8*)(B + IMG_QG + ((rt * 8 + ks) * 64 + lane) * 16);
                        up[rt] = mfma32(wk, bf, up[rt]); o[rt] = mfma32(qg, bf, o[rt]);
                    }
                }
#pragma unroll
            for (int rt = 0; rt < 2; ++rt)
#pragma unroll
                for (int r = 0; r < 16; ++r) up[rt][r] = (float)uv[rt][r >> 3][r & 7] - up[rt][r];
#pragma unroll
            for (int t = 0; t < 4; ++t) S[t] = S[t] * gl;
#pragma unroll
            for (int rt2 = 0; rt2 < 2; ++rt2)
#pragma unroll
                for (int sp = 0; sp < 2; ++sp) {
                    const f16x8 bf = cvt8(up[rt2], 8 * sp); const int ks = 2 * rt2 + sp;
                    o[1] = mfma32(*(const LAS f16x8*)(B + IMG_QK + ((1 * 4 + ks) * 64 + lane) * 16), bf, o[1]);
                    if (rt2 == 0) o[0] = mfma32(*(const LAS f16x8*)(B + IMG_QK + ((0 * 4 + ks) * 64 + lane) * 16), bf, o[0]);
#pragma unroll
                    for (int t = 0; t < 4; ++t) S[t] = mfma32(tr_frag(B + IMG_KT, TA, 16 * ks, t), bf, S[t]);
                }
            LAS f16* ob = (LAS f16*)(L + SC_OB + (n & 1) * SC_OBB);
#pragma unroll
            for (int rt = 0; rt < 2; ++rt)
#pragma unroll
                for (int r = 0; r < 16; ++r) ob[(32 * rt + crow(r, hi)) * 128 + 32 * w + r32] = (f16)o[rt][r];
        }
        __syncthreads();
        {
            const int l = tid >> 3, part = tid & 7;
            const LAS f16* ob = (const LAS f16*)(L + SC_OB + (n & 1) * SC_OBB) + l * 128 + 16 * part;
            const f16x8 a0 = *(const LAS f16x8*)ob, a1 = *(const LAS f16x8*)(ob + 8);
            float v[16]; float ss = 0.f;
#pragma unroll
            for (int e = 0; e < 8; ++e) { v[e] = (float)a0[e]; v[8 + e] = (float)a1[e]; }
#pragma unroll
            for (int e = 0; e < 16; ++e) ss += v[e] * v[e];
            ss += __shfl_xor(ss, 1); ss += __shfl_xor(ss, 2); ss += __shfl_xor(ss, 4);
            const float rstd = rsqrtf(ss * (1.0f / 128.0f) + LN_EPS);
            if (l < nvalid) {
                const size_t row = (size_t)row00 + 64 * n + l; const int c = h * 128 + 16 * part;
                const f16* zp = (const f16*)(F.ws + WS_Z) + row * D + c; const f16* gp = (const f16*)(F.ws + WS_GAB) + row * 2048 + c;
                const float* na = inp(F, I_NORMA) + layer * 128 + 16 * part;
                const f16x8 z0 = *(const f16x8*)zp, z1 = *(const f16x8*)(zp + 8), g0 = *(const f16x8*)gp, g1 = *(const f16x8*)(gp + 8);
                float r_[16];
#pragma unroll
                for (int e = 0; e < 8; ++e) { r_[e] = v[e] * rstd * na[e] * siluf_((float)z0[e]) * (float)g0[e]; r_[8 + e] = v[8 + e] * rstd * na[8 + e] * siluf_((float)z1[e]) * (float)g1[e]; }
                f16* op = (f16*)(F.ws + WS_MAB) + row * 2048 + c;
                *(u32x4*)op = (u32x4){pk2h(r_[0], r_[1]), pk2h(r_[2], r_[3]), pk2h(r_[4], r_[5]), pk2h(r_[6], r_[7])};
                *(u32x4*)(op + 8) = (u32x4){pk2h(r_[8], r_[9]), pk2h(r_[10], r_[11]), pk2h(r_[12], r_[13]), pk2h(r_[14], r_[15])};
            }
        }
    }
#undef SC_STAGE
    if (cwv) {
        float* od = F.out + (samp ? OUT_DS + ((size_t)(layer * NSB + b) * NH + h) * DK * DK : OUT_DP + ((size_t)(layer * NB + b) * NH + h) * DK * DK);
#pragma unroll
        for (int t = 0; t < 4; ++t)
#pragma unroll
            for (int r = 0; r < 16; ++r) od[(32 * t + crow(r, hi)) * DK + 32 * w + r32] = S[t][r];
    }
    __syncthreads();
}

constexpr int AT_K0 = 0, AT_V0 = 32768, AT_BT = 65536, AT_XCH = 66560;
struct AttnTask { const f16* Q; const f16* K; const f16* V; const f16* G; f16* O; int q0, nqw, nkeys, ntiles, h; };

__device__ __forceinline__ void attn_task(Frame& F, const AttnTask& T, int layer) {
    LAS unsigned char* L = F.lds;
    int lane = F.lane, wave = F.wave; asm volatile("" : "+v"(lane), "+s"(wave));
    const int tid = wave * 64 + lane, r32 = lane & 31, hi = lane >> 5;
    const int map = wave >> 2, wq = wave & 3;
    const TrAddr TA = tr_addr(lane);
    const bool active = wq < T.nqw;
    const int qbase = T.q0 + 32 * wq, qpos = qbase + r32, cwv = qbase >> 6;
    const float* misc = (const float*)(F.ws + WS_MISC);
    LAS float* BT = (LAS float*)(L + AT_BT);
    if (tid < 256) BT[tid] = misc[64 + T.h * 256 + tid];
    f16x8 qf[4];
#pragma unroll
    for (int s = 0; s < 4; ++s) qf[s] = active ? *(const f16x8*)(T.Q + (size_t)qpos * D + map * 64 + 16 * s + 8 * hi) : f16x8{};
    const int srow0 = tid >> 4, srow1 = srow0 + 32, sch = tid & 15;
    const int kdo0 = srow0 * 256 + ((sch ^ (srow0 & 15)) << 4), kdo1 = srow1 * 256 + ((sch ^ (srow1 & 15)) << 4);
    const int vdo0 = vswz(srow0, sch), vdo1 = vswz(srow1, sch);
    u32x4 kr0, kr1, vr0, vr1;
#define AT_LOAD(j) do { const size_t o0_ = ((size_t)(64 * (j) + srow0)) * D + sch * 8, o1_ = o0_ + (size_t)32 * D; \
        kr0 = *(const u32x4*)(T.K + o0_); kr1 = *(const u32x4*)(T.K + o1_); vr0 = *(const u32x4*)(T.V + o0_); vr1 = *(const u32x4*)(T.V + o1_); } while (0)
#define AT_STORE(bufi) do { *(LAS u32x4*)(L + AT_K0 + (bufi) * 16384 + kdo0) = kr0; *(LAS u32x4*)(L + AT_K0 + (bufi) * 16384 + kdo1) = kr1; \
        *(LAS u32x4*)(L + AT_V0 + (bufi) * 16384 + vdo0) = vr0; *(LAS u32x4*)(L + AT_V0 + (bufi) * 16384 + vdo1) = vr1; } while (0)
    AT_LOAD(0); AT_STORE(0);
    __syncthreads();
    float m = -1e30f, lsum = 0.f;
    f32x16 o[4];
#pragma unroll
    for (int d = 0; d < 4; ++d) o[d] = f32x16{};
    const float cfar = misc[64 + T.h * 256];
    for (int j = 0; j < T.ntiles; ++j) {
        const bool more = j + 1 < T.ntiles;
        if (more) AT_LOAD(j + 1);
        if (active && j <= cwv) {
            const LAS unsigned char* kb = L + AT_K0 + (j & 1) * 16384;
            const LAS unsigned char* vb = L + AT_V0 + (j & 1) * 16384;
            const bool far = 64 * j + 191 <= qbase;
            f32x16 p0, p1;
            { const float ini = far ? cfar : 0.f;
#pragma unroll
              for (int r = 0; r < 16; ++r) { p0[r] = ini; p1[r] = ini; } }
#pragma unroll
            for (int s = 0; s < 4; ++s) {
                const int ko = ((map * 8 + 2 * s + hi) ^ (r32 & 15)) << 4;
                const f16x8 a0 = *(const LAS f16x8*)(kb + r32 * 256 + ko);
                const f16x8 a1 = *(const LAS f16x8*)(kb + (32 + r32) * 256 + ko);
                p0 = mfma32(a0, qf[s], p0); p1 = mfma32(a1, qf[s], p1);
            }
            if (!far) {
#pragma unroll
                for (int r = 0; r < 16; ++r) {
                    const int kp0 = 64 * j + crow(r, hi), kp1 = kp0 + 32;
                    int i0 = kp0 - qpos + 128, i1 = kp1 - qpos + 128; i0 = i0 < 0 ? 0 : i0; i1 = i1 < 0 ? 0 : i1;
                    p0[r] = kp0 < T.nkeys ? p0[r] + BT[i0] : -INFINITY;
                    p1[r] = kp1 < T.nkeys ? p1[r] + BT[i1] : -INFINITY;
                }
            }
            float mx = fmaxf(p0[0], p1[0]);
#pragma unroll
            for (int r = 1; r < 16; ++r) mx = fmaxf(mx, fmaxf(p0[r], p1[r]));
            mx = fmaxf(mx, __shfl_xor(mx, 32));
            const float mnew = fmaxf(m, mx);
            if (__any(mnew > m)) {
                const float alpha = exp2f(m - mnew);
#pragma unroll
                for (int d = 0; d < 4; ++d) o[d] = o[d] * alpha;
                lsum *= alpha;
            }
            m = mnew;
            float ps = 0.f;
#pragma unroll
            for (int r = 0; r < 16; ++r) { p0[r] = exp2f(p0[r] - m); p1[r] = exp2f(p1[r] - m); ps += p0[r] + p1[r]; }
            lsum += ps;
#pragma unroll
            for (int kb2 = 0; kb2 < 2; ++kb2)
#pragma unroll
                for (int sp = 0; sp < 2; ++sp) {
                    const f16x8 pf = cvt8(kb2 == 0 ? p0 : p1, 8 * sp);
#pragma unroll
                    for (int d = 0; d < 4; ++d) o[d] = mfma32(tr_frag(vb, TA, 32 * kb2 + 16 * sp, d), pf, o[d]);
                }
        }
        if (more) AT_STORE((j + 1) & 1);
        __syncthreads();
    }
#undef AT_LOAD
#undef AT_STORE
    lsum += __shfl_xor(lsum, 32);
    const float lam = misc[layer];
    const float scl = (map == 0 ? 1.0f : lam) / lsum;
    LAS float* XC = (LAS float*)(L + AT_XCH) + wq * 4096;
    if (active && map == 1) {
#pragma unroll
        for (int d = 0; d < 4; ++d)
#pragma unroll
            for (int r = 0; r < 16; ++r) XC[(d * 16 + r) * 64 + lane] = o[d][r] * scl;
    }
    __syncthreads();
    if (active && map == 0) {
        float ss = 0.f;
#pragma unroll
        for (int d = 0; d < 4; ++d)
#pragma unroll
            for (int r = 0; r < 16; ++r) { const float v = o[d][r] * scl - XC[(d * 16 + r) * 64 + lane]; o[d][r] = v; ss += v * v; }
        ss += __shfl_xor(ss, 32);
        const float lam_init = 0.8f - 0.6f * expf(-0.3f * (float)layer);
        const float rs = rsqrtf(ss * (1.0f / 128.0f) + LN_EPS) * (1.0f - lam_init);
        const float* sg = inp(F, I_SUBLN) + layer * 128;
        const f16* gp = T.G + (size_t)qpos * 2048; f16* op = T.O + (size_t)qpos * 2048;
#pragma unroll
        for (int d = 0; d < 4; ++d)
#pragma unroll
            for (int g4 = 0; g4 < 4; ++g4) {
                const int dv = 32 * d + 8 * g4 + 4 * hi;
                const f16x4 gg = *(const f16x4*)(gp + dv); const f32x4 s4 = *(const f32x4*)(sg + dv);
                u32x2 wv; wv.x = pk2h(o[d][4 * g4] * rs * s4[0] * (float)gg[0], o[d][4 * g4 + 1] * rs * s4[1] * (float)gg[1]);
                wv.y = pk2h(o[d][4 * g4 + 2] * rs * s4[2] * (float)gg[2], o[d][4 * g4 + 3] * rs * s4[3] * (float)gg[3]);
                *(u32x2*)(op + dv) = wv;
            }
    }
    __syncthreads();
}

#ifndef MK_PER_PHASE
#define MK_PER_PHASE 0
#endif
constexpr int N_PHASES = 2 + 8 * DEPTH;
constexpr int QN_SCANP = NB * NH, QN_ATTS = NSB * NH, QN_ATTP = NB * NH * 16, QN_SCANS = NSB * NH, QN_TOTAL = QN_SCANP + QN_ATTS + QN_ATTP + QN_SCANS;
struct Args { const float* in[27]; float* out; unsigned char* ws; int ph_lo, ph_hi; };

__global__ void __launch_bounds__(NWAVES * 64, 2) mk_fwd(Args args) {
    extern __shared__ __attribute__((aligned(16))) unsigned char lds[];
    Frame F;
    F.lds = (LAS unsigned char*)lds;
    F.MISC = (volatile LAS unsigned*)(F.lds + LDSCTL_OFF);
    F.tid = threadIdx.x; F.lane = F.tid & 63; F.wave = __builtin_amdgcn_readfirstlane(F.tid >> 6);
    F.G = gridDim.x; F.bx = blockIdx.x; { const int bx = blockIdx.x; F.vcu = (F.G % 8 == 0) ? (bx % 8) * (F.G / 8) + bx / 8 : bx; }
    F.out = args.out; F.ws = args.ws; F.ctl = (unsigned*)(args.ws + WS_CTL);
    for (int u = F.tid; u < 64; u += NWAVES * 64) ((LAS unsigned*)(F.lds + LDSCTL_OFF))[u] = 0u;
    if (F.tid < 27) ((LAS unsigned long long*)(F.lds + LDS_INP_OFF))[F.tid] = (unsigned long long)args.in[F.tid];
    __syncthreads();
    XcdBarrier bar; bar.bar = F.ctl + CW_BAR; bar.x = 0; bar.st = nullptr;
    if (!MK_PER_PHASE) bar = xcd_barrier_post(F.ctl + CW_BAR, F.MISC + 8);
    const int lo = args.ph_lo, hi = args.ph_hi;
#define IN(k) (lo <= (k) && (k) < hi)
#define SEAM(k) do { if (!MK_PER_PHASE && IN(k) && IN((k) + 1)) { XcdBarrier b2_ = bar; asm volatile("" : "+s"(b2_.bar)); b2_.bar = as_global(b2_.bar); xcd_barrier(b2_); } } while (0)

    if (IN(0)) {
#ifndef DIS_P0A
 { PHASE_FRAME(P); p0a_prologue(P); }
#endif
 }
    SEAM(0);
    if (IN(1)) { PHASE_FRAME(P); ln_phase(P, true, false, inp(P, I_LNG), inp(P, I_LNB), (const float*)(P.ws + WS_MOD), 0, 1024); }
    SEAM(1);

    for (int l = 0; l < DEPTH; ++l) {
        const int p = 2 + 8 * l;
        if (IN(p)) { asm volatile("; PHASE_MARK P1"); PHASE_FRAME(P);
            pg8::Gemm g{(const pg8::bf16_t*)(P.ws + WS_H), (const pg8::bf16_t*)(P.ws + WS_WIN) + (size_t)l * NPROJ * D, M, NPROJ, D};
            pg8::StaticOrder S; S.init(M, NPROJ, P.G, P.bx);
            EpiProj E{(f16*)(P.ws + WS_QKVA), (f16*)(P.ws + WS_Z), (f16*)(P.ws + WS_QB), (f16*)(P.ws + WS_KB), (f16*)(P.ws + WS_VB), (f16*)(P.ws + WS_GAB), (float*)(P.ws + WS_BG),
                      (f16*)(P.ws + WS_KS) + (size_t)l * NSB * KSROWS * D, (f16*)(P.ws + WS_VS) + (size_t)l * NSB * KSROWS * D, P.out, l};

#ifndef DIS_G1
 pg8::gemm_phase<EpiProj, pg8::StaticOrder, true, true>(P.lds, g, S, E);
#endif

        }
        SEAM(p);
        if (IN(p + 1)) { asm volatile("; PHASE_MARK P2"); PHASE_FRAME(P);
            for (int u = P.vcu; u < N_DUNITS; u += P.G) {
                D1Task T; int h;
                if (u < NB * NH * 32) { const int n = u & 31, bh = u >> 5; h = bh & 7; const int b = bh >> 3; T.row0 = b * SEQ + 64 * n; T.nvalid = 64; T.n = n; T.unit = u; T.hist = nullptr; }
                else { const int v = u - NB * NH * 32, sb = v >> 3; h = v & 7; T.row0 = MP + sb * SSEQ; T.nvalid = SSEQ; T.n = 0; T.unit = u; T.hist = inp(P, I_SCONV) + (size_t)(l * NSB + sb) * 3 * CONVC; }

#ifndef DIS_D1
 d1_unit(P, T, h, l);
#endif

            }
        }
        SEAM(p + 1);
        if (IN(p + 2)) { asm volatile("; PHASE_MARK P3"); PHASE_FRAME(P);
            unsigned* qh = P.ctl + CW_Q + 64 * l;
            for (;;) {
                if (P.tid == 0) P.MISC[0] = __hip_atomic_fetch_add(qh, 1u, __ATOMIC_RELAXED, __HIP_MEMORY_SCOPE_AGENT);
                __syncthreads();
                const int t = (int)P.MISC[0];
                __syncthreads();
                if (t >= QN_TOTAL) break;
                if (t < QN_SCANP) { asm volatile("; PHASE_MARK SCANP");
#ifndef DIS_SCAN
 scan_task(P, false, t >> 3, t & 7, l);
#endif
 }
                else if (t < QN_SCANP + QN_ATTS + QN_ATTP) {
                    asm volatile("; PHASE_MARK ATTN"); AttnTask A; const int t2 = t - QN_SCANP;
                    if (t2 < QN_ATTS) { const int sb = t2 >> 3, h = t2 & 7;
                        A.Q = (const f16*)(P.ws + WS_QB) + ((ptrdiff_t)(MP + sb * SSEQ) - PAST) * D + h * 128;
                        A.K = (const f16*)(P.ws + WS_KS) + ((size_t)(l * NSB + sb) * KSROWS) * D + h * 128; A.V = (const f16*)(P.ws + WS_VS) + ((size_t)(l * NSB + sb) * KSROWS) * D + h * 128;
                        A.G = (const f16*)(P.ws + WS_GAB) + ((ptrdiff_t)(MP + sb * SSEQ) - PAST) * 2048 + 1024 + h * 128; A.O = (f16*)(P.ws + WS_MAB) + ((ptrdiff_t)(MP + sb * SSEQ) - PAST) * 2048 + 1024 + h * 128;
                        A.q0 = PAST; A.nqw = 1; A.nkeys = PAST + SSEQ; A.ntiles = 33; A.h = h; }
                    else { const int t3 = t2 - QN_ATTS, qb = 15 - (t3 >> 7), bh = t3 & 127, b = bh >> 3, h = bh & 7;
                        A.Q = (const f16*)(P.ws + WS_QB) + (size_t)b * SEQ * D + h * 128; A.K = (const f16*)(P.ws + WS_KB) + (size_t)b * SEQ * D + h * 128; A.V = (const f16*)(P.ws + WS_VB) + (size_t)b * SEQ * D + h * 128;
                        A.G = (const f16*)(P.ws + WS_GAB) + (size_t)b * SEQ * 2048 + 1024 + h * 128; A.O = (f16*)(P.ws + WS_MAB) + (size_t)b * SEQ * 2048 + 1024 + h * 128;
                        A.q0 = 128 * qb; A.nqw = 4; A.nkeys = SEQ; A.ntiles = 2 * qb + 2; A.h = h; }

#ifndef DIS_ATT
 attn_task(P, A, l);
#endif

                } else { const int t2 = t - (QN_SCANP + QN_ATTS + QN_ATTP);
#ifndef DIS_SCAN
 scan_task(P, true, t2 >> 3, t2 & 7, l);
#endif
 }
            }
        }
        SEAM(p + 2);
        if (IN(p + 3)) { asm volatile("; PHASE_MARK P4"); PHASE_FRAME(P);
            pg8::Gemm g{(const pg8::bf16_t*)(P.ws + WS_MAB), (const pg8::bf16_t*)(P.ws + WS_WO2) + (size_t)l * D * 2048, M, D, 2048};
            pg8::StaticOrder S; S.init(M, D, P.G, P.bx);
            EpiRes E{(float*)(P.ws + WS_X), (const float*)(P.ws + WS_MOD) + (size_t)l * NBB * 6144 + 2048};

#ifndef DIS_G2
 pg8::gemm_phase<EpiRes, pg8::StaticOrder, true, true>(P.lds, g, S, E);
#endif

        }
        SEAM(p + 3);
        if (IN(p + 4)) { asm volatile("; PHASE_MARK P5"); PHASE_FRAME(P); ln_phase(P, false, false, inp(P, I_LN1G) + l * D, inp(P, I_LN1B) + l * D, (const float*)(P.ws + WS_MOD) + (size_t)l * NBB * 6144, 3072, 4096); }
        SEAM(p + 4);
        if (IN(p + 5)) { asm volatile("; PHASE_MARK P6"); PHASE_FRAME(P);
            pg8::Gemm g{(const pg8::bf16_t*)(P.ws + WS_H), (const pg8::bf16_t*)(P.ws + WS_WFI) + (size_t)l * 2 * DFF * D, M, 2 * DFF, D};
            pg8::StaticOrder S; S.init(M, 2 * DFF, P.G, P.bx);
            EpiSwiGLU E{(f16*)(P.ws + WS_ACT)};

#ifndef DIS_G3
 pg8::gemm_phase<EpiSwiGLU, pg8::StaticOrder, true, true>(P.lds, g, S, E);
#endif

        }
        SEAM(p + 5);
        if (IN(p + 6)) { asm volatile("; PHASE_MARK P7"); PHASE_FRAME(P);
            pg8::Gemm g{(const pg8::bf16_t*)(P.ws + WS_ACT), (const pg8::bf16_t*)(P.ws + WS_WFO) + (size_t)l * D * DFF, M, D, DFF};
            pg8::StaticOrder S; S.init(M, D, P.G, P.bx);
            EpiRes E{(float*)(P.ws + WS_X), (const float*)(P.ws + WS_MOD) + (size_t)l * NBB * 6144 + 5120};

#ifndef DIS_G2
 pg8::gemm_phase<EpiRes, pg8::StaticOrder, true, true>(P.lds, g, S, E);
#endif

        }
        SEAM(p + 6);
        if (IN(p + 7)) { asm volatile("; PHASE_MARK P8"); PHASE_FRAME(P); ln_phase(P, false, l == DEPTH - 1, inp(P, I_LN2G) + l * D, inp(P, I_LN2B) + l * D, (const float*)(P.ws + WS_MOD) + (size_t)(l == DEPTH - 1 ? l : l + 1) * NBB * 6144, 0, 1024); }
        SEAM(p + 7);
    }
#undef IN
#undef SEAM
}

extern "C" void kernel_launch(void* const* d_in, const int* in_sizes, int n_in, void* d_out, int out_size, void* d_ws, size_t ws_size, hipStream_t stream) {
    static int grid = 0;
    if (grid == 0) {
        if (n_in != 27 || (size_t)out_size != OUT_END || ws_size < WS_END) { fprintf(stderr, "kernel_launch: unexpected shapes (n_in %d, out %d, ws %zu)\n", n_in, out_size, ws_size); grid = -1; return; }
        int dev = 0, cus = 0, per_cu = 0;
        if (hipGetDevice(&dev) != hipSuccess || hipDeviceGetAttribute(&cus, hipDeviceAttributeMultiprocessorCount, dev) != hipSuccess) { grid = -1; return; }
        if (hipFuncSetAttribute((const void*)mk_fwd, hipFuncAttributeMaxDynamicSharedMemorySize, LDS_BYTES) != hipSuccess) { fprintf(stderr, "kernel_launch: hipFuncSetAttribute failed\n"); grid = -1; return; }
        if (hipOccupancyMaxActiveBlocksPerMultiprocessor(&per_cu, (const void*)mk_fwd, NWAVES * 64, LDS_BYTES) != hipSuccess || per_cu < 1) { fprintf(stderr, "kernel_launch: occupancy query reports %d\n", per_cu); }
        (void)hipGetLastError();
        grid = cus;
    }
    if (grid < 0) return;
    if (hipMemsetAsync((char*)d_ws + WS_CTL, 0, CTL_ZERO_BYTES, stream) != hipSuccess) return;
    Args a{};
    for (int i = 0; i < 27; ++i) a.in[i] = (const float*)d_in[i];
    a.out = (float*)d_out; a.ws = (unsigned char*)d_ws;
#if MK_PER_PHASE
    for (int p = 0; p < N_PHASES; ++p) { a.ph_lo = p; a.ph_hi = p + 1; hipLaunchKernelGGL(mk_fwd, dim3(grid), dim3(NWAVES * 64), LDS_BYTES, stream, a); }
#else
    a.ph_lo = 0; a.ph_hi = N_PHASES;
    hipLaunchKernelGGL(mk_fwd, dim3(grid), dim3(NWAVES * 64), LDS_BYTES, stream, a);
#endif
}
```

```cpp
#include <hip/hip_runtime.h>
#include <cstdio>
#include <cstdint>

#define LAS __attribute__((address_space(3)))
#define GAS __attribute__((address_space(1)))
typedef _Float16 f16;
typedef _Float16 f16x2 __attribute__((ext_vector_type(2)));
typedef _Float16 f16x4 __attribute__((ext_vector_type(4)));
typedef _Float16 f16x8 __attribute__((ext_vector_type(8)));
typedef float f32x2 __attribute__((ext_vector_type(2)));
typedef float f32x4 __attribute__((ext_vector_type(4)));
typedef float f32x16 __attribute__((ext_vector_type(16)));
typedef unsigned u32x2 __attribute__((ext_vector_type(2)));
typedef unsigned u32x4 __attribute__((ext_vector_type(4)));
typedef short v4i16_t __attribute__((ext_vector_type(4)));

constexpr int D = 1024, NB = 16, SEQ = 2048, MP = NB * SEQ, NSB = 8, SSEQ = 32, MS = NSB * SSEQ, M = MP + MS, PAST = 2048, DEPTH = 4;
constexpr int NH = 8, DK = 128, CONVC = 3072, DFF = 2816, DIN = 9232, NPROJ = 9472;
constexpr int KSROWS = 2112;
constexpr float LN_EPS = 1e-5f;
constexpr float ALPHA = 1.6817928305074290f;
constexpr float LOG2E = 1.4426950408889634f;
constexpr int NBB = NB + NSB;

constexpr size_t OUT_YP = 0;
constexpr size_t OUT_YS = OUT_YP + (size_t)MP * D;
constexpr size_t OUT_KP = OUT_YS + (size_t)MS * D;
constexpr size_t OUT_VP = OUT_KP + (size_t)DEPTH * MP * D;
constexpr size_t OUT_CP = OUT_VP + (size_t)DEPTH * MP * D;
constexpr size_t OUT_DP = OUT_CP + (size_t)DEPTH * NB * 3 * CONVC;
constexpr size_t OUT_KS = OUT_DP + (size_t)DEPTH * NB * NH * DK * DK;
constexpr size_t OUT_VS = OUT_KS + (size_t)DEPTH * MS * D;
constexpr size_t OUT_CS = OUT_VS + (size_t)DEPTH * MS * D;
constexpr size_t OUT_DS = OUT_CS + (size_t)DEPTH * NSB * 3 * CONVC;
constexpr size_t OUT_END = OUT_DS + (size_t)DEPTH * NSB * NH * DK * DK;

constexpr size_t MiB = 1u << 20;
constexpr size_t WS_CTL = 0, CTL_ZERO_BYTES = 1 * MiB;
constexpr size_t WS_MOD = 1 * MiB;
constexpr size_t WS_MISC = 4 * MiB;
constexpr size_t WS_WIN = 5 * MiB;
constexpr size_t WS_WO2 = WS_WIN + 74 * MiB;
constexpr size_t WS_WFI = WS_WO2 + 16 * MiB;
constexpr size_t WS_WFO = WS_WFI + 44 * MiB;
constexpr size_t WS_X = WS_WFO + 22 * MiB;
constexpr size_t WS_H = WS_X + 129 * MiB;
constexpr size_t WS_QKVA = WS_H + 65 * MiB;
constexpr size_t WS_Z = WS_QKVA + 194 * MiB;
constexpr size_t WS_QB = WS_Z + 65 * MiB;
constexpr size_t WS_KB = WS_QB + 65 * MiB;
constexpr size_t WS_VB = WS_KB + 65 * MiB;
constexpr size_t WS_GAB = WS_VB + 65 * MiB;
constexpr size_t WS_BG = WS_GAB + 129 * MiB;
constexpr size_t WS_MAB = WS_BG + 3 * MiB;
constexpr size_t WS_ACT = WS_MAB + 129 * MiB;
constexpr size_t WS_DIMG = WS_ACT + 178 * MiB;
constexpr size_t WS_KS = WS_DIMG + 293 * MiB;
constexpr size_t WS_VS = WS_KS + 132 * MiB;
constexpr size_t WS_PART = WS_VS + 132 * MiB;
constexpr size_t WS_END = WS_PART + 8 * MiB;
static_assert(WS_END <= 2048 * MiB, "d_ws map");
constexpr int DIMG_BYTES = 73728, IMG_WK = 0, IMG_QG = 16384, IMG_QK = 32768, IMG_KT = 40960, IMG_UV = 57344, IMG_STAGE = 57344;
constexpr int N_DUNITS = NB * NH * 32 + NSB * NH;
constexpr int CW_BAR = 4096;
constexpr int CW_Q = 16384;

constexpr int RING_BYTES = 155648;
constexpr int LDSCTL_OFF = RING_BYTES;
constexpr int LDS_BYTES = 159 * 1024;
constexpr int NWAVES = 8;

__device__ __forceinline__ unsigned pk2h(float lo, float hi) { f32x2 v = {lo, hi}; f16x2 h = __builtin_convertvector(v, f16x2); return __builtin_bit_cast(unsigned, h); }
__device__ __forceinline__ u32x4 pk8h(f32x4 a, f32x4 b) { u32x4 w; w.x = pk2h(a[0], a[1]); w.y = pk2h(a[2], a[3]); w.z = pk2h(b[0], b[1]); w.w = pk2h(b[2], b[3]); return w; }
__device__ __forceinline__ float sigmoidf_(float x) { return __builtin_amdgcn_rcpf(1.0f + __expf(-x)); }
__device__ __forceinline__ float siluf_(float x) { return x * __builtin_amdgcn_rcpf(1.0f + __expf(-x)); }
__device__ __forceinline__ int crow(int r, int hi) { return (r & 3) + 8 * (r >> 2) + 4 * hi; }
#define LDS_WAIT() asm volatile("s_waitcnt lgkmcnt(0)" ::: "memory")
#define VM_WAIT() asm volatile("s_waitcnt vmcnt(0)" ::: "memory")

namespace pg8 {
#define PG8_LAS __attribute__((address_space(3)))
typedef unsigned short bf16_t;
typedef _Float16 bf16x8 __attribute__((ext_vector_type(8)));
typedef float f32x4 __attribute__((ext_vector_type(4)));
typedef unsigned u32x4 __attribute__((ext_vector_type(4)));
constexpr int BM = 256, BK = 64, HALF = 128, HTB = HALF * BK * 2  , STAGE_BYTES = 8 * HTB, NXCD = 8, WGM = 8;

__host__ __device__ __forceinline__ int lds_byte(int r, int c) { const int st = (r >> 4) * 2 + (c >> 5), rr = r & 15, cc = c & 31, ob = rr * 64 + cc * 2; return st * 1024 + (ob ^ (((ob >> 9) & 1) << 5)); }
__host__ __device__ __forceinline__ void stage_rc(int b, int& R, int& C) { const int st = b / 1024, sb = b % 1024, swz = sb ^ (((sb >> 9) & 1) << 5); R = (st >> 1) * 16 + swz / 64; C = (st & 1) * 32 + (swz % 64) / 2; }
__host__ __device__ __forceinline__ int perm32(int rho) { const int n = rho >> 4, i = rho & 15; return 8 * (i >> 2) + 4 * n + (i & 3); }

struct Unit { int pm, pn; };
struct Gemm { const bf16_t* A; const bf16_t* Bt; int M, N, K; };

struct StaticOrder {
    int nM, nN, nwg, G, c, rot = 0;
    __host__ __device__ void init(int M, int N, int G_, int c_) { nM = M / BM; nN = N / BM; nwg = nM * nN; G = G_; c = c_; }
    __host__ __device__ bool next(int i, Unit& u) const {
        const long L = (long)i * G + c; if (L >= nwg) return false;
        int wgid = (int)L; { const int q = nwg / NXCD, r = nwg % NXCD, xcd = wgid % NXCD; int off = wgid / NXCD; if (rot) off = (off + xcd * rot) % (q + (xcd < r ? 1 : 0)); wgid = (xcd < r ? xcd * (q + 1) : r * (q + 1) + (xcd - r) * q) + off; }
        const int nig = WGM * nN, gid = wgid / nig, fm = gid * WGM, gsz = (nM - fm) < WGM ? (nM - fm) : WGM;
        u.pm = fm + ((wgid % nig) % gsz); u.pn = (wgid % nig) / gsz; return true;
    }
    __device__ __forceinline__ void a_ready(const Unit&) const {}
    __device__ __forceinline__ void done(const Unit&) const {}
};
template <class Epi, class Sched, bool ALIGN_EPI = false, bool SP2 = false>
__device__ __forceinline__ void gemm_phase(PG8_LAS unsigned char* lds, const Gemm g, const Sched& S, const Epi& E, int tid_in) {
    int tid_ = tid_in; asm volatile("" : "+v"(tid_));
    const int tid = tid_, wid = __builtin_amdgcn_readfirstlane(tid >> 6), lane = tid & 63, wr = wid >> 2, wc = wid & 3, fr = lane & 15, fq = lane >> 4;
    const int K = g.K, nt = K / BK;
    unsigned voffA[2], voffB[2];
#pragma unroll
    for (int i = 0; i < 2; ++i) { int R, C; stage_rc(tid * 16 + i * 8192, R, C); const int Rb = Epi::PERM ? ((R & ~31) + perm32(R & 31)) : R;
        voffA[i] = (unsigned)(R * K + C) * 2u; voffB[i] = (unsigned)(Rb * K + C) * 2u; }
    const size_t kstep = (size_t)(BK * 2);
    const size_t hstep = (size_t)HALF * K * 2;
    const size_t tstep = 2 * hstep;
    const unsigned ldsw = (unsigned)wid * 1024u;
    const int aoff = lds_byte(wr * 64 + fr, fq * 8), boff = lds_byte(wc * 32 + fr, fq * 8);
#define PG8_SA(b, h) (((b) * 2 + (h)) * HTB)
#define PG8_SB(b, h) ((4 + (b) * 2 + (h)) * HTB)
#define PG8_STAGE(bufoff, gbase, voff) do { _Pragma("unroll") for (int _i = 0; _i < 2; ++_i) \
        __builtin_amdgcn_global_load_lds((const unsigned*)((const char*)(gbase) + (voff)[_i]), (PG8_LAS unsigned*)(lds + (bufoff) + ldsw + _i * 8192), 16, 0, 0); } while (0)
#define PG8_LDA(dst, b, h) do { _Pragma("unroll") for (int m = 0; m < 4; ++m) _Pragma("unroll") for (int k = 0; k < 2; ++k) dst[m][k] = *(const PG8_LAS bf16x8*)(lds + PG8_SA(b, h) + aoff + m * 2048 + k * 1024); } while (0)
#define PG8_LDB(dst, b, h) do { _Pragma("unroll") for (int n = 0; n < 2; ++n) _Pragma("unroll") for (int k = 0; k < 2; ++k) dst[n][k] = *(const PG8_LAS bf16x8*)(lds + PG8_SB(b, h) + boff + n * 2048 + k * 1024); } while (0)
#define PG8_MMA(ai, bj, At, Bt) do { __builtin_amdgcn_s_setprio(1); _Pragma("unroll") for (int m = 0; m < 4; ++m) _Pragma("unroll") for (int n = 0; n < 2; ++n) _Pragma("unroll") for (int k = 0; k < 2; ++k) \
        acc[ai][bj][m][n] = __builtin_amdgcn_mfma_f32_16x16x32_f16(Bt[n][k], At[m][k], acc[ai][bj][m][n], 0, 0, 0); __builtin_amdgcn_s_setprio(0); } while (0)
#define PG8_WAIT_V(n) asm volatile("s_waitcnt vmcnt(" #n ")" ::: "memory")
#define PG8_WAIT_L(n) asm volatile("s_waitcnt lgkmcnt(" #n ")" ::: "memory")
#define PG8_BAR __builtin_amdgcn_s_barrier()
#define PG8_SCHED __builtin_amdgcn_sched_barrier(0)
    Unit cur, nxt; int ui = 0;
    if (!S.next(0, cur)) return;
    f32x4 acc[2][2][4][2];
#pragma unroll
    for (int a = 0; a < 2; ++a)
#pragma unroll
        for (int b = 0; b < 2; ++b)
#pragma unroll
            for (int m = 0; m < 4; ++m)
#pragma unroll
                for (int n = 0; n < 2; ++n) acc[a][b][m][n] = (f32x4){0.f, 0.f, 0.f, 0.f};
    bf16x8 At[4][2], B0[2][2], B1[2][2];
    const char* cA = (const char*)g.A + (size_t)cur.pm * tstep; const char* cB = (const char*)g.Bt + (size_t)cur.pn * tstep;
    S.a_ready(cur);
    if constexpr (SP2) {
        PG8_STAGE(PG8_SB(0, 0), cB, voffB); PG8_STAGE(PG8_SB(0, 1), cB + hstep, voffB); PG8_STAGE(PG8_SA(0, 0), cA, voffA); PG8_STAGE(PG8_SA(0, 1), cA + hstep, voffA);
        if (wr == 1) PG8_BAR;
        PG8_WAIT_V(2); PG8_BAR;
        PG8_STAGE(PG8_SB(1, 0), cB + kstep, voffB); PG8_STAGE(PG8_SA(1, 0), cA + kstep, voffA); PG8_STAGE(PG8_SB(1, 1), cB + hstep + kstep, voffB);
        PG8_WAIT_V(6); PG8_BAR;
    } else {
        PG8_STAGE(PG8_SB(0, 0), cB, voffB); PG8_STAGE(PG8_SA(0, 0), cA, voffA); PG8_STAGE(PG8_SB(0, 1), cB + hstep, voffB); PG8_STAGE(PG8_SA(0, 1), cA + hstep, voffA);
        if (wr == 1) PG8_BAR;
        PG8_WAIT_V(4); PG8_BAR;
        PG8_STAGE(PG8_SB(1, 0), cB + kstep, voffB); PG8_STAGE(PG8_SA(1, 0), cA + kstep, voffA); PG8_STAGE(PG8_SB(1, 1), cB + hstep + kstep, voffB);
        PG8_WAIT_V(6); PG8_BAR;
    }
    for (;;) {
        const bool has_next = S.next(ui + 1, nxt);
        const char* nA = has_next ? (const char*)g.A + (size_t)nxt.pm * tstep : cA; const char* nB = has_next ? (const char*)g.Bt + (size_t)nxt.pn * tstep : cB;
        for (int t = 0; t < nt; t += 2) {
            const bool last = (t == nt - 2);
            const char* a1 = cA + (size_t)(t + 1) * kstep;
            const char* a2 = last ? nA : cA + (size_t)(t + 2) * kstep; const char* b2 = last ? nB : cB + (size_t)(t + 2) * kstep;
            const char* a3 = a2 + kstep; const char* b3 = b2 + kstep;
            if (last && has_next) S.a_ready(nxt);
            if constexpr (SP2) {
            PG8_LDB(B0, 0, 0); PG8_LDB(B1, 0, 1); PG8_SCHED; PG8_LDA(At, 0, 0); PG8_STAGE(PG8_SA(1, 1), a1 + hstep, voffA);
            PG8_WAIT_V(8); PG8_WAIT_L(0); PG8_BAR; PG8_MMA(0, 0, At, B0); PG8_MMA(0, 1, At, B1); PG8_BAR; PG8_SCHED;
            PG8_LDA(At, 0, 1); PG8_STAGE(PG8_SB(0, 0), b2, voffB); PG8_STAGE(PG8_SB(0, 1), b2 + hstep, voffB); PG8_STAGE(PG8_SA(0, 0), a2, voffA);
            PG8_WAIT_V(8); PG8_WAIT_L(0); PG8_BAR; PG8_MMA(1, 0, At, B0); PG8_MMA(1, 1, At, B1); PG8_BAR; PG8_SCHED;
            PG8_LDB(B0, 1, 0); PG8_LDB(B1, 1, 1); PG8_SCHED; PG8_LDA(At, 1, 0); PG8_STAGE(PG8_SA(0, 1), a2 + hstep, voffA);
            PG8_WAIT_V(8); PG8_WAIT_L(0); PG8_BAR; PG8_MMA(0, 0, At, B0); PG8_MMA(0, 1, At, B1); PG8_BAR; PG8_SCHED;
            PG8_LDA(At, 1, 1); PG8_STAGE(PG8_SB(1, 0), b3, voffB); PG8_STAGE(PG8_SB(1, 1), b3 + hstep, voffB); PG8_STAGE(PG8_SA(1, 0), a3, voffA);
            PG8_WAIT_V(8); PG8_WAIT_L(0); PG8_BAR; PG8_MMA(1, 0, At, B0); PG8_MMA(1, 1, At, B1); PG8_BAR; PG8_SCHED;
            } else {
            PG8_LDB(B0, 0, 0); PG8_SCHED; PG8_LDA(At, 0, 0); PG8_STAGE(PG8_SA(1, 1), a1 + hstep, voffA);
            PG8_WAIT_L(8); PG8_BAR; PG8_WAIT_L(0); PG8_MMA(0, 0, At, B0); PG8_BAR; PG8_SCHED;
            PG8_LDB(B1, 0, 1); PG8_STAGE(PG8_SB(0, 0), b2, voffB);
            PG8_BAR; PG8_WAIT_L(0); PG8_MMA(0, 1, At, B1); PG8_BAR;
            PG8_LDA(At, 0, 1); PG8_STAGE(PG8_SA(0, 0), a2, voffA);
            PG8_BAR; PG8_WAIT_L(0); PG8_MMA(1, 0, At, B0); PG8_BAR; PG8_SCHED;
            PG8_STAGE(PG8_SB(0, 1), b2 + hstep, voffB);
            PG8_WAIT_V(6); PG8_BAR; PG8_MMA(1, 1, At, B1); PG8_BAR;
            PG8_LDB(B0, 1, 0); PG8_SCHED; PG8_LDA(At, 1, 0); PG8_STAGE(PG8_SA(0, 1), a2 + hstep, voffA);
            PG8_WAIT_L(8); PG8_BAR; PG8_WAIT_L(0); PG8_MMA(0, 0, At, B0); PG8_BAR; PG8_SCHED;
            PG8_LDB(B1, 1, 1); PG8_STAGE(PG8_SB(1, 0), b3, voffB);
            PG8_BAR; PG8_WAIT_L(0); PG8_MMA(0, 1, At, B1); PG8_BAR;
            PG8_LDA(At, 1, 1); PG8_STAGE(PG8_SA(1, 0), a3, voffA);
            PG8_BAR; PG8_WAIT_L(0); PG8_MMA(1, 0, At, B0); PG8_BAR; PG8_SCHED;
            PG8_STAGE(PG8_SB(1, 1), b3 + hstep, voffB);
            PG8_WAIT_V(6); PG8_BAR; PG8_MMA(1, 1, At, B1); PG8_BAR;
            }
        }
        if constexpr (ALIGN_EPI) { if (wr == 0) PG8_BAR; }
        if constexpr (!Epi::AFTER_DRAIN) { E(acc, cur, wr, wc, fr, fq); S.done(cur); }
        if (!has_next) break;
#pragma unroll
        for (int a = 0; a < 2; ++a)
#pragma unroll
            for (int b = 0; b < 2; ++b)
#pragma unroll
                for (int m = 0; m < 4; ++m)
#pragma unroll
                    for (int n = 0; n < 2; ++n) acc[a][b][m][n] = (f32x4){0.f, 0.f, 0.f, 0.f};
        cur = nxt; cA = nA; cB = nB; ++ui;
        if constexpr (ALIGN_EPI) { if (wr == 1) PG8_BAR; }
    }
    PG8_WAIT_V(0);
    if constexpr (!ALIGN_EPI) { if (wr == 0) PG8_BAR; }
    PG8_BAR;
    if constexpr (Epi::AFTER_DRAIN) { E.fused(acc, cur, wr, wc, fr, fq, lds, wid, lane); S.done(cur); }
#undef PG8_SA
#undef PG8_SB
#undef PG8_STAGE
#undef PG8_LDA
#undef PG8_LDB
#undef PG8_MMA
#undef PG8_WAIT_V
#undef PG8_WAIT_L
#undef PG8_BAR
#undef PG8_SCHED
}
}

#define XB_TMO      128
#define XB_XCNT(j)  (256  + 64 * (j))
#define XB_XSUB(j)  (1280 + 64 * (j))
#define XB_XGEN(j)  (2304 + 64 * (j))
#define XB_TOP      3328
#define XB_TOPGEN   3392
#define XCD_BAR_WORDS 3456
#define XB_SPIN_CAP (1u << 18)

__device__ __forceinline__ unsigned xb_ld(unsigned* p)              { return __hip_atomic_load(p, __ATOMIC_RELAXED, __HIP_MEMORY_SCOPE_AGENT); }
__device__ __forceinline__ unsigned xb_add(unsigned* p, unsigned v) { return __hip_atomic_fetch_add(p, v, __ATOMIC_RELAXED, __HIP_MEMORY_SCOPE_AGENT); }
__device__ __forceinline__ unsigned xb_xcc_id() { return (unsigned)__builtin_amdgcn_s_getreg((3 << 11) | 20) & 0xFu; }
#define XB_SPIN(cond, bar) do { unsigned _sp = 0; while (cond) { __builtin_amdgcn_s_sleep(1); \
    if ((++_sp & 255u) == 0u) { if (xb_ld(&(bar)[XB_TMO])) break; if (_sp > XB_SPIN_CAP) { atomicAdd(&(bar)[XB_TMO], 1u); break; } } } } while (0)

struct XcdBarrier {
    unsigned* bar; unsigned x;
    volatile LAS unsigned* st;
};

__device__ __forceinline__ XcdBarrier xcd_barrier_post(unsigned* bar, volatile LAS unsigned* st) {
    XcdBarrier b; b.bar = bar; b.x = xb_xcc_id(); b.st = st;
    if (threadIdx.x == 0) (void)xb_add(&bar[XB_XCNT(b.x)], 1u);
    return b;
}
__device__ __forceinline__ void xcd_barrier_complete(unsigned* bar, unsigned x, unsigned& nloc, unsigned& nx) {
    const unsigned G = gridDim.x * gridDim.y * gridDim.z;
    unsigned sum, cnt, mine, sp = 0u;
    for (;;) {
        sum = 0u; cnt = 0u; mine = 0u;
#pragma unroll
        for (unsigned j = 0; j < 16; ++j) { const unsigned c = xb_ld(&bar[XB_XCNT(j)]); sum += c; cnt += (c > 0u) ? 1u : 0u; mine = (j == x) ? c : mine; }
        if (sum == G) break;
        __builtin_amdgcn_s_sleep(1);
        if ((++sp & 255u) == 0u) { if (xb_ld(&bar[XB_TMO])) break; if (sp > XB_SPIN_CAP) { atomicAdd(&bar[XB_TMO], 1u); break; } }
    }
    nloc = mine > 0u ? mine : 1u; nx = cnt > 0u ? cnt : 1u;
}

__device__ __forceinline__ void xcd_barrier(const XcdBarrier& b) {
    asm volatile("s_waitcnt vmcnt(0)" ::: "memory");
    __syncthreads();
    if (threadIdx.x == 0) {
        unsigned* bar = b.bar;
        __builtin_amdgcn_s_waitcnt(0);
        unsigned nloc = b.st[0], nx = b.st[1];
        if (nloc == 0u) { xcd_barrier_complete(bar, b.x, nloc, nx); b.st[0] = nloc; b.st[1] = nx; }
        const unsigned old = xb_add(&bar[XB_XSUB(b.x)], 1u);
        const unsigned gen = old / nloc;
        if (old + 1u == (gen + 1u) * nloc) {
            __builtin_amdgcn_fence(__ATOMIC_RELEASE, "agent");
            asm volatile("s_waitcnt vmcnt(0)" ::: "memory");
            const unsigned og = xb_add(&bar[XB_TOP], 1u);
            const unsigned tg = og / nx;
            if (og + 1u == (tg + 1u) * nx) xb_add(&bar[XB_TOPGEN], 1u);
            else XB_SPIN(xb_ld(&bar[XB_TOPGEN]) == tg, bar);
            __builtin_amdgcn_fence(__ATOMIC_ACQUIRE, "agent");
            xb_add(&bar[XB_XGEN(b.x)], 1u);
            asm volatile("s_waitcnt vmcnt(0)" ::: "memory");
        } else {
            XB_SPIN(xb_ld(&bar[XB_XGEN(b.x)]) == gen, bar);
            __builtin_amdgcn_fence(__ATOMIC_ACQUIRE, "agent");
            asm volatile("s_waitcnt vmcnt(0)" ::: "memory");
        }
    }
    __syncthreads();
}


struct Frame {
    LAS unsigned char* lds;
    volatile LAS unsigned* MISC;
    unsigned* ctl;
    int tid, lane, wave, vcu, G, bx;
    float* out;
    unsigned char* ws;
};
enum { I_XP = 0, I_XS, I_CK, I_CV, I_SCONV, I_SDELTA, I_CP, I_CS, I_LNG, I_LNB, I_RELB, I_WADA, I_BADA, I_WIN, I_CONVW, I_ALOG, I_DTB, I_NORMA, I_LAM, I_SUBLN, I_WO, I_LN1G, I_LN1B, I_WFI, I_WFO, I_LN2G, I_LN2B };

constexpr int LDS_INP_OFF = LDSCTL_OFF + 256;
__device__ __forceinline__ const float* inp(const Frame& F, int i) {
    const unsigned long long v = *((volatile LAS unsigned long long*)(F.lds + LDS_INP_OFF) + i);
    const unsigned lo = __builtin_amdgcn_readfirstlane((unsigned)v), hi = __builtin_amdgcn_readfirstlane((unsigned)(v >> 32));
    return (const float*)(const GAS float*)(((unsigned long long)hi << 32) | lo);
}
template <class T> __device__ __forceinline__ T* as_global(T* p) { return (T*)(GAS T*)(unsigned long long)p; }
__device__ __forceinline__ int hw_lane() { int l; asm volatile("v_mbcnt_lo_u32_b32 %0, -1, 0\n\tv_mbcnt_hi_u32_b32 %0, -1, %0" : "=v"(l)); return l; }
#define PHASE_FRAME(P) Frame P = F; P.lane = hw_lane(); \
    asm volatile("" : "+s"(P.ws), "+s"(P.out), "+s"(P.ctl), "+s"(P.G), "+s"(P.vcu), "+s"(P.bx), "+s"(P.wave)); P.tid = P.wave * 64 + P.lane; \
    P.ws = as_global(P.ws); P.out = as_global(P.out); P.ctl = as_global(P.ctl)
__device__ __forceinline__ unsigned char* ws_of(const Frame& F) { unsigned char* w = F.ws; asm volatile("" : "+s"(w)); return as_global(w); }
__device__ __forceinline__ float wave_sum(float v) {
#pragma unroll
    for (int o = 1; o < 64; o <<= 1) v += __shfl_xor(v, o);
    return v;
}
__device__ __forceinline__ f32x16 mfma32(f16x8 a, f16x8 b, f32x16 c) { return __builtin_amdgcn_mfma_f32_32x32x16_f16(a, b, c, 0, 0, 0); }
__device__ __forceinline__ f16x8 cvt8(const f32x16& v, int o) {
    u32x4 w; w.x = pk2h(v[o], v[o + 1]); w.y = pk2h(v[o + 2], v[o + 3]); w.z = pk2h(v[o + 4], v[o + 5]); w.w = pk2h(v[o + 6], v[o + 7]); return __builtin_bit_cast(f16x8, w);
}

__device__ __forceinline__ int bb_of_row(int row) { return row < MP ? (row >> 11) : NB + ((row - MP) >> 5); }

#define EPI_ROWS(BODY) _Pragma("unroll") for (int ai = 0; ai < 2; ++ai) _Pragma("unroll") for (int m = 0; m < 4; ++m) { const int row = u.pm * 256 + ai * 128 + wr * 64 + m * 16 + fr; \
        _Pragma("unroll") for (int bj = 0; bj < 2; ++bj) { const int c = cb0 + bj * 128; const f32x4 v0 = acc[ai][bj][m][0], v1 = acc[ai][bj][m][1]; BODY } }
struct EpiProj {
    static constexpr bool PERM = true, AFTER_DRAIN = false;
    f16 *QKVA, *Z, *QB, *KB, *VB, *GAB; float* BG; f16 *KS, *VS; float* out; int layer;
    __device__ __forceinline__ void operator()(const f32x4 (&acc)[2][2][4][2], const pg8::Unit& u, int wr, int wc, int fr, int fq) const {
        asm volatile("" : "+v"(fr), "+v"(fq));
        const int pn = u.pn; const bool samp = u.pm == MP / 256;
        const int cb0 = (pn * 256 + wc * 32 + 8 * fq) - (pn < 12 ? 0 : pn < 24 ? 5120 : pn < 28 ? 6144 : pn < 32 ? 7168 : pn < 36 ? 8192 : 9216);
        if (pn < 12) {
            EPI_ROWS( *(u32x4*)(QKVA + (size_t)row * CONVC + c) = pk8h(v0, v1);
                      const int t = samp ? ((row - MP) & 31) - 29 : (row & 2047) - 2045;
                      if (t >= 0) { float* o = out + (samp ? OUT_CS + ((size_t)(layer * NSB + ((row - MP) >> 5)) * 3 + t) * CONVC : OUT_CP + ((size_t)(layer * NB + (row >> 11)) * 3 + t) * CONVC) + c;
                                    __builtin_nontemporal_store(v0, (f32x4*)o); __builtin_nontemporal_store(v1, (f32x4*)(o + 4)); } )
        } else if (pn < 20) {
            _Pragma("unroll") for (int ai = 0; ai < 2; ++ai) _Pragma("unroll") for (int m = 0; m < 4; ++m) { const int row = u.pm * 256 + ai * 128 + wr * 64 + m * 16 + fr;
                f32x4 a0, a1;
                _Pragma("unroll") for (int i = 0; i < 4; ++i) { a0[i] = siluf_(acc[ai][0][m][0][i]) * sigmoidf_(acc[ai][1][m][0][i]); a1[i] = siluf_(acc[ai][0][m][1][i]) * sigmoidf_(acc[ai][1][m][1][i]); }
                *(u32x4*)(Z + (size_t)row * D + (pn - 12) * 128 + wc * 32 + 8 * fq) = pk8h(a0, a1); }
        } else if (pn < 24) {
            const float sc = 0.125f * LOG2E;
            EPI_ROWS( *(u32x4*)(QB + (size_t)row * D + c) = pk8h(v0 * sc, v1 * sc); )
        } else if (pn < 32) {
            const bool isk = pn < 28;
            if (!samp) { f16* dst = isk ? KB : VB;
                EPI_ROWS( *(u32x4*)(dst + (size_t)row * D + c) = pk8h(v0, v1); )
            } else { f16* dst = isk ? KS : VS; float* ob = out + (isk ? OUT_KS : OUT_VS) + (size_t)layer * MS * D;
                EPI_ROWS( const int sr = row - MP; *(u32x4*)(dst + ((size_t)(sr >> 5) * KSROWS + PAST + (sr & 31)) * D + c) = pk8h(v0, v1); float* o = ob + (size_t)sr * D + c; __builtin_nontemporal_store(v0, (f32x4*)o); __builtin_nontemporal_store(v1, (f32x4*)(o + 4)); )
            }
        } else if (pn < 36) {
            EPI_ROWS( f32x4 s0; f32x4 s1;
                      _Pragma("unroll") for (int i = 0; i < 4; ++i) { s0[i] = sigmoidf_(v0[i]); s1[i] = sigmoidf_(v1[i]); }
                      *(u32x4*)(GAB + (size_t)row * D + c) = pk8h(s0, s1); )
        } else {
            if (wc == 0 && fq < 2) {
                EPI_ROWS( if (bj == 0) { *(f32x4*)(BG + (size_t)row * 16 + c) = v0; *(f32x4*)(BG + (size_t)row * 16 + c + 4) = v1; } )
            }
        }
    }
};
#undef EPI_ROWS
struct EpiRes {
    static constexpr bool PERM = false, AFTER_DRAIN = false;
    f16* X; const float* gate;
    __device__ __forceinline__ void operator()(const f32x4 (&acc)[2][2][4][2], const pg8::Unit& u, int wr, int wc, int fr, int fq) const {
        asm volatile("" : "+v"(fr), "+v"(fq));
#pragma unroll
        for (int ai = 0; ai < 2; ++ai)
#pragma unroll
            for (int m = 0; m < 4; ++m) {
                const int row = u.pm * 256 + ai * 128 + wr * 64 + m * 16 + fr;
                const float* gp = gate + (size_t)bb_of_row(row) * 6144; f16* xp = X + (size_t)row * D;
#pragma unroll
                for (int bj = 0; bj < 2; ++bj)
#pragma unroll
                    for (int n = 0; n < 2; ++n) {
                        const int c = u.pn * 256 + bj * 128 + wc * 32 + n * 16 + 4 * fq;
                        const f32x4 g = *(const f32x4*)(gp + c); const f16x4 xh = *(const f16x4*)(xp + c);
                        const f32x4 x = (f32x4){(float)xh[0], (float)xh[1], (float)xh[2], (float)xh[3]} * ALPHA + g * acc[ai][bj][m][n];
                        u32x2 w; w.x = pk2h(x[0], x[1]); w.y = pk2h(x[2], x[3]); *(u32x2*)(xp + c) = w;
                    }
                asm volatile("" ::: "memory");
            }
    }
};
struct EpiSwiGLU {
    static constexpr bool PERM = true, AFTER_DRAIN = false;
    f16* ACT;
    __device__ __forceinline__ void operator()(const f32x4 (&acc)[2][2][4][2], const pg8::Unit& u, int wr, int wc, int fr, int fq) const {
        asm volatile("" : "+v"(fr), "+v"(fq));
#pragma unroll
        for (int ai = 0; ai < 2; ++ai)
#pragma unroll
            for (int m = 0; m < 4; ++m) {
                const int row = u.pm * 256 + ai * 128 + wr * 64 + m * 16 + fr;
                f32x4 a0, a1;
#pragma unroll
                for (int i = 0; i < 4; ++i) { a0[i] = siluf_(acc[ai][0][m][0][i]) * acc[ai][1][m][0][i]; a1[i] = siluf_(acc[ai][0][m][1][i]) * acc[ai][1][m][1][i]; }
                *(u32x4*)(ACT + (size_t)row * DFF + u.pn * 128 + wc * 32 + 8 * fq) = pk8h(a0, a1);
            }
    }
};

__device__ __forceinline__ void cache_slice_load(Frame& F, int layer, int k, f32x4 (&v)[4]) {
#pragma unroll
    for (int j = 0; j < 2; ++j) {
        const size_t c = (size_t)F.vcu * 16384 + (size_t)k * 1024 + F.tid + 512 * j;
        const bool isv = c >= (size_t)NSB * PAST * D / 8; const size_t cc = isv ? c - (size_t)NSB * PAST * D / 8 : c;
        const float* src = inp(F, isv ? I_CV : I_CK) + (size_t)layer * NSB * PAST * D + cc * 8;
        v[2 * j] = *(const f32x4*)src; v[2 * j + 1] = *(const f32x4*)(src + 4);
    }
}
__device__ __forceinline__ void cache_slice_store(Frame& F, int layer, int k, const f32x4 (&v)[4]) {
#pragma unroll
    for (int j = 0; j < 2; ++j) {
        const size_t c = (size_t)F.vcu * 16384 + (size_t)k * 1024 + F.tid + 512 * j;
        const bool isv = c >= (size_t)NSB * PAST * D / 8; const size_t cc = isv ? c - (size_t)NSB * PAST * D / 8 : c;
        const size_t sb = cc / (PAST * D / 8), rem = cc % (PAST * D / 8);
        f16* dst = (f16*)(F.ws + (isv ? WS_VS : WS_KS)) + ((size_t)layer * NSB + sb) * KSROWS * D + rem * 8;
        *(u32x4*)dst = pk8h(v[2 * j], v[2 * j + 1]);
    }
}

template <int NSTEP  > __device__ __forceinline__ void thin_gemm(Frame& F, const f16* A, int lda, const f16* Bt, int K) {
    const int w = F.vcu * NWAVES + F.wave; if (w >= 2048) return;
    const int rb = w & 7, cg = (w >> 3) & 31, ks = w >> 8, r32 = F.lane & 31, hi = F.lane >> 5;
    const f16* ap = A + (size_t)(32 * rb + r32) * lda + ks * (16 * NSTEP) + 8 * hi;
    const f16* bp = Bt + (size_t)(32 * cg + r32) * K + ks * (16 * NSTEP) + 8 * hi;
    f32x16 acc = {};
    constexpr int HB = NSTEP / 2;
#pragma unroll
    for (int h0 = 0; h0 < NSTEP; h0 += HB) {
        f16x8 av[HB], bv[HB];
#pragma unroll
        for (int s = 0; s < HB; ++s) { av[s] = *(const f16x8*)(ap + 16 * (h0 + s)); bv[s] = *(const f16x8*)(bp + 16 * (h0 + s)); }
#pragma unroll
        for (int s = 0; s < HB; ++s) acc = mfma32(av[s], bv[s], acc);
    }
    float* pp = (float*)(F.ws + WS_PART) + ((size_t)ks * MS + 32 * rb) * D + 32 * cg + r32;
#pragma unroll
    for (int r = 0; r < 16; ++r) pp[(size_t)crow(r, hi) * D] = acc[r];
}

__device__ __forceinline__ int win_src_col(int d) {
    if (d < 3072) return d;
    if (d < 5120) { const int t = (d - 3072) >> 8, j = (d - 3072) & 255; return j < 128 ? 3072 + 128 * t + j : 7184 + 128 * t + (j - 128); }
    if (d < 8192) return d - 5120 + 4112;
    if (d < 9216) return d - 8192 + 8208;
    if (d < 9232) return d - 9216 + 4096;
    return -1;
}
__device__ __forceinline__ int wfi_src_col(int d) { const int t = d >> 8, w = d & 255; return w < 128 ? 128 * t + w : DFF + 128 * t + (w - 128); }
__device__ __forceinline__ void transpose_item(const float* W, int ldw, int ksrc0, int srccol, f16* WT, int ldwt, int drow0, int kdst0, LAS float* scr, int lane) {
#pragma unroll 8
    for (int i = 0; i < 32; ++i) { const int kk = 2 * i + (lane >> 5); scr[kk * 33 + (lane & 31)] = srccol >= 0 ? W[(size_t)(ksrc0 + kk) * ldw + srccol] : 0.f; }
    LDS_WAIT(); asm volatile("" ::: "memory");
    const int c = lane & 7;
#pragma unroll
    for (int j = 0; j < 4; ++j) { const int n = (lane >> 3) + 8 * j; const LAS float* s = scr + (8 * c) * 33 + n;
        u32x4 o; o.x = pk2h(s[0 * 33], s[1 * 33]); o.y = pk2h(s[2 * 33], s[3 * 33]); o.z = pk2h(s[4 * 33], s[5 * 33]); o.w = pk2h(s[6 * 33], s[7 * 33]);
        *(u32x4*)(WT + (size_t)(drow0 + n) * ldwt + kdst0 + 8 * c) = o; }
    LDS_WAIT(); asm volatile("" ::: "memory");
}
__device__ __forceinline__ int t5_bucket(int rel) {
    const int n = rel < 0 ? -rel : rel;
    const int large = 8 + (n >= 12) + (n >= 16) + (n >= 23) + (n >= 32) + (n >= 46) + (n >= 64) + (n >= 91);
    return (rel > 0 ? 16 : 0) + (n < 8 ? n : large);
}
__device__ __forceinline__ void p0a_prologue(Frame& F) {
    const int gw = F.vcu * NWAVES + F.wave, NGW = F.G * NWAVES;
    const int gt = F.vcu * 512 + F.tid, NGT = F.G * 512;
    if (F.vcu < 192) {
        LAS float* sT = (LAS float*)F.lds;
        LAS float* red = (LAS float*)(F.lds + 98304);
        for (int i = F.tid; i < NBB * D; i += 512) { const int bb = i >> 10, d = i & 1023; const float c = bb < NB ? inp(F, I_CP)[bb * D + d] : inp(F, I_CS)[(bb - NB) * D + d]; sT[d * NBB + bb] = siluf_(c); }
        __syncthreads();
        const int cidx = F.vcu * 128 + (F.tid & 127), l = cidx / 6144, e = cidx % 6144, dq = F.tid >> 7;
        float acc[NBB];
#pragma unroll
        for (int b = 0; b < NBB; ++b) acc[b] = 0.f;
        const float* wp = inp(F, I_WADA) + ((size_t)l * D + dq * 256) * 6144 + e;
#pragma unroll 4
        for (int d = 0; d < 256; ++d) {
            const float w = wp[(size_t)d * 6144];
            const LAS f32x4* sp = (const LAS f32x4*)(sT + (dq * 256 + d) * NBB);
#pragma unroll
            for (int q = 0; q < 6; ++q) { const f32x4 s = sp[q]; acc[4 * q] += s[0] * w; acc[4 * q + 1] += s[1] * w; acc[4 * q + 2] += s[2] * w; acc[4 * q + 3] += s[3] * w; }
        }
        for (int r = 0; r < 4; ++r) {
            if (dq == r) {
#pragma unroll
                for (int b = 0; b < NBB; ++b) { LAS float* p = red + b * 128 + (F.tid & 127); *p = (r == 0 ? 0.f : *p) + acc[b]; }
            }
            __syncthreads();
        }
        float* mod = (float*)(F.ws + WS_MOD);
        for (int i = F.tid; i < NBB * 128; i += 512) { const int b = i >> 7, cc = i & 127; const int ci = F.vcu * 128 + cc, ll = ci / 6144, ee = ci % 6144;
            mod[((size_t)ll * NBB + b) * 6144 + ee] = red[b * 128 + cc] + inp(F, I_BADA)[ll * 6144 + ee]; }
        __syncthreads();
    }
    {
        LAS float* scr = (LAS float*)(F.lds + F.wave * 16384);
        constexpr int I_IN = 16 * (NPROJ / 32), I_O = 32 * 32, I_FI = 16 * (2 * DFF / 32), I_FO = (DFF / 64) * 32, I_L = I_IN + I_O + I_FI + I_FO;
        for (int it = gw; it < DEPTH * I_L; it += NGW) {
            const int l = it / I_L; int r = it % I_L;
            if (r < I_IN) { const int kb = r / (NPROJ / 32), nb = r % (NPROJ / 32);
                transpose_item(inp(F, I_WIN) + (size_t)l * D * DIN, DIN, 64 * kb, win_src_col(32 * nb + (F.lane & 31)), (f16*)(F.ws + WS_WIN) + (size_t)l * NPROJ * D, D, 32 * nb, 64 * kb, scr, F.lane); continue; }
            r -= I_IN;
            if (r < I_O) { const int kb = r / 32, nb = r % 32;
                transpose_item(inp(F, I_WO) + (size_t)l * D * D, D, (64 * kb) & 1023, 32 * nb + (F.lane & 31), (f16*)(F.ws + WS_WO2) + (size_t)l * D * 2048, 2048, 32 * nb, 64 * kb, scr, F.lane); continue; }
            r -= I_O;
            if (r < I_FI) { const int kb = r / (2 * DFF / 32), nb = r % (2 * DFF / 32);
                transpose_item(inp(F, I_WFI) + (size_t)l * D * 2 * DFF, 2 * DFF, 64 * kb, wfi_src_col(32 * nb + (F.lane & 31)), (f16*)(F.ws + WS_WFI) + (size_t)l * 2 * DFF * D, D, 32 * nb, 64 * kb, scr, F.lane); continue; }
            r -= I_FI;
            { const int kb = r / 32, nb = r % 32;
                transpose_item(inp(F, I_WFO) + (size_t)l * DFF * D, D, 64 * kb, 32 * nb + (F.lane & 31), (f16*)(F.ws + WS_WFO) + (size_t)l * D * DFF, DFF, 32 * nb, 64 * kb, scr, F.lane); }
        }
    }
    {
        const int nz = DEPTH * NSB * 32 * D / 8;
        for (int i = gt; i < 2 * nz; i += NGT) {
            const bool isv = i >= nz; const int j = isv ? i - nz : i;
            const int lsb = j / (32 * D / 8), rem = j % (32 * D / 8);
            f16* dst = (f16*)(F.ws + (isv ? WS_VS : WS_KS)) + ((size_t)lsb * KSROWS + PAST + 32) * D + rem * 8;
            *(u32x4*)dst = (u32x4){0u, 0u, 0u, 0u};
        }
    }
    if (F.vcu == F.G - 1) {
        float* misc = (float*)(F.ws + WS_MISC);
        if (F.wave < DEPTH) {
            const float* lp = inp(F, I_LAM) + F.wave * 4 * 64;
            const float s01 = wave_sum(lp[F.lane] * lp[64 + F.lane]), s23 = wave_sum(lp[128 + F.lane] * lp[192 + F.lane]);
            const float lam_init = 0.8f - 0.6f * expf(-0.3f * (float)F.wave);
            if (F.lane == 0) { misc[F.wave] = expf(s01) - expf(s23) + lam_init; misc[8 + F.wave] = 1.0f - lam_init; }
        }
        for (int i = F.tid; i < NH * 256; i += 512) { const int h = i >> 8, rel = (i & 255) - 128; misc[64 + i] = inp(F, I_RELB)[t5_bucket(rel) * NH + h] * LOG2E; }
    }
}
__device__ __forceinline__ void ld8(const float* p, float (&v)[8]) { const f32x4 a = *(const f32x4*)p, c = *(const f32x4*)(p + 4); v[0] = a[0]; v[1] = a[1]; v[2] = a[2]; v[3] = a[3]; v[4] = c[0]; v[5] = c[1]; v[6] = c[2]; v[7] = c[3]; }
__device__ __forceinline__ void ld8(const f16* p, float (&v)[8]) { const f16x8 a = *(const f16x8*)p;
#pragma unroll
    for (int e = 0; e < 8; ++e) v[e] = (float)a[e]; }
__device__ __forceinline__ void st8(float* p, const float (&v)[8]) { *(f32x4*)p = (f32x4){v[0], v[1], v[2], v[3]}; *(f32x4*)(p + 4) = (f32x4){v[4], v[5], v[6], v[7]}; }
__device__ __forceinline__ void st8(f16* p, const float (&v)[8]) { *(u32x4*)p = (u32x4){pk2h(v[0], v[1]), pk2h(v[2], v[3]), pk2h(v[4], v[5]), pk2h(v[6], v[7])}; }
template <class TS, class TD> __device__ __forceinline__ void ln_row(const TS* src, const float* g, const float* b, TD* dst, f16* hrow, const float* sh, const float* sc, int lane, const float* part, const float* gate) {
    float v[2][8]; float s = 0.f;
#pragma unroll
    for (int j = 0; j < 2; ++j) ld8(src + 8 * lane + 512 * j, v[j]);
    if (part) {
#pragma unroll
        for (int j = 0; j < 2; ++j) { const int c = 8 * lane + 512 * j; float y[8], t[8], gt[8]; ld8(part + c, y);
#pragma unroll
            for (int k = 1; k < 8; ++k) { ld8(part + (size_t)k * MS * D + c, t);
#pragma unroll
                for (int e = 0; e < 8; ++e) y[e] += t[e]; }
            ld8(gate + c, gt);
#pragma unroll
            for (int e = 0; e < 8; ++e) v[j][e] = v[j][e] * ALPHA + gt[e] * y[e]; }
    }
#pragma unroll
    for (int j = 0; j < 2; ++j)
#pragma unroll
        for (int e = 0; e < 8; ++e) s += v[j][e];
    const float mean = wave_sum(s) * (1.f / D); float s2 = 0.f;
#pragma unroll
    for (int j = 0; j < 2; ++j)
#pragma unroll
        for (int e = 0; e < 8; ++e) { v[j][e] -= mean; s2 += v[j][e] * v[j][e]; }
    const float rstd = 1.0f / sqrtf(wave_sum(s2) * (1.f / D) + LN_EPS);
#pragma unroll
    for (int j = 0; j < 2; ++j) {
        const int c = 8 * lane + 512 * j; float gg[8], bb[8], x[8];
        ld8(g + c, gg); ld8(b + c, bb);
#pragma unroll
        for (int e = 0; e < 8; ++e) x[e] = v[j][e] * rstd * gg[e] + bb[e];
        st8(dst + c, x);
        if (hrow) { float s1[8], s0[8], hh[8]; ld8(sc + c, s1); ld8(sh + c, s0);
#pragma unroll
            for (int e = 0; e < 8; ++e) hh[e] = x[e] * (s1[e] + 1.0f) + s0[e];
            st8(hrow + c, hh); }
    }
}
__device__ __forceinline__ void ln_phase(Frame& F, bool first, bool last, const float* g, const float* b, const float* modl, int sh_off, int sc_off, const float* gate_l = nullptr) {
    const int gw = F.vcu * NWAVES + F.wave, NGW = F.G * NWAVES;
    f16* X = (f16*)(F.ws + WS_X); f16* H = (f16*)(F.ws + WS_H);
    for (int m = gw; m < M; m += NGW) {
        const float* mb = modl + (size_t)bb_of_row(m) * 6144;
        const bool sp = gate_l != nullptr && m >= MP;
        const float* part = sp ? (const float*)(F.ws + WS_PART) + (size_t)(m - MP) * D : nullptr; const float* gate = sp ? gate_l + (size_t)bb_of_row(m) * 6144 : nullptr;
        if (first) ln_row(m < MP ? inp(F, I_XP) + (size_t)m * D : inp(F, I_XS) + (size_t)(m - MP) * D, g, b, X + (size_t)m * D, H + (size_t)m * D, mb + sh_off, mb + sc_off, F.lane, part, gate);
        else if (last) ln_row(X + (size_t)m * D, g, b, m < MP ? F.out + OUT_YP + (size_t)m * D : F.out + OUT_YS + (size_t)(m - MP) * D, (f16*)nullptr, mb + sh_off, mb + sc_off, F.lane, part, gate);
        else ln_row(X + (size_t)m * D, g, b, X + (size_t)m * D, H + (size_t)m * D, mb + sh_off, mb + sc_off, F.lane, part, gate);
    }
}

constexpr int D1_KN = 0, D1_QN = 17408, D1_RT0 = 34816, D1_RT1 = 71680, D1_AM = 108544, D1_TM = 125952, D1_SC = 135168, D1_SS = 137216, D1_AH = 141312, D1_W = 143872;
struct D1Task { int row0, nvalid, n, unit; const float* hist; };

#define LDS_BARRIER() do { __builtin_amdgcn_fence(__ATOMIC_RELEASE, "workgroup", "local"); __builtin_amdgcn_s_barrier(); __builtin_amdgcn_fence(__ATOMIC_ACQUIRE, "workgroup", "local"); } while (0)
#define D1_LOCALS \
    LAS unsigned char* L = F.lds; \
    LAS f16* Kn = (LAS f16*)(L + D1_KN); LAS f16* Qn = (LAS f16*)(L + D1_QN); LAS f16* RT = (LAS f16*)(L + (rtb ? D1_RT1 : D1_RT0)); \
    LAS float* Am = (LAS float*)(L + D1_AM); LAS f16* Tm = (LAS f16*)(L + D1_TM); \
    LAS float* sBeta = (LAS float*)(L + D1_SC); LAS float* sG = sBeta + 64; \
    LAS float* sSS = (LAS float*)(L + D1_SS); LAS f16* Ah = (LAS f16*)(L + D1_AH); \
    int lane = hw_lane(), wave = F.wave; asm volatile("" : "+s"(wave));        \
    const int r32 = lane & 31, hi = lane >> 5, l = lane; \
    const f16* QKVA = (const f16*)(F.ws + WS_QKVA); const float* BG = (const float*)(F.ws + WS_BG); \
    unsigned char* img = F.ws + WS_DIMG + (size_t)T.unit * DIMG_BYTES; \
    (void)Kn; (void)Qn; (void)RT; (void)Am; (void)Tm; (void)sBeta; (void)sG; (void)sSS; (void)Ah; (void)r32; (void)hi; (void)l; (void)QKVA; (void)BG; (void)img; (void)wave

__device__ __forceinline__ void d1_wload(Frame& F, int h, int layer, float (&w)[3]) {
    const float* cw = inp(F, I_CONVW) + (size_t)layer * 4 * CONVC;
    const int tid = F.wave * 64 + hw_lane();
#pragma unroll
    for (int j = 0; j < 3; ++j) { const int idx = tid + 512 * j; w[j] = cw[((idx >> 7) & 3) * CONVC + (idx >> 9) * 1024 + h * 128 + (idx & 127)]; }
}
__device__ __forceinline__ void d1_wstore(Frame& F, const float (&w)[3]) {
    LAS float* Wl = (LAS float*)(F.lds + D1_W);
    const int tid = F.wave * 64 + hw_lane();
#pragma unroll
    for (int j = 0; j < 3; ++j) Wl[tid + 512 * j] = w[j];
}
__device__ __forceinline__ void d1_s1(Frame& F, const D1Task& T, int h, int layer, int rtb, float (&xq)[16], float (&xk)[16], float& beta_o, float& eg_o, float& egl_o) {
    D1_LOCALS;
    const bool valid = l < T.nvalid, first = T.n == 0;
    f16x8 rm[3][2], rh[3][2];
    const int lr = l < T.nvalid ? l : T.nvalid - 1; const float vmask = valid ? 1.f : 0.f;
#pragma unroll
    for (int tz = 0; tz < 3; ++tz) {
        const f16* p = QKVA + (size_t)(T.row0 + lr) * CONVC + tz * 1024 + h * 128 + 16 * wave;
        rm[tz][0] = *(const f16x8*)p; rm[tz][1] = *(const f16x8*)(p + 8);
        if (!first) { const f16* ph = QKVA + (size_t)(T.row0 + (l >= 3 ? l : l - 3)) * CONVC + tz * 1024 + h * 128 + 16 * wave; rh[tz][0] = *(const f16x8*)ph; rh[tz][1] = *(const f16x8*)(ph + 8); }
        else if (T.hist) { const float* ph = T.hist + (size_t)(l < 3 ? l : 0) * CONVC + tz * 1024 + h * 128 + 16 * wave;
            const f32x4 a = *(const f32x4*)ph, b4 = *(const f32x4*)(ph + 4), c4 = *(const f32x4*)(ph + 8), d4 = *(const f32x4*)(ph + 12);
            rh[tz][0] = __builtin_bit_cast(f16x8, pk8h(a, b4)); rh[tz][1] = __builtin_bit_cast(f16x8, pk8h(c4, d4)); }
        else { rh[tz][0] = f16x8{}; rh[tz][1] = f16x8{}; }
    }
    float beta = 0.f, g = 0.f;
    if (valid) {
        const float braw = BG[(size_t)(T.row0 + lane) * 16 + h], araw = BG[(size_t)(T.row0 + lane) * 16 + 8 + h];
        beta = 1.0f / (1.0f + __expf(-braw));
        const float x = araw + inp(F, I_DTB)[layer * NH + h];
        const float y = __expf(x);
        const float sp = x > 20.f ? x : (y < 0.01f ? y * (1.0f - y * (0.5f - y * 0.333333343f)) : __logf(1.0f + y));
        g = -__expf(inp(F, I_ALOG)[layer * NH + h]) * sp;
    }
#pragma unroll
    for (int o = 1; o < 64; o <<= 1) {
        const float t = __builtin_bit_cast(float, __builtin_amdgcn_ds_bpermute(4 * (lane >= o ? lane - o : lane), __builtin_bit_cast(int, g)));
        if (lane >= o) g += t;
    }
    const float glast = __builtin_bit_cast(float, __builtin_amdgcn_readlane(__builtin_bit_cast(int, g), 63));
    const float eg = __expf(g), egl = __expf(glast - g);
    if (wave == 0) {
        sBeta[lane] = beta; sG[lane] = g;
        if (lane == 0) ((float*)(F.ws + WS_MISC))[4096 + T.unit] = __expf(glast);
    }
    const LAS float* Wl = (const LAS float*)(L + D1_W) + 16 * wave; asm volatile("" : "+v"(Wl));
#pragma unroll
    for (int tz = 0; tz < 3; ++tz) {
        LAS f16* slab = (LAS f16*)(L + D1_KN) + wave * (68 * 16);
        *(LAS f16x8*)(slab + (l + 3) * 16) = rm[tz][0]; *(LAS f16x8*)(slab + (l + 3) * 16 + 8) = rm[tz][1];
        if (l < 3) { *(LAS f16x8*)(slab + l * 16) = rh[tz][0]; *(LAS f16x8*)(slab + l * 16 + 8) = rh[tz][1]; }
        f16x8 raw[4][2];
#pragma unroll
        for (int i = 0; i < 4; ++i) { raw[i][0] = *(const LAS f16x8*)(slab + (l + i) * 16); raw[i][1] = *(const LAS f16x8*)(slab + (l + i) * 16 + 8); }
        float x[16];
#pragma unroll
        for (int e = 0; e < 16; ++e) x[e] = 0.f;
#pragma unroll
        for (int i = 0; i < 4; ++i) {
            const LAS f32x4* wp = (const LAS f32x4*)(Wl + (tz * 4 + i) * 128); const f32x4 w0 = wp[0], w1 = wp[1], w2 = wp[2], w3 = wp[3];
#pragma unroll
            for (int e = 0; e < 4; ++e) { x[e] = __builtin_fmaf((float)raw[i][0][e], w0[e], x[e]); x[4 + e] = __builtin_fmaf((float)raw[i][0][4 + e], w1[e], x[4 + e]);
                x[8 + e] = __builtin_fmaf((float)raw[i][1][e], w2[e], x[8 + e]); x[12 + e] = __builtin_fmaf((float)raw[i][1][4 + e], w3[e], x[12 + e]); }
        }
        float ss = 0.f;
#pragma unroll
        for (int e = 0; e < 16; ++e) { x[e] = siluf_(x[e]) * vmask; ss += x[e] * x[e]; }
        if (tz == 0) {
#pragma unroll
            for (int e = 0; e < 16; ++e) xq[e] = x[e];
            sSS[(0 * 8 + wave) * 64 + l] = ss;
        } else if (tz == 1) {
#pragma unroll
            for (int e = 0; e < 16; ++e) xk[e] = x[e];
            sSS[(1 * 8 + wave) * 64 + l] = ss;
        } else {
#pragma unroll
            for (int e = 0; e < 16; ++e) RT[(16 * wave + e) * 72 + l] = (f16)(x[e] * beta);
        }
    }
    beta_o = beta; eg_o = eg; egl_o = egl;
}
__device__ __forceinline__ void d1_s1b(Frame& F, const D1Task& T, int h, int rtb, float (&xq)[16], float (&xk)[16], float beta, float eg, float egl) {
    D1_LOCALS;
    {
        float sq = 0.f, sk = 0.f;
#pragma unroll
        for (int w = 0; w < 8; ++w) { sq += sSS[(0 * 8 + w) * 64 + l]; sk += sSS[(1 * 8 + w) * 64 + l]; }
        const float rq = rsqrtf(sq + 1e-6f) * 0.08838834764831845f, rk = rsqrtf(sk + 1e-6f);
        float qg[16], kt[16];
#pragma unroll
        for (int e = 0; e < 16; ++e) { xq[e] *= rq; xk[e] *= rk; qg[e] = xq[e] * eg; kt[e] = xk[e] * egl; }
        u32x4 w0, w1;
        w0 = (u32x4){pk2h(xq[0], xq[1]), pk2h(xq[2], xq[3]), pk2h(xq[4], xq[5]), pk2h(xq[6], xq[7])}; w1 = (u32x4){pk2h(xq[8], xq[9]), pk2h(xq[10], xq[11]), pk2h(xq[12], xq[13]), pk2h(xq[14], xq[15])};
        *(LAS u32x4*)(Qn + l * 136 + 16 * wave) = w0; *(LAS u32x4*)(Qn + l * 136 + 16 * wave + 8) = w1;
        w0 = (u32x4){pk2h(xk[0], xk[1]), pk2h(xk[2], xk[3]), pk2h(xk[4], xk[5]), pk2h(xk[6], xk[7])}; w1 = (u32x4){pk2h(xk[8], xk[9]), pk2h(xk[10], xk[11]), pk2h(xk[12], xk[13]), pk2h(xk[14], xk[15])};
        *(LAS u32x4*)(Kn + l * 136 + 16 * wave) = w0; *(LAS u32x4*)(Kn + l * 136 + 16 * wave + 8) = w1;
        f16* qgi = (f16*)(img + IMG_QG) + ((size_t)((l >> 5) * 8 + wave) * 64 + (l & 31)) * 8;
        *(u32x4*)qgi = (u32x4){pk2h(qg[0], qg[1]), pk2h(qg[2], qg[3]), pk2h(qg[8], qg[9]), pk2h(qg[10], qg[11])};
        *(u32x4*)(qgi + 32 * 8) = (u32x4){pk2h(qg[4], qg[5]), pk2h(qg[6], qg[7]), pk2h(qg[12], qg[13]), pk2h(qg[14], qg[15])};
        f16* kti = (f16*)(img + IMG_KT) + l * 128 + 16 * wave;
        *(u32x4*)kti = (u32x4){pk2h(kt[0], kt[1]), pk2h(kt[2], kt[3]), pk2h(kt[4], kt[5]), pk2h(kt[6], kt[7])};
        *(u32x4*)(kti + 8) = (u32x4){pk2h(kt[8], kt[9]), pk2h(kt[10], kt[11]), pk2h(kt[12], kt[13]), pk2h(kt[14], kt[15])};
        const float be = beta * eg;
#pragma unroll
        for (int e = 0; e < 16; ++e) RT[(128 + 16 * wave + e) * 72 + l] = (f16)(xk[e] * be);
    }
}
__device__ __forceinline__ void d1_s2(Frame& F, const D1Task& T) {
    const int rtb = 0; D1_LOCALS;
    if ((wave & 3) < 3) {
        const bool isqk = wave >= 4; const int w3 = wave & 3;
        const int ta = isqk ? (w3 == 2 ? 1 : 0) : (w3 == 0 ? 0 : 1);
        const int tb = isqk ? (w3 == 0 ? 0 : 1) : (w3 == 2 ? 1 : 0);
        const LAS f16* Bm = isqk ? Qn : Kn;
        f32x16 acc = {};
#pragma unroll
        for (int s = 0; s < 8; ++s) {
            const f16x8 a = *(const LAS f16x8*)(Kn + (32 * ta + r32) * 136 + 16 * s + 8 * hi);
            const f16x8 b = *(const LAS f16x8*)(Bm + (32 * tb + r32) * 136 + 16 * s + 8 * hi);
            acc = mfma32(a, b, acc);
        }
        const int cj = 32 * tb + r32;
        const float gj = sG[cj];
        if (!isqk) {
#pragma unroll
            for (int r = 0; r < 16; ++r) { const int i = 32 * ta + crow(r, hi);
                const float v = i > cj ? sBeta[i] * acc[r] * __expf(sG[i] - gj) : 0.f;
                Am[i * 68 + cj] = v;
                if (w3 == 1) Ah[(i - 32) * 40 + cj] = (f16)v; }
        } else {
            f32x16 v;
#pragma unroll
            for (int r = 0; r < 16; ++r) { const int lp = 32 * ta + crow(r, hi);
                v[r] = cj >= lp ? acc[r] * __expf(gj - sG[lp]) : 0.f; }
            f16* qki = (f16*)(img + IMG_QK);
#pragma unroll
            for (int sp = 0; sp < 2; ++sp) *(f16x8*)(qki + ((size_t)(tb * 4 + 2 * ta + sp) * 64 + lane) * 8) = cvt8(v, 8 * sp);
        }
    } else if (wave == 7) {
        f16* qki = (f16*)(img + IMG_QK);
#pragma unroll
        for (int ks = 2; ks < 4; ++ks) *(u32x4*)(qki + ((size_t)(0 * 4 + ks) * 64 + lane) * 8) = (u32x4){0u, 0u, 0u, 0u};
    }
}
__device__ __forceinline__ void d1_s3(Frame& F) {
    const int rtb = 0; D1Task T; T.unit = 0; D1_LOCALS;
    if (wave == 0) {
        const int hb = lane >> 5, c = lane & 31;
        const LAS float* Ab = Am + (32 * hb) * 68 + 32 * hb; asm volatile("" : "+v"(Ab));
        float t[32];
#pragma unroll
        for (int i = 0; i < 32; ++i) t[i] = 0.f;
        f32x4 cur[8];
#pragma unroll
        for (int i = 0; i < 32; ++i) {
            f32x4 nxt[8];
            if (i + 1 < 32) {
                const LAS float* Ar = Ab;
                if (i > 0) asm volatile("" : "+v"(Ar) : "v"(t[i - 1]));
#pragma unroll
                for (int g = 0; g < (i + 4) / 4; ++g) nxt[g] = *(const LAS f32x4*)(Ar + (i + 1) * 68 + 4 * g);
            }
            float a0 = (i == c) ? 1.f : 0.f, a1 = 0.f, a2 = 0.f, a3 = 0.f;
#pragma unroll
            for (int g = 0; g < (i + 3) / 4; ++g) { a0 -= cur[g][0] * t[4 * g]; a1 -= cur[g][1] * t[4 * g + 1]; a2 -= cur[g][2] * t[4 * g + 2]; a3 -= cur[g][3] * t[4 * g + 3]; }
            t[i] = (a0 + a1) + (a2 + a3);
#pragma unroll
            for (int g = 0; g < 8; ++g) cur[g] = nxt[g];
        }
#pragma unroll
        for (int i = 0; i < 32; ++i) Tm[(32 * hb + i) * 72 + 32 * hb + c] = (f16)t[i];
        f32x16 P = {};
#pragma unroll
        for (int s = 0; s < 2; ++s) {
            float bv[8];
#pragma unroll
            for (int e = 0; e < 8; ++e) { const float x = __shfl(t[16 * s + 8 + e], c); bv[e] = hb ? x : t[16 * s + e]; }
            const u32x4 bw = {pk2h(bv[0], bv[1]), pk2h(bv[2], bv[3]), pk2h(bv[4], bv[5]), pk2h(bv[6], bv[7])};
            const f16x8 af = *(const LAS f16x8*)(Ah + c * 40 + 16 * s + 8 * hb);
            P = mfma32(af, __builtin_bit_cast(f16x8, bw), P);
        }
        f32x16 Q = {};
#pragma unroll
        for (int s = 0; s < 2; ++s) {
            const LAS f16* tp = Tm + (32 + c) * 72 + 32 + 16 * s + 4 * hb;
            const f16x4 lo = *(const LAS f16x4*)tp, h4 = *(const LAS f16x4*)(tp + 8);
            Q = mfma32((f16x8){lo[0], lo[1], lo[2], lo[3], h4[0], h4[1], h4[2], h4[3]}, cvt8(P, 8 * s), Q);
        }
#pragma unroll
        for (int r = 0; r < 16; ++r) Tm[(32 + crow(r, hb)) * 72 + c] = (f16)(-Q[r]);
    }
}
__device__ __forceinline__ void d1_s4(Frame& F, const D1Task& T, int rtb) {
    D1_LOCALS;
    {
        const int rt = wave & 1, tq = wave >> 1;
        f32x16 au = {}, aw = {};
        const int ns = rt == 0 ? 2 : 4;
#pragma unroll
        for (int s = 0; s < 4; ++s) if (s < ns) {
            const f16x8 tf = *(const LAS f16x8*)(Tm + (32 * rt + r32) * 72 + 16 * s + 8 * hi);
            const f16x8 bv = *(const LAS f16x8*)(RT + (32 * tq + r32) * 72 + 16 * s + 8 * hi);
            const f16x8 ak = *(const LAS f16x8*)(RT + (128 + 32 * tq + r32) * 72 + 16 * s + 8 * hi);
            au = mfma32(tf, bv, au);
            aw = mfma32(ak, tf, aw);
        }
        f16* uvi = (f16*)(img + IMG_UV) + ((size_t)(tq * 2 + rt) * 64 + lane) * 16;
        *(f16x8*)uvi = cvt8(au, 0); *(f16x8*)(uvi + 8) = cvt8(au, 8);
        f16* wki = (f16*)(img + IMG_WK);
#pragma unroll
        for (int sp = 0; sp < 2; ++sp) *(f16x8*)(wki + ((size_t)(rt * 8 + 2 * tq + sp) * 64 + lane) * 8) = cvt8(aw, 8 * sp);
    }
}

constexpr int SC_BUF = 57344, SC_OB = 2 * SC_BUF, SC_OBB = 16384;
__device__ __forceinline__ int vswz(int row, int ch) { return row * 256 + ((ch ^ (((row & 3) << 2) | ((row >> 2) & 3))) << 4); }
__device__ __forceinline__ f16x4 tr_read(const LAS unsigned char* p) { return __builtin_bit_cast(f16x4, __builtin_amdgcn_ds_read_tr16_b64_v4i16((LAS v4i16_t*)p)); }
struct TrAddr { int a[2][4]; };
__device__ __forceinline__ TrAddr tr_addr(int lane) {
    const int g = lane >> 4, i = lane & 15, q = i >> 2, p = i & 3, hi = g >> 1; TrAddr t;
#pragma unroll
    for (int sec = 0; sec < 2; ++sec)
#pragma unroll
        for (int cb = 0; cb < 4; ++cb)
            t.a[sec][cb] = (4 * hi + q + 8 * sec) * 256 + (((((cb ^ q) << 2) | ((((g & 1) << 1) | (p >> 1)) ^ ((hi + 2 * sec) & 3)))) << 4) + 8 * (p & 1);
    return t;
}
__device__ __forceinline__ f16x8 tr_frag(const LAS unsigned char* base, const TrAddr& t, int k0, int cb) {
    const f16x4 lo = tr_read(base + t.a[0][cb] + k0 * 256);
    const f16x4 hh = tr_read(base + t.a[1][cb] + k0 * 256);
    return (f16x8){lo[0], lo[1], lo[2], lo[3], hh[0], hh[1], hh[2], hh[3]};
}

__device__ __forceinline__ void scan_task(Frame& F, bool samp, int b, int h, int layer, unsigned* qh) {
    LAS unsigned char* L = F.lds;
    int lane = hw_lane(), wave = F.wave; asm volatile("" : "+s"(wave));
    const int tid = wave * 64 + lane, r32 = lane & 31, hi = lane >> 5;
    const bool cwv = wave < 4; const int w = wave & 3;
    const TrAddr TA = tr_addr(lane);
    const int nch = samp ? 1 : 32, unit0 = samp ? NB * NH * 32 + b * NH + h : (b * NH + h) * 32;
    const int row00 = samp ? MP + b * SSEQ : b * SEQ, nvalid = samp ? SSEQ : 64;
    const unsigned char* img0 = F.ws + WS_DIMG + (size_t)unit0 * DIMG_BYTES;
    const float* glast = (const float*)(F.ws + WS_MISC) + 4096 + unit0;
    f32x16 S[4];
#pragma unroll
    for (int t = 0; t < 4; ++t) S[t] = f32x16{};
    if (samp && cwv) {
        const float* sd = inp(F, I_SDELTA) + ((size_t)(layer * NSB + b) * NH + h) * DK * DK;
#pragma unroll
        for (int t = 0; t < 4; ++t)
#pragma unroll
            for (int r = 0; r < 16; ++r) S[t][r] = sd[(32 * t + crow(r, hi)) * DK + 32 * w + r32];
    }
    const int st0 = tid - 256;
    int st = st0;
#define SC_STAGE_LOAD(nn, RG) do { const unsigned char* im_ = img0 + (size_t)(nn) * DIMG_BYTES; \
        _Pragma("unroll") for (int i_ = 0; i_ < 14; ++i_) RG[i_] = *(const u32x4*)(im_ + (size_t)(st + 256 * i_) * 16); } while (0)
#define SC_STAGE_STORE(bufo, RG) do { _Pragma("unroll") for (int i_ = 0; i_ < 14; ++i_) { const int c_ = st + 256 * i_; \
            const int o_ = c_ < (IMG_KT / 16) ? c_ * 16 : IMG_KT + vswz((c_ - IMG_KT / 16) >> 4, (c_ - IMG_KT / 16) & 15); \
            *(LAS u32x4*)(L + (bufo) + o_) = RG[i_]; } } while (0)
#define SC_ZLOAD(nn, Z_) do { const int l_ = st >> 2, part_ = st & 3; \
        const size_t row_ = (size_t)row00 + 64 * (nn) + (l_ < nvalid ? l_ : 0); \
        const f16* zp_ = (const f16*)(F.ws + WS_Z) + row_ * D + h * 128 + 32 * part_;      \
        _Pragma("unroll") for (int q_ = 0; q_ < 4; ++q_) Z_[q_] = *(const f16x8*)(zp_ + 8 * q_); } while (0)
#define SC_EPI(nn, z_, live_) do { const int l_ = st >> 2, part_ = st & 3; \
        const LAS f16* ob_ = (const LAS f16*)(L + SC_OB + ((nn) & 1) * SC_OBB) + l_ * 128 + 32 * part_; \
        const size_t row_ = (size_t)row00 + 64 * (nn) + (l_ < nvalid ? l_ : 0); const int c_ = h * 128 + 32 * part_; \
        float ss_ = 0.f; \
        _Pragma("unroll") for (int q_ = 0; q_ < 4; ++q_) { const f16x8 a1_ = *(const LAS f16x8*)(ob_ + 8 * q_); _Pragma("unroll") for (int e_ = 0; e_ < 8; ++e_) { const float v_ = (float)a1_[e_]; ss_ += v_ * v_; } } \
        const LAS f16* ob2_ = ob_; asm volatile("" : "+v"(ob2_));        \
        ss_ += __shfl_xor(ss_, 1); ss_ += __shfl_xor(ss_, 2); \
        const float rstd_ = rsqrtf(ss_ * (1.0f / 128.0f) + LN_EPS); \
        const LAS f32x4* na_ = (const LAS f32x4*)(L + LDSCTL_OFF + 1024 + 4 * 132) + 8 * part_;     \
        f16* op_ = (live_) ? (f16*)(F.ws + WS_MAB) + row_ * 2048 + c_ : (f16*)(F.ws + WS_PART) + st * 32;     \
        _Pragma("unroll") for (int q_ = 0; q_ < 4; ++q_) { float r_[8]; const f32x4 n0_ = na_[2 * q_], n1_ = na_[2 * q_ + 1]; const f16x8 a2_ = *(const LAS f16x8*)(ob2_ + 8 * q_); \
            _Pragma("unroll") for (int e_ = 0; e_ < 8; ++e_) r_[e_] = (float)a2_[e_] * rstd_ * (e_ < 4 ? n0_[e_ & 3] : n1_[e_ & 3]) * (float)z_[q_][e_]; \
            if (!samp || l_ < nvalid) *(u32x4*)(op_ + 8 * q_) = (u32x4){pk2h(r_[0], r_[1]), pk2h(r_[2], r_[3]), pk2h(r_[4], r_[5]), pk2h(r_[6], r_[7])}; } } while (0)
    f16x8 uvn[2][2] = {}; float gln = 0.f;
    u32x4 rga[14], rgb[14];
    if (!cwv) { SC_STAGE_LOAD(0, rga); SC_STAGE_STORE(0, rga); SC_STAGE_LOAD(nch > 1 ? 1 : 0, rgb); }
    else {
        const f16* uvp = (const f16*)(img0 + IMG_UV);
#pragma unroll
        for (int rt = 0; rt < 2; ++rt) { const f16* p = uvp + ((size_t)(w * 2 + rt) * 64 + lane) * 16; uvn[rt][0] = *(const f16x8*)p; uvn[rt][1] = *(const f16x8*)(p + 8); }
        gln = glast[0];
    }
    __syncthreads();
    if (cwv) {
        for (int n = 0; n < nch; ++n) {
            const int bo = (n & 1) * SC_BUF;
            const LAS unsigned char* B = L + bo;
            f16x8 uv[2][2];
#pragma unroll
            for (int rt = 0; rt < 2; ++rt) { uv[rt][0] = uvn[rt][0]; uv[rt][1] = uvn[rt][1]; }
            const float gl = gln;
            f32x16 up[2] = {f32x16{}, f32x16{}}, o[2] = {f32x16{}, f32x16{}};
#define SB() __builtin_amdgcn_sched_barrier(0)
#define SC_REQ1(ks, W) do { _Pragma("unroll") for (int rt = 0; rt < 2; ++rt) { wkf[W][rt] = *(const LAS f16x8*)(B + IMG_WK + ((rt * 8 + (ks)) * 64 + lane) * 16); qgf[W][rt] = *(const LAS f16x8*)(B + IMG_QG + ((rt * 8 + (ks)) * 64 + lane) * 16); } } while (0)
#define SC_MMA1(ks, W) do { const f16x8 bf = cvt8(S[(ks) >> 1], 8 * ((ks) & 1)); _Pragma("unroll") for (int rt = 0; rt < 2; ++rt) { up[rt] = mfma32(wkf[W][rt], bf, up[rt]); o[rt] = mfma32(qgf[W][rt], bf, o[rt]); } } while (0)
            {
                f16x8 wkf[1][2], qgf[1][2];
#pragma unroll
                for (int ks = 0; ks < 8; ++ks) { SC_REQ1(ks, 0); SB(); SC_MMA1(ks, 0); SB(); }
            }
#pragma unroll
            for (int rt = 0; rt < 2; ++rt)
#pragma unroll
                for (int r = 0; r < 16; ++r) up[rt][r] = (float)uv[rt][r >> 3][r & 7] - up[rt][r];
#pragma unroll
            for (int t = 0; t < 4; ++t) S[t] = S[t] * gl;
            if (n + 1 < nch) {
                const f16* uvp = (const f16*)(img0 + (size_t)(n + 1) * DIMG_BYTES + IMG_UV);
#pragma unroll
                for (int rt = 0; rt < 2; ++rt) { const f16* p = uvp + ((size_t)(w * 2 + rt) * 64 + lane) * 16; uvn[rt][0] = *(const f16x8*)p; uvn[rt][1] = *(const f16x8*)(p + 8); }
                gln = glast[n + 1];
            }
#define SC_REQ2(ks, W) do { qk1[W] = *(const LAS f16x8*)(B + IMG_QK + ((1 * 4 + (ks)) * 64 + lane) * 16); if ((ks) < 2) qk0[W] = *(const LAS f16x8*)(B + IMG_QK + ((0 * 4 + (ks)) * 64 + lane) * 16); \
        _Pragma("unroll") for (int t = 0; t < 4; ++t) { ktl[W][t] = tr_read(B + IMG_KT + TA.a[0][t] + (16 * (ks)) * 256); kth[W][t] = tr_read(B + IMG_KT + TA.a[1][t] + (16 * (ks)) * 256); } } while (0)
#define SC_MMA2(ks, W) do { const f16x8 bf = cvt8(up[(ks) >> 1], 8 * ((ks) & 1)); o[1] = mfma32(qk1[W], bf, o[1]); if ((ks) < 2) o[0] = mfma32(qk0[W], bf, o[0]); \
        _Pragma("unroll") for (int t = 0; t < 4; ++t) S[t] = mfma32((f16x8){ktl[W][t][0], ktl[W][t][1], ktl[W][t][2], ktl[W][t][3], kth[W][t][0], kth[W][t][1], kth[W][t][2], kth[W][t][3]}, bf, S[t]); } while (0)
            {
                f16x8 qk1[1], qk0[1]; f16x4 ktl[1][4], kth[1][4];
#pragma unroll
                for (int ks = 0; ks < 4; ++ks) { SC_REQ2(ks, 0); SB(); SC_MMA2(ks, 0); SB(); }
            }
#undef SC_REQ1
#undef SC_MMA1
#undef SC_REQ2
#undef SC_MMA2
#undef SB
            LAS f16* ob = (LAS f16*)(L + SC_OB + (n & 1) * SC_OBB);
#pragma unroll
            for (int rt = 0; rt < 2; ++rt)
#pragma unroll
                for (int r = 0; r < 16; ++r) ob[(32 * rt + crow(r, hi)) * 128 + 32 * w + r32] = (f16)o[rt][r];
            LDS_BARRIER();
        }
        {
        float* od = F.out + (samp ? OUT_DS + ((size_t)(layer * NSB + b) * NH + h) * DK * DK : OUT_DP + ((size_t)(layer * NB + b) * NH + h) * DK * DK);
#pragma unroll
        for (int t = 0; t < 4; ++t)
#pragma unroll
            for (int r = 0; r < 16; ++r) od[(32 * t + crow(r, hi)) * DK + 32 * w + r32] = S[t][r];
        }
    } else {
        const int nl = nch - 1;
        f16x8 zg[4] = {};
        for (int n = 0; n < nch; n += 2) {
            st = st0; asm volatile("" : "+v"(st));
            SC_STAGE_LOAD(n + 2 < nl ? n + 2 : nl, rga);
            SC_EPI(n > 0 ? n - 1 : 0, zg, n > 0);
            SC_ZLOAD(n, zg);
            if (n + 1 < nch) SC_STAGE_STORE(SC_BUF, rgb);
            LDS_BARRIER();
            if (n + 1 >= nch) break;
            st = st0; asm volatile("" : "+v"(st));
            SC_STAGE_LOAD(n + 3 < nl ? n + 3 : nl, rgb);
            SC_EPI(n, zg, true);
            SC_ZLOAD(n + 1, zg);
            if (n + 2 < nch) SC_STAGE_STORE(0, rga);
            LDS_BARRIER();
        }
        st = st0; asm volatile("" : "+v"(st));
        SC_EPI(nch - 1, zg, true);
    }
#undef SC_STAGE_LOAD
#undef SC_STAGE_STORE
#undef SC_EPI
#undef SC_ZLOAD
    if (wave == 0 && lane == 0) F.MISC[0] = __hip_atomic_fetch_add(qh, 1u, __ATOMIC_RELAXED, __HIP_MEMORY_SCOPE_AGENT);
    __syncthreads();
}

constexpr int AT_K0 = 0, AT_V0 = 32768, AT_XCH = 65536, AT_BT = 147456;
struct AttnTask { const f16* Q; const f16* K; const f16* V; const f16* G; f16* O; float* OK; float* OV; int q0, nqw, nkeys, ntiles, h, wr0; };

__device__ __forceinline__ float max3f_(float a, float b, float c) { return __builtin_fmaxf(__builtin_fmaxf(a, b), c); }
constexpr float AT_THR = 4.0f;
__device__ __forceinline__ void attn_task(Frame& F, const AttnTask& T, int layer, unsigned* qh) {
    LAS unsigned char* L = F.lds;
    int lane = hw_lane(), wave = F.wave; asm volatile("" : "+s"(wave));
    const int tid = wave * 64 + lane, r32 = lane & 31, hi = lane >> 5;
    const int map = wave >> 2, wq = wave & 3;
    const TrAddr TA = tr_addr(lane);
    const bool active = wq < T.nqw;
    const int qbase = T.q0 + 32 * wq, qpos = qbase + r32, cwv = qbase >> 6;
    const float* misc = (const float*)(F.ws + WS_MISC);
    const LAS float* BT = (const LAS float*)(L + AT_BT) + T.h * 256;
    float cfar = BT[0];
    f16x8 qf[4];
#pragma unroll
    for (int s = 0; s < 4; ++s) qf[s] = active ? *(const f16x8*)(T.Q + (size_t)qpos * D + map * 64 + 16 * s + 8 * hi) : f16x8{};
    int kadr[4];
#pragma unroll
    for (int s = 0; s < 4; ++s) kadr[s] = r32 * 256 + (((map * 8 + 2 * s + hi) ^ (r32 & 15)) << 4);
    const int srow0 = tid >> 4, srow1 = srow0 + 32, sch = tid & 15;
    const int kdo0 = srow0 * 256 + ((sch ^ (srow0 & 15)) << 4), kdo1 = srow1 * 256 + ((sch ^ (srow1 & 15)) << 4);
    const int vdo0 = vswz(srow0, sch), vdo1 = vswz(srow1, sch);
    u32x4 ka0, ka1, va0, va1, kb0, kb1, vb0, vb1;
#define AT_LOAD(j, S) do { const size_t o0_ = ((size_t)(64 * (j) + srow0)) * D + sch * 8, o1_ = o0_ + (size_t)32 * D; \
        k##S##0 = *(const u32x4*)(T.K + o0_); k##S##1 = *(const u32x4*)(T.K + o1_); v##S##0 = *(const u32x4*)(T.V + o0_); v##S##1 = *(const u32x4*)(T.V + o1_); } while (0)
#define AT_OUT8(P_, W_) do { const f16x8 h_ = __builtin_bit_cast(f16x8, W_); \
        __builtin_nontemporal_store((f32x4){(float)h_[0], (float)h_[1], (float)h_[2], (float)h_[3]}, (f32x4*)(P_)); __builtin_nontemporal_store((f32x4){(float)h_[4], (float)h_[5], (float)h_[6], (float)h_[7]}, (f32x4*)((P_) + 4)); } while (0)
#define AT_STORE(bo, S, jt) do { *(LAS u32x4*)(L + AT_K0 + (bo) + kdo0) = k##S##0; *(LAS u32x4*)(L + AT_K0 + (bo) + kdo1) = k##S##1; \
        *(LAS u32x4*)(L + AT_V0 + (bo) + vdo0) = v##S##0; *(LAS u32x4*)(L + AT_V0 + (bo) + vdo1) = v##S##1; \
        if ((jt) >= T.wr0) {                                       \
            const size_t q0_ = ((size_t)(64 * (jt) + srow0)) * D + sch * 8, q1_ = q0_ + (size_t)32 * D; \
            AT_OUT8(T.OK + q0_, k##S##0); AT_OUT8(T.OK + q1_, k##S##1); AT_OUT8(T.OV + q0_, v##S##0); AT_OUT8(T.OV + q1_, v##S##1); } } while (0)
    AT_LOAD(0, a); AT_STORE(0, a, 0);
    asm volatile("s_waitcnt vmcnt(0)" ::: "memory");
    asm volatile("" : "+v"(qf[0]), "+v"(qf[1]), "+v"(qf[2]), "+v"(qf[3]), "+v"(cfar));
    const int jlast = T.ntiles - 1;
    AT_LOAD(jlast < 1 ? jlast : 1, b);
    LDS_BARRIER();
    float m = 0.f, lsum = 0.f;
    bool firstt = true;
    f32x16 o[4];
#pragma unroll
    for (int d = 0; d < 4; ++d) o[d] = f32x16{};
#define SB() __builtin_amdgcn_sched_barrier(0)
#define AT_VREQ(g, W) do { _Pragma("unroll") for (int d = 0; d < 4; ++d) { vl[W][d] = tr_read(vb + TA.a[0][d] + (16 * (g)) * 256); vh[W][d] = tr_read(vb + TA.a[1][d] + (16 * (g)) * 256); } } while (0)
#define AT_PV(g, W) do { const f16x8 pf = cvt8((g) < 2 ? p0 : p1, 8 * ((g) & 1)); \
        _Pragma("unroll") for (int d = 0; d < 4; ++d) o[d] = mfma32((f16x8){vl[W][d][0], vl[W][d][1], vl[W][d][2], vl[W][d][3], vh[W][d][0], vh[W][d][1], vh[W][d][2], vh[W][d][3]}, pf, o[d]); } while (0)
#define AT_TILE(j, bo) do { if (active && (j) <= cwv) { \
            const LAS unsigned char* kb = L + AT_K0 + (bo); \
            const LAS unsigned char* vb = L + AT_V0 + (bo); \
            f16x8 ka[4], kc[4]; f16x4 vl[2][4], vh[2][4]; \
            _Pragma("unroll") for (int s = 0; s < 2; ++s) { ka[s] = *(const LAS f16x8*)(kb + kadr[s]); kc[s] = *(const LAS f16x8*)(kb + kadr[s] + 8192); } \
            SB(); \
            _Pragma("unroll") for (int s = 2; s < 4; ++s) { ka[s] = *(const LAS f16x8*)(kb + kadr[s]); kc[s] = *(const LAS f16x8*)(kb + kadr[s] + 8192); } \
            f32x16 p0 = f32x16{}, p1 = f32x16{}; \
            _Pragma("unroll") for (int s = 0; s < 2; ++s) { p0 = mfma32(ka[s], qf[s], p0); p1 = mfma32(kc[s], qf[s], p1); } \
            SB(); \
            AT_VREQ(0, 0); \
            _Pragma("unroll") for (int s = 2; s < 4; ++s) { p0 = mfma32(ka[s], qf[s], p0); p1 = mfma32(kc[s], qf[s], p1); } \
            SB(); \
            const bool near_ = 64 * (j) + 191 > qbase; \
            float cm = (near_ ? 0.f : cfar) - m;                   \
            if (near_) {                                           \
                const int ib = 64 * (j) - qpos + 128 + 4 * hi; \
                const bool tail = 64 * (j) + 64 > T.nkeys; \
                _Pragma("unroll") for (int hb = 0; hb < 2; ++hb) { float b0[8], b1[8]; \
                    _Pragma("unroll") for (int r8 = 0; r8 < 8; ++r8) { const int r = 8 * hb + r8; const int i0 = ib + (r & 3) + 8 * (r >> 2), i1 = i0 + 32; b0[r8] = BT[i0 < 0 ? 0 : i0]; b1[r8] = BT[i1 < 0 ? 0 : i1]; } \
                    SB(); \
                    _Pragma("unroll") for (int r8 = 0; r8 < 8; ++r8) { const int r = 8 * hb + r8; const int i0 = ib + (r & 3) + 8 * (r >> 2), i1 = i0 + 32; \
                        p0[r] += b0[r8]; p1[r] += b1[r8]; \
                        if (tail) { if (i0 + qpos - 128 >= T.nkeys) p0[r] = -INFINITY; if (i1 + qpos - 128 >= T.nkeys) p1[r] = -INFINITY; } } \
                    SB(); } } \
            float mx = max3f_(p0[0], p0[1], p1[0]); mx = max3f_(mx, p1[1], p0[2]); \
            _Pragma("unroll") for (int r = 2; r < 16; r += 2) { mx = max3f_(mx, p0[r], p0[r + 1]); mx = max3f_(mx, p1[r], p1[r + 1]); } \
            mx = __builtin_fmaxf(mx, __shfl_xor(mx, 32)) + cm; \
            if (firstt || __any(mx > AT_THR)) {                    \
                const float dl = firstt ? mx : __builtin_fmaxf(mx, 0.f); \
                const float alpha = firstt ? 1.0f : __builtin_amdgcn_exp2f(-dl); \
                m += dl; lsum *= alpha; cm -= dl; \
                _Pragma("unroll") for (int d = 0; d < 4; ++d) o[d] = o[d] * alpha; \
                firstt = false; } \
            f32x2 ps2 = {0.f, 0.f}; const f32x2 cm2 = {cm, cm}; \
            _Pragma("unroll") for (int r = 0; r < 16; r += 2) { \
                const f32x2 x0 = (f32x2){p0[r], p0[r + 1]} + cm2, x1 = (f32x2){p1[r], p1[r + 1]} + cm2; \
                p0[r] = __builtin_amdgcn_exp2f(x0[0]); p0[r + 1] = __builtin_amdgcn_exp2f(x0[1]); p1[r] = __builtin_amdgcn_exp2f(x1[0]); p1[r + 1] = __builtin_amdgcn_exp2f(x1[1]); \
                ps2 += (f32x2){p0[r], p0[r + 1]}; ps2 += (f32x2){p1[r], p1[r + 1]}; } \
            lsum += ps2[0] + ps2[1]; \
            SB(); AT_VREQ(1, 1); SB(); AT_PV(0, 0); SB(); AT_VREQ(2, 0); SB(); AT_PV(1, 1); SB(); AT_VREQ(3, 1); SB(); AT_PV(2, 0); SB(); AT_PV(3, 1); SB(); \
        } } while (0)
    for (int j = 0; j < T.ntiles; j += 2) {
        AT_LOAD(j + 2 < jlast ? j + 2 : jlast, a);
        AT_TILE(j, 0);
        if (j + 1 < T.ntiles) AT_STORE(16384, b, j + 1);
        LDS_BARRIER();
        if (j + 1 >= T.ntiles) break;
        AT_LOAD(j + 3 < jlast ? j + 3 : jlast, b);
        AT_TILE(j + 1, 16384);
        if (j + 2 < T.ntiles) AT_STORE(0, a, j + 2);
        LDS_BARRIER();
    }
#undef AT_LOAD
#undef AT_STORE
#undef AT_OUT8
#undef AT_TILE
#undef AT_VREQ
#undef AT_PV
#undef SB
    unsigned tk = 0;
    const bool qlead = wave == 0 && lane == 0;
    if (qlead) tk = __hip_atomic_fetch_add(qh, 1u, __ATOMIC_RELAXED, __HIP_MEMORY_SCOPE_AGENT);
    lsum += __shfl_xor(lsum, 32);
    const LAS float* PC = (const LAS float*)(L + LDSCTL_OFF + 1024);
    const float lam = PC[0];
    const float scl = (map == 0 ? 1.0f : lam) / lsum;
    LAS float* XC = (LAS float*)(L + AT_XCH) + wq * 4096;
    f16x4 gg[4][4];
    if (active && map == 0) {
        const f16* gp = T.G + (size_t)qpos * D;
#pragma unroll
        for (int d = 0; d < 4; ++d)
#pragma unroll
            for (int g4 = 0; g4 < 4; ++g4) gg[d][g4] = *(const f16x4*)(gp + 32 * d + 8 * g4 + 4 * hi);
    }
    if (active && map == 1) {
#pragma unroll
        for (int d = 0; d < 4; ++d)
#pragma unroll
            for (int r = 0; r < 16; ++r) XC[(d * 16 + r) * 64 + lane] = o[d][r] * scl;
    }
    LDS_BARRIER();
    if (active && map == 0) {
        float ss = 0.f;
#pragma unroll
        for (int d = 0; d < 4; ++d)
#pragma unroll
            for (int r = 0; r < 16; ++r) { const float v = o[d][r] * scl - XC[(d * 16 + r) * 64 + lane]; o[d][r] = v; ss += v * v; }
        ss += __shfl_xor(ss, 32);
        const float rs = rsqrtf(ss * (1.0f / 128.0f) + LN_EPS) * PC[1];
        f16* op = T.O + (size_t)qpos * 2048;
#pragma unroll
        for (int d = 0; d < 4; ++d)
#pragma unroll
            for (int g4 = 0; g4 < 4; ++g4) {
                const int dv = 32 * d + 8 * g4 + 4 * hi;
                const f32x4 s4 = *(const LAS f32x4*)(PC + 4 + dv);
                u32x2 wv; wv.x = pk2h(o[d][4 * g4] * rs * s4[0] * (float)gg[d][g4][0], o[d][4 * g4 + 1] * rs * s4[1] * (float)gg[d][g4][1]);
                wv.y = pk2h(o[d][4 * g4 + 2] * rs * s4[2] * (float)gg[d][g4][2], o[d][4 * g4 + 3] * rs * s4[3] * (float)gg[d][g4][3]);
                *(u32x2*)(op + dv) = wv;
            }
    }
    if (qlead) F.MISC[0] = tk;
    LDS_BARRIER();
}

#ifndef MK_PER_PHASE
#define MK_PER_PHASE 0
#endif
constexpr int N_PHASES = 2 + 8 * DEPTH;
constexpr int QN_SCANP = 2 * NH, QN_ATTS = NH, QN_ATTP = 2 * NH * 16, QN_SCANS = NH, QN_TOTAL = QN_SCANP + QN_ATTS + QN_ATTP + QN_SCANS;
static_assert(NB == 16 && NSB == 8, "queue partition");
struct Args { const float* in[27]; float* out; unsigned char* ws; int ph_lo, ph_hi; };

__global__ void __launch_bounds__(NWAVES * 64, 2) mk_fwd(Args args) {
    extern __shared__ __attribute__((aligned(16))) unsigned char lds[];
    Frame F;
    F.lds = (LAS unsigned char*)lds;
    F.MISC = (volatile LAS unsigned*)(F.lds + LDSCTL_OFF);
    F.tid = threadIdx.x; F.lane = F.tid & 63; F.wave = __builtin_amdgcn_readfirstlane(F.tid >> 6);
    F.G = gridDim.x; F.bx = blockIdx.x; { const int bx = blockIdx.x; F.vcu = (F.G % 8 == 0) ? (bx % 8) * (F.G / 8) + bx / 8 : bx; }
    F.out = args.out; F.ws = args.ws; F.ctl = (unsigned*)(args.ws + WS_CTL);
    for (int u = F.tid; u < 64; u += NWAVES * 64) ((LAS unsigned*)(F.lds + LDSCTL_OFF))[u] = 0u;
    if (F.tid < 27) ((LAS unsigned long long*)(F.lds + LDS_INP_OFF))[F.tid] = (unsigned long long)args.in[F.tid];
    __syncthreads();
    XcdBarrier bar; bar.bar = F.ctl + CW_BAR; bar.x = 0; bar.st = nullptr;
    if (!MK_PER_PHASE) bar = xcd_barrier_post(F.ctl + CW_BAR, F.MISC + 8);
    const int lo = args.ph_lo, hi = args.ph_hi;
#define IN(k) (lo <= (k) && (k) < hi)
#ifndef PROBE_PHASE
#define PROBE_PHASE -1
#endif
#define PROBE_T0() const unsigned long long pt0_ = (PROBE_PHASE >= 0) ? __builtin_amdgcn_s_memrealtime() : 0ull
#define PROBE_T1(k) do { if (PROBE_PHASE == (k)) { const unsigned long long pt1_ = __builtin_amdgcn_s_memrealtime(); while (__builtin_amdgcn_s_memrealtime() - pt1_ < pt1_ - pt0_) __builtin_amdgcn_s_sleep(8); } } while (0)
#define SEAM(k) do { if (!MK_PER_PHASE && IN(k) && IN((k) + 1)) { XcdBarrier b2_ = bar; asm volatile("" : "+s"(b2_.bar)); b2_.bar = as_global(b2_.bar); xcd_barrier(b2_); if (PROBE_PHASE == 30) xcd_barrier(b2_); } } while (0)

    if (IN(0)) { PROBE_T0();
#ifndef DIS_P0A
 { PHASE_FRAME(P); p0a_prologue(P); }
#endif
 PROBE_T1(8); }
    SEAM(0);
    if (IN(1)) { PROBE_T0(); PHASE_FRAME(P); ln_phase(P, true, false, inp(P, I_LNG), inp(P, I_LNB), (const float*)(P.ws + WS_MOD), 0, 1024); PROBE_T1(9); }
    SEAM(1);

    for (int l = 0; l < DEPTH; ++l) {
        const int p = 2 + 8 * l;
        if (IN(p)) { asm volatile("; PHASE_MARK P1"); PROBE_T0(); PHASE_FRAME(P);
            pg8::Gemm g{(const pg8::bf16_t*)(P.ws + WS_H), (const pg8::bf16_t*)(P.ws + WS_WIN) + (size_t)l * NPROJ * D, M, NPROJ, D};
            pg8::StaticOrder S; S.init(M, NPROJ, P.G, P.bx); S.rot = 33;
            EpiProj E{(f16*)(P.ws + WS_QKVA), (f16*)(P.ws + WS_Z), (f16*)(P.ws + WS_QB), (f16*)(P.ws + WS_KB), (f16*)(P.ws + WS_VB), (f16*)(P.ws + WS_GAB), (float*)(P.ws + WS_BG),
                      (f16*)(P.ws + WS_KS) + (size_t)l * NSB * KSROWS * D, (f16*)(P.ws + WS_VS) + (size_t)l * NSB * KSROWS * D, P.out, l};

#ifndef DIS_G1
 pg8::gemm_phase<EpiProj, pg8::StaticOrder, true, true>(P.lds, g, S, E, P.tid);
#endif

        PROBE_T1(0); }
        SEAM(p);
        if (IN(p + 1)) { asm volatile("; PHASE_MARK P2"); PROBE_T0(); PHASE_FRAME(P);
            float xq[16], xk[16]; float beta = 0.f, eg = 0.f, egl = 0.f;
#pragma unroll
            for (int e = 0; e < 16; ++e) { xq[e] = 0.f; xk[e] = 0.f; }
            D1Task Tc, Tn; int hn = 0, rtb = 0; bool cur = false;
            Tc.row0 = 0; Tc.nvalid = 0; Tc.n = 0; Tc.unit = 0; Tc.hist = nullptr; Tn = Tc;
            if (P.vcu < N_DUNITS) { float w3[3]; d1_wload(P, P.vcu < NB * NH * 32 ? (P.vcu >> 5) & 7 : (P.vcu - NB * NH * 32) & 7, l, w3); d1_wstore(P, w3); }
            LDS_BARRIER();
            for (int uu = P.vcu; ; uu += P.G) {
                int u = uu; asm volatile("" : "+s"(u));
                const bool nxt = u < N_DUNITS;
                if (!cur && !nxt) break;
                const int kstep = (uu - P.vcu) / P.G;
                const bool cvt = kstep < 16 && P.G == 256;
                if (nxt) {
                    if (u < NB * NH * 32) { const int n = u & 31, bh = u >> 5; hn = bh & 7; const int b = bh >> 3; Tn.row0 = b * SEQ + 64 * n; Tn.nvalid = 64; Tn.n = n; Tn.unit = u; Tn.hist = nullptr; }
                    else { const int v = u - NB * NH * 32, sb = v >> 3; hn = v & 7; Tn.row0 = MP + sb * SSEQ; Tn.nvalid = SSEQ; Tn.n = 0; Tn.unit = u; Tn.hist = inp(P, I_SCONV) + (size_t)(l * NSB + sb) * 3 * CONVC; }
                }
#ifndef DIS_D1
#define D1_PROBE(k, BODY) do { const unsigned long long d0_ = (PROBE_PHASE == (k)) ? __builtin_amdgcn_s_memrealtime() : 0ull; BODY; \
        if (PROBE_PHASE == (k)) { const unsigned long long d1_ = __builtin_amdgcn_s_memrealtime(); while (__builtin_amdgcn_s_memrealtime() - d1_ < d1_ - d0_) __builtin_amdgcn_s_sleep(4); } } while (0)
                D1_PROBE(20, if (cur) d1_s3(P));
                D1_PROBE(21, if (nxt) d1_s1(P, Tn, hn, l, rtb ^ 1, xq, xk, beta, eg, egl));
                LDS_BARRIER();
                D1_PROBE(22, if (cur) d1_s4(P, Tc, rtb));
                D1_PROBE(23, if (nxt) d1_s1b(P, Tn, hn, rtb ^ 1, xq, xk, beta, eg, egl));
                LDS_BARRIER();
                { const int u2 = u + P.G; const bool nn = u2 < N_DUNITS; float w3[3] = {0.f, 0.f, 0.f}; f32x4 cv[4] = {f32x4{}, f32x4{}, f32x4{}, f32x4{}};
                  if (nn) d1_wload(P, u2 < NB * NH * 32 ? (u2 >> 5) & 7 : (u2 - NB * NH * 32) & 7, l, w3);
                  if (cvt) cache_slice_load(P, l, kstep, cv);
                  D1_PROBE(24, if (nxt) d1_s2(P, Tn));
                  if (nn) d1_wstore(P, w3);
                  if (cvt) cache_slice_store(P, l, kstep, cv); }
                LDS_BARRIER();
#endif
                Tc = Tn; cur = nxt; rtb ^= 1;
            }
                PROBE_T1(1); }
        SEAM(p + 1);
        if (IN(p + 2)) { asm volatile("; PHASE_MARK P3"); PROBE_T0(); PHASE_FRAME(P);
            const int qx = P.bx & 7;
            unsigned* qh = P.ctl + CW_Q + 1024 + (l * 8 + qx) * 32;
            { LAS float* bt = (LAS float*)(P.lds + AT_BT); const float* misc = (const float*)(P.ws + WS_MISC);
#pragma unroll
              for (int i = 0; i < 4; ++i) bt[P.tid + 512 * i] = misc[64 + P.tid + 512 * i];
              LAS float* pc = (LAS float*)(P.lds + LDSCTL_OFF + 1024);
              if (P.tid == 0) { pc[0] = misc[l]; pc[1] = misc[8 + l]; }
              if (P.tid < 128) { pc[4 + P.tid] = inp(P, I_SUBLN)[l * 128 + P.tid]; pc[132 + P.tid] = inp(P, I_NORMA)[l * 128 + P.tid]; } }
            if (P.wave == 0 && hw_lane() == 0) P.MISC[0] = __hip_atomic_fetch_add(qh, 1u, __ATOMIC_RELAXED, __HIP_MEMORY_SCOPE_AGENT);
            __syncthreads();
            for (;;) {
                const int t = (int)P.MISC[0];
                if (t >= QN_TOTAL) break;
                if (t < QN_SCANP) { asm volatile("; PHASE_MARK SCANP");
#ifndef DIS_SCAN
 { const unsigned long long q0_ = (PROBE_PHASE == 10) ? __builtin_amdgcn_s_memrealtime() : 0ull; scan_task(P, false, 2 * qx + (t >> 3), t & 7, l, qh); if (PROBE_PHASE == 10) { const unsigned long long q1_ = __builtin_amdgcn_s_memrealtime(); while (__builtin_amdgcn_s_memrealtime() - q1_ < q1_ - q0_) __builtin_amdgcn_s_sleep(8); } }
#endif
 }
                else if (t < QN_SCANP + QN_ATTS + QN_ATTP) {
                    asm volatile("; PHASE_MARK ATTN"); AttnTask A; const int t2 = t - QN_SCANP;
                    if (t2 < QN_ATTS) { const int sb = qx, h = t2 & 7;
                        A.Q = (const f16*)(P.ws + WS_QB) + ((ptrdiff_t)(MP + sb * SSEQ) - PAST) * D + h * 128;
                        A.K = (const f16*)(P.ws + WS_KS) + ((size_t)(l * NSB + sb) * KSROWS) * D + h * 128; A.V = (const f16*)(P.ws + WS_VS) + ((size_t)(l * NSB + sb) * KSROWS) * D + h * 128;
                        A.G = (const f16*)(P.ws + WS_GAB) + ((ptrdiff_t)(MP + sb * SSEQ) - PAST) * D + h * 128; A.O = (f16*)(P.ws + WS_MAB) + ((ptrdiff_t)(MP + sb * SSEQ) - PAST) * 2048 + 1024 + h * 128;
                        A.q0 = PAST; A.nqw = 1; A.nkeys = PAST + SSEQ; A.ntiles = 33; A.h = h; A.OK = nullptr; A.OV = nullptr; A.wr0 = 1 << 20; }
                    else { const int t3 = t2 - QN_ATTS, r = t3 & 127, qb = 8 * (1 - (t3 >> 7)) + 7 - (r & 7), bhl = r >> 3, b = 2 * qx + (bhl >> 3), h = bhl & 7;
                        A.Q = (const f16*)(P.ws + WS_QB) + (size_t)b * SEQ * D + h * 128; A.K = (const f16*)(P.ws + WS_KB) + (size_t)b * SEQ * D + h * 128; A.V = (const f16*)(P.ws + WS_VB) + (size_t)b * SEQ * D + h * 128;
                        A.G = (const f16*)(P.ws + WS_GAB) + (size_t)b * SEQ * D + h * 128; A.O = (f16*)(P.ws + WS_MAB) + (size_t)b * SEQ * 2048 + 1024 + h * 128;
                        A.q0 = 128 * qb; A.nqw = 4; A.nkeys = SEQ; A.ntiles = 2 * qb + 2; A.h = h; A.wr0 = 2 * qb;
                        A.OK = P.out + OUT_KP + ((size_t)(l * NB + b) * SEQ) * D + h * 128; A.OV = P.out + OUT_VP + ((size_t)(l * NB + b) * SEQ) * D + h * 128; }

#ifndef DIS_ATT
 attn_task(P, A, l, qh);
#endif

                } else { const int t2 = t - (QN_SCANP + QN_ATTS + QN_ATTP);
#ifndef DIS_SCAN
 scan_task(P, true, qx, t2 & 7, l, qh);
#endif
 }
            }
        PROBE_T1(2); }
        SEAM(p + 2);
        if (IN(p + 3)) { asm volatile("; PHASE_MARK P4"); PROBE_T0(); PHASE_FRAME(P);
            pg8::Gemm g{(const pg8::bf16_t*)(P.ws + WS_MAB), (const pg8::bf16_t*)(P.ws + WS_WO2) + (size_t)l * D * 2048, MP, D, 2048};
            pg8::StaticOrder S; S.init(MP, D, P.G, P.bx);
            thin_gemm<16>(P, (const f16*)(P.ws + WS_MAB) + (size_t)MP * 2048, 2048, (const f16*)(P.ws + WS_WO2) + (size_t)l * D * 2048, 2048);
            EpiRes E{(f16*)(P.ws + WS_X), (const float*)(P.ws + WS_MOD) + (size_t)l * NBB * 6144 + 2048};

#ifndef DIS_G2
 pg8::gemm_phase<EpiRes, pg8::StaticOrder, true, true>(P.lds, g, S, E, P.tid);
#endif

        PROBE_T1(3); }
        SEAM(p + 3);
        if (IN(p + 4)) { asm volatile("; PHASE_MARK P5"); PROBE_T0(); PHASE_FRAME(P); ln_phase(P, false, false, inp(P, I_LN1G) + l * D, inp(P, I_LN1B) + l * D, (const float*)(P.ws + WS_MOD) + (size_t)l * NBB * 6144, 3072, 4096, (const float*)(P.ws + WS_MOD) + (size_t)l * NBB * 6144 + 2048); PROBE_T1(4); }
        SEAM(p + 4);
        if (IN(p + 5)) { asm volatile("; PHASE_MARK P6"); PROBE_T0(); PHASE_FRAME(P);
            pg8::Gemm g{(const pg8::bf16_t*)(P.ws + WS_H), (const pg8::bf16_t*)(P.ws + WS_WFI) + (size_t)l * 2 * DFF * D, M, 2 * DFF, D};
            pg8::StaticOrder S; S.init(M, 2 * DFF, P.G, P.bx);
            EpiSwiGLU E{(f16*)(P.ws + WS_ACT)};

#ifndef DIS_G3
 pg8::gemm_phase<EpiSwiGLU, pg8::StaticOrder, true, true>(P.lds, g, S, E, P.tid);
#endif

        PROBE_T1(5); }
        SEAM(p + 5);
        if (IN(p + 6)) { asm volatile("; PHASE_MARK P7"); PROBE_T0(); PHASE_FRAME(P);
            pg8::Gemm g{(const pg8::bf16_t*)(P.ws + WS_ACT), (const pg8::bf16_t*)(P.ws + WS_WFO) + (size_t)l * D * DFF, MP, D, DFF};
            pg8::StaticOrder S; S.init(MP, D, P.G, P.bx);
            thin_gemm<22>(P, (const f16*)(P.ws + WS_ACT) + (size_t)MP * DFF, DFF, (const f16*)(P.ws + WS_WFO) + (size_t)l * D * DFF, DFF);
            EpiRes E{(f16*)(P.ws + WS_X), (const float*)(P.ws + WS_MOD) + (size_t)l * NBB * 6144 + 5120};

#ifndef DIS_G2
 pg8::gemm_phase<EpiRes, pg8::StaticOrder, true, true>(P.lds, g, S, E, P.tid);
#endif

        PROBE_T1(6); }
        SEAM(p + 6);
        if (IN(p + 7)) { asm volatile("; PHASE_MARK P8"); PROBE_T0(); PHASE_FRAME(P); ln_phase(P, false, l == DEPTH - 1, inp(P, I_LN2G) + l * D, inp(P, I_LN2B) + l * D, (const float*)(P.ws + WS_MOD) + (size_t)(l == DEPTH - 1 ? l : l + 1) * NBB * 6144, 0, 1024, (const float*)(P.ws + WS_MOD) + (size_t)l * NBB * 6144 + 5120); PROBE_T1(7); }
        SEAM(p + 7);
    }
#undef IN
#undef SEAM
}

extern "C" void kernel_launch(void* const* d_in, const int* in_sizes, int n_in, void* d_out, int out_size, void* d_ws, size_t ws_size, hipStream_t stream) {
    static int grid = 0;
    if (grid == 0) {
        if (n_in != 27 || (size_t)out_size != OUT_END || ws_size < WS_END) { fprintf(stderr, "kernel_launch: unexpected shapes (n_in %d, out %d, ws %zu)\n", n_in, out_size, ws_size); grid = -1; return; }
        int dev = 0, cus = 0, per_cu = 0;
        if (hipGetDevice(&dev) != hipSuccess || hipDeviceGetAttribute(&cus, hipDeviceAttributeMultiprocessorCount, dev) != hipSuccess) { grid = -1; return; }
        if (hipFuncSetAttribute((const void*)mk_fwd, hipFuncAttributeMaxDynamicSharedMemorySize, LDS_BYTES) != hipSuccess) { fprintf(stderr, "kernel_launch: hipFuncSetAttribute failed\n"); grid = -1; return; }
        if (hipOccupancyMaxActiveBlocksPerMultiprocessor(&per_cu, (const void*)mk_fwd, NWAVES * 64, LDS_BYTES) != hipSuccess || per_cu < 1) { fprintf(stderr, "kernel_launch: occupancy query reports %d\n", per_cu); }
        (void)hipGetLastError();
        grid = cus;
    }
    if (grid < 0) return;
    if (hipMemsetAsync((char*)d_ws + WS_CTL, 0, CTL_ZERO_BYTES, stream) != hipSuccess) return;
    Args a{};
    for (int i = 0; i < 27; ++i) a.in[i] = (const float*)d_in[i];
    a.out = (float*)d_out; a.ws = (unsigned char*)d_ws;
#if MK_PER_PHASE
    for (int p = 0; p < N_PHASES; ++p) { a.ph_lo = p; a.ph_hi = p + 1; hipLaunchKernelGGL(mk_fwd, dim3(grid), dim3(NWAVES * 64), LDS_BYTES, stream, a); }
#else
    a.ph_lo = 0; a.ph_hi = N_PHASES;
    hipLaunchKernelGGL(mk_fwd, dim3(grid), dim3(NWAVES * 64), LDS_BYTES, stream, a);
#endif
}
```

```cpp
#include <hip/hip_runtime.h>
#include <cstdio>
#include <cstdint>

#define LAS __attribute__((address_space(3)))
#define GAS __attribute__((address_space(1)))
typedef _Float16 f16;
typedef _Float16 f16x2 __attribute__((ext_vector_type(2)));
typedef _Float16 f16x4 __attribute__((ext_vector_type(4)));
typedef _Float16 f16x8 __attribute__((ext_vector_type(8)));
typedef float f32x2 __attribute__((ext_vector_type(2)));
typedef float f32x4 __attribute__((ext_vector_type(4)));
typedef float f32x16 __attribute__((ext_vector_type(16)));
typedef unsigned u32x2 __attribute__((ext_vector_type(2)));
typedef unsigned u32x4 __attribute__((ext_vector_type(4)));
typedef short v4i16_t __attribute__((ext_vector_type(4)));

constexpr int D = 1024, NB = 16, SEQ = 2048, MP = NB * SEQ, NSB = 8, SSEQ = 32, MS = NSB * SSEQ, M = MP + MS, PAST = 2048, DEPTH = 4;
constexpr int NH = 8, DK = 128, CONVC = 3072, DFF = 2816, DIN = 9232, NPROJ = 9472;
constexpr int KSROWS = 2112;
constexpr float LN_EPS = 1e-5f;
constexpr float ALPHA = 1.6817928305074290f;
constexpr float LOG2E = 1.4426950408889634f;
constexpr int NBB = NB + NSB;

constexpr size_t OUT_YP = 0;
constexpr size_t OUT_YS = OUT_YP + (size_t)MP * D;
constexpr size_t OUT_KP = OUT_YS + (size_t)MS * D;
constexpr size_t OUT_VP = OUT_KP + (size_t)DEPTH * MP * D;
constexpr size_t OUT_CP = OUT_VP + (size_t)DEPTH * MP * D;
constexpr size_t OUT_DP = OUT_CP + (size_t)DEPTH * NB * 3 * CONVC;
constexpr size_t OUT_KS = OUT_DP + (size_t)DEPTH * NB * NH * DK * DK;
constexpr size_t OUT_VS = OUT_KS + (size_t)DEPTH * MS * D;
constexpr size_t OUT_CS = OUT_VS + (size_t)DEPTH * MS * D;
constexpr size_t OUT_DS = OUT_CS + (size_t)DEPTH * NSB * 3 * CONVC;
constexpr size_t OUT_END = OUT_DS + (size_t)DEPTH * NSB * NH * DK * DK;

constexpr size_t MiB = 1u << 20;
constexpr size_t WS_CTL = 0, CTL_ZERO_BYTES = 1 * MiB;
constexpr size_t WS_MOD = 1 * MiB;
constexpr size_t WS_MISC = 4 * MiB;
constexpr size_t WS_WIN = 5 * MiB;
constexpr size_t WS_WO2 = WS_WIN + 74 * MiB;
constexpr size_t WS_WFI = WS_WO2 + 16 * MiB;
constexpr size_t WS_WFO = WS_WFI + 44 * MiB;
constexpr size_t WS_X = WS_WFO + 22 * MiB;
constexpr size_t WS_H = WS_X + 129 * MiB;
constexpr size_t WS_QKVA = WS_H + 65 * MiB;
constexpr size_t WS_Z = WS_QKVA + 194 * MiB;
constexpr size_t WS_QB = WS_Z + 65 * MiB;
constexpr size_t WS_KB = WS_QB + 65 * MiB;
constexpr size_t WS_VB = WS_KB + 65 * MiB;
constexpr size_t WS_GAB = WS_VB + 65 * MiB;
constexpr size_t WS_BG = WS_GAB + 129 * MiB;
constexpr size_t WS_MAB = WS_BG + 3 * MiB;
constexpr size_t WS_ACT = WS_MAB + 129 * MiB;
constexpr size_t WS_DIMG = WS_ACT + 178 * MiB;
constexpr size_t WS_KS = WS_DIMG + 293 * MiB;
constexpr size_t WS_VS = WS_KS + 132 * MiB;
constexpr size_t WS_PART = WS_VS + 132 * MiB;
constexpr size_t WS_END = WS_PART + 8 * MiB;
static_assert(WS_END <= 2048 * MiB, "d_ws map");
constexpr int DIMG_BYTES = 73728, IMG_WK = 0, IMG_QG = 16384, IMG_QK = 32768, IMG_KT = 40960, IMG_UV = 57344, IMG_STAGE = 57344;
constexpr int N_DUNITS = NB * NH * 32 + NSB * NH;
constexpr int CW_BAR = 4096;
constexpr int CW_Q = 16384;

constexpr int RING_BYTES = 155648;
constexpr int LDSCTL_OFF = RING_BYTES;
constexpr int LDS_BYTES = 159 * 1024;
constexpr int NWAVES = 8;

__device__ __forceinline__ unsigned pk2h(float lo, float hi) { f32x2 v = {lo, hi}; f16x2 h = __builtin_convertvector(v, f16x2); return __builtin_bit_cast(unsigned, h); }
__device__ __forceinline__ u32x4 pk8h(f32x4 a, f32x4 b) { u32x4 w; w.x = pk2h(a[0], a[1]); w.y = pk2h(a[2], a[3]); w.z = pk2h(b[0], b[1]); w.w = pk2h(b[2], b[3]); return w; }
__device__ __forceinline__ float sigmoidf_(float x) { return __builtin_amdgcn_rcpf(1.0f + __expf(-x)); }
__device__ __forceinline__ float siluf_(float x) { return x * __builtin_amdgcn_rcpf(1.0f + __expf(-x)); }
__device__ __forceinline__ int crow(int r, int hi) { return (r & 3) + 8 * (r >> 2) + 4 * hi; }
#define LDS_WAIT() asm volatile("s_waitcnt lgkmcnt(0)" ::: "memory")
#define VM_WAIT() asm volatile("s_waitcnt vmcnt(0)" ::: "memory")

namespace pg8 {
#define PG8_LAS __attribute__((address_space(3)))
typedef unsigned short bf16_t;
typedef _Float16 bf16x8 __attribute__((ext_vector_type(8)));
typedef float f32x4 __attribute__((ext_vector_type(4)));
typedef unsigned u32x4 __attribute__((ext_vector_type(4)));
constexpr int BM = 256, BK = 64, HALF = 128, HTB = HALF * BK * 2  , STAGE_BYTES = 8 * HTB, NXCD = 8, WGM = 8;

__host__ __device__ __forceinline__ int lds_byte(int r, int c) { const int st = (r >> 4) * 2 + (c >> 5), rr = r & 15, cc = c & 31, ob = rr * 64 + cc * 2; return st * 1024 + (ob ^ (((ob >> 9) & 1) << 5)); }
__host__ __device__ __forceinline__ void stage_rc(int b, int& R, int& C) { const int st = b / 1024, sb = b % 1024, swz = sb ^ (((sb >> 9) & 1) << 5); R = (st >> 1) * 16 + swz / 64; C = (st & 1) * 32 + (swz % 64) / 2; }
__host__ __device__ __forceinline__ int perm32(int rho) { const int n = rho >> 4, i = rho & 15; return 8 * (i >> 2) + 4 * n + (i & 3); }

struct Unit { int pm, pn; };
struct Gemm { const bf16_t* A; const bf16_t* Bt; int M, N, K; };

struct StaticOrder {
    int nM, nN, nwg, G, c, rot = 0;
    __host__ __device__ void init(int M, int N, int G_, int c_) { nM = M / BM; nN = N / BM; nwg = nM * nN; G = G_; c = c_; }
    __host__ __device__ bool next(int i, Unit& u) const {
        const long L = (long)i * G + c; if (L >= nwg) return false;
        int wgid = (int)L; { const int q = nwg / NXCD, r = nwg % NXCD, xcd = wgid % NXCD; int off = wgid / NXCD; if (rot) off = (off + xcd * rot) % (q + (xcd < r ? 1 : 0)); wgid = (xcd < r ? xcd * (q + 1) : r * (q + 1) + (xcd - r) * q) + off; }
        const int nig = WGM * nN, gid = wgid / nig, fm = gid * WGM, gsz = (nM - fm) < WGM ? (nM - fm) : WGM;
        u.pm = fm + ((wgid % nig) % gsz); u.pn = (wgid % nig) / gsz; return true;
    }
    __device__ __forceinline__ void a_ready(const Unit&) const {}
    __device__ __forceinline__ void done(const Unit&) const {}
};
template <class Epi, class Sched, bool ALIGN_EPI = false, bool SP2 = false>
__device__ __forceinline__ void gemm_phase(PG8_LAS unsigned char* lds, const Gemm g, const Sched& S, const Epi& E, int tid_in) {
    int tid_ = tid_in; asm volatile("" : "+v"(tid_));
    const int tid = tid_, wid = __builtin_amdgcn_readfirstlane(tid >> 6), lane = tid & 63, wr = wid >> 2, wc = wid & 3, fr = lane & 15, fq = lane >> 4;
    const int K = g.K, nt = K / BK;
    unsigned voffA[2], voffB[2];
#pragma unroll
    for (int i = 0; i < 2; ++i) { int R, C; stage_rc(tid * 16 + i * 8192, R, C); const int Rb = Epi::PERM ? ((R & ~31) + perm32(R & 31)) : R;
        voffA[i] = (unsigned)(R * K + C) * 2u; voffB[i] = (unsigned)(Rb * K + C) * 2u; }
    const size_t kstep = (size_t)(BK * 2);
    const size_t hstep = (size_t)HALF * K * 2;
    const size_t tstep = 2 * hstep;
    const unsigned ldsw = (unsigned)wid * 1024u;
    const int aoff = lds_byte(wr * 64 + fr, fq * 8), boff = lds_byte(wc * 32 + fr, fq * 8);
#define PG8_SA(b, h) (((b) * 2 + (h)) * HTB)
#define PG8_SB(b, h) ((4 + (b) * 2 + (h)) * HTB)
#define PG8_STAGE(bufoff, gbase, voff) do { _Pragma("unroll") for (int _i = 0; _i < 2; ++_i) \
        __builtin_amdgcn_global_load_lds((const unsigned*)((const char*)(gbase) + (voff)[_i]), (PG8_LAS unsigned*)(lds + (bufoff) + ldsw + _i * 8192), 16, 0, 0); } while (0)
#define PG8_LDA(dst, b, h) do { _Pragma("unroll") for (int m = 0; m < 4; ++m) _Pragma("unroll") for (int k = 0; k < 2; ++k) dst[m][k] = *(const PG8_LAS bf16x8*)(lds + PG8_SA(b, h) + aoff + m * 2048 + k * 1024); } while (0)
#define PG8_LDB(dst, b, h) do { _Pragma("unroll") for (int n = 0; n < 2; ++n) _Pragma("unroll") for (int k = 0; k < 2; ++k) dst[n][k] = *(const PG8_LAS bf16x8*)(lds + PG8_SB(b, h) + boff + n * 2048 + k * 1024); } while (0)
#define PG8_MMA(ai, bj, At, Bt) do { __builtin_amdgcn_s_setprio(1); _Pragma("unroll") for (int m = 0; m < 4; ++m) _Pragma("unroll") for (int n = 0; n < 2; ++n) _Pragma("unroll") for (int k = 0; k < 2; ++k) \
        acc[ai][bj][m][n] = __builtin_amdgcn_mfma_f32_16x16x32_f16(Bt[n][k], At[m][k], acc[ai][bj][m][n], 0, 0, 0); __builtin_amdgcn_s_setprio(0); } while (0)
#define PG8_WAIT_V(n) asm volatile("s_waitcnt vmcnt(" #n ")" ::: "memory")
#define PG8_WAIT_L(n) asm volatile("s_waitcnt lgkmcnt(" #n ")" ::: "memory")
#define PG8_BAR __builtin_amdgcn_s_barrier()
#define PG8_SCHED __builtin_amdgcn_sched_barrier(0)
    Unit cur, nxt; int ui = 0;
    if (!S.next(0, cur)) return;
    f32x4 acc[2][2][4][2];
#pragma unroll
    for (int a = 0; a < 2; ++a)
#pragma unroll
        for (int b = 0; b < 2; ++b)
#pragma unroll
            for (int m = 0; m < 4; ++m)
#pragma unroll
                for (int n = 0; n < 2; ++n) acc[a][b][m][n] = (f32x4){0.f, 0.f, 0.f, 0.f};
    bf16x8 At[4][2], B0[2][2], B1[2][2];
    const char* cA = (const char*)g.A + (size_t)cur.pm * tstep; const char* cB = (const char*)g.Bt + (size_t)cur.pn * tstep;
    S.a_ready(cur);
    if constexpr (SP2) {
        PG8_STAGE(PG8_SB(0, 0), cB, voffB); PG8_STAGE(PG8_SB(0, 1), cB + hstep, voffB); PG8_STAGE(PG8_SA(0, 0), cA, voffA); PG8_STAGE(PG8_SA(0, 1), cA + hstep, voffA);
        if (wr == 1) PG8_BAR;
        PG8_WAIT_V(2); PG8_BAR;
        PG8_STAGE(PG8_SB(1, 0), cB + kstep, voffB); PG8_STAGE(PG8_SA(1, 0), cA + kstep, voffA); PG8_STAGE(PG8_SB(1, 1), cB + hstep + kstep, voffB);
        PG8_WAIT_V(6); PG8_BAR;
    } else {
        PG8_STAGE(PG8_SB(0, 0), cB, voffB); PG8_STAGE(PG8_SA(0, 0), cA, voffA); PG8_STAGE(PG8_SB(0, 1), cB + hstep, voffB); PG8_STAGE(PG8_SA(0, 1), cA + hstep, voffA);
        if (wr == 1) PG8_BAR;
        PG8_WAIT_V(4); PG8_BAR;
        PG8_STAGE(PG8_SB(1, 0), cB + kstep, voffB); PG8_STAGE(PG8_SA(1, 0), cA + kstep, voffA); PG8_STAGE(PG8_SB(1, 1), cB + hstep + kstep, voffB);
        PG8_WAIT_V(6); PG8_BAR;
    }
    for (;;) {
        const bool has_next = S.next(ui + 1, nxt);
        const char* nA = has_next ? (const char*)g.A + (size_t)nxt.pm * tstep : cA; const char* nB = has_next ? (const char*)g.Bt + (size_t)nxt.pn * tstep : cB;
        for (int t = 0; t < nt; t += 2) {
            const bool last = (t == nt - 2);
            const char* a1 = cA + (size_t)(t + 1) * kstep;
            const char* a2 = last ? nA : cA + (size_t)(t + 2) * kstep; const char* b2 = last ? nB : cB + (size_t)(t + 2) * kstep;
            const char* a3 = a2 + kstep; const char* b3 = b2 + kstep;
            if (last && has_next) S.a_ready(nxt);
            if constexpr (SP2) {
            PG8_LDB(B0, 0, 0); PG8_LDB(B1, 0, 1); PG8_SCHED; PG8_LDA(At, 0, 0); PG8_STAGE(PG8_SA(1, 1), a1 + hstep, voffA);
            PG8_WAIT_V(8); PG8_WAIT_L(0); PG8_BAR; PG8_MMA(0, 0, At, B0); PG8_MMA(0, 1, At, B1); PG8_BAR; PG8_SCHED;
            PG8_LDA(At, 0, 1); PG8_STAGE(PG8_SB(0, 0), b2, voffB); PG8_STAGE(PG8_SB(0, 1), b2 + hstep, voffB); PG8_STAGE(PG8_SA(0, 0), a2, voffA);
            PG8_WAIT_V(8); PG8_WAIT_L(0); PG8_BAR; PG8_MMA(1, 0, At, B0); PG8_MMA(1, 1, At, B1); PG8_BAR; PG8_SCHED;
            PG8_LDB(B0, 1, 0); PG8_LDB(B1, 1, 1); PG8_SCHED; PG8_LDA(At, 1, 0); PG8_STAGE(PG8_SA(0, 1), a2 + hstep, voffA);
            PG8_WAIT_V(8); PG8_WAIT_L(0); PG8_BAR; PG8_MMA(0, 0, At, B0); PG8_MMA(0, 1, At, B1); PG8_BAR; PG8_SCHED;
            PG8_LDA(At, 1, 1); PG8_STAGE(PG8_SB(1, 0), b3, voffB); PG8_STAGE(PG8_SB(1, 1), b3 + hstep, voffB); PG8_STAGE(PG8_SA(1, 0), a3, voffA);
            PG8_WAIT_V(8); PG8_WAIT_L(0); PG8_BAR; PG8_MMA(1, 0, At, B0); PG8_MMA(1, 1, At, B1); PG8_BAR; PG8_SCHED;
            } else {
            PG8_LDB(B0, 0, 0); PG8_SCHED; PG8_LDA(At, 0, 0); PG8_STAGE(PG8_SA(1, 1), a1 + hstep, voffA);
            PG8_WAIT_L(8); PG8_BAR; PG8_WAIT_L(0); PG8_MMA(0, 0, At, B0); PG8_BAR; PG8_SCHED;
            PG8_LDB(B1, 0, 1); PG8_STAGE(PG8_SB(0, 0), b2, voffB);
            PG8_BAR; PG8_WAIT_L(0); PG8_MMA(0, 1, At, B1); PG8_BAR;
            PG8_LDA(At, 0, 1); PG8_STAGE(PG8_SA(0, 0), a2, voffA);
            PG8_BAR; PG8_WAIT_L(0); PG8_MMA(1, 0, At, B0); PG8_BAR; PG8_SCHED;
            PG8_STAGE(PG8_SB(0, 1), b2 + hstep, voffB);
            PG8_WAIT_V(6); PG8_BAR; PG8_MMA(1, 1, At, B1); PG8_BAR;
            PG8_LDB(B0, 1, 0); PG8_SCHED; PG8_LDA(At, 1, 0); PG8_STAGE(PG8_SA(0, 1), a2 + hstep, voffA);
            PG8_WAIT_L(8); PG8_BAR; PG8_WAIT_L(0); PG8_MMA(0, 0, At, B0); PG8_BAR; PG8_SCHED;
            PG8_LDB(B1, 1, 1); PG8_STAGE(PG8_SB(1, 0), b3, voffB);
            PG8_BAR; PG8_WAIT_L(0); PG8_MMA(0, 1, At, B1); PG8_BAR;
            PG8_LDA(At, 1, 1); PG8_STAGE(PG8_SA(1, 0), a3, voffA);
            PG8_BAR; PG8_WAIT_L(0); PG8_MMA(1, 0, At, B0); PG8_BAR; PG8_SCHED;
            PG8_STAGE(PG8_SB(1, 1), b3 + hstep, voffB);
            PG8_WAIT_V(6); PG8_BAR; PG8_MMA(1, 1, At, B1); PG8_BAR;
            }
        }
        if constexpr (ALIGN_EPI) { if (wr == 0) PG8_BAR; }
        if constexpr (!Epi::AFTER_DRAIN) { E(acc, cur, wr, wc, fr, fq); S.done(cur); }
        if (!has_next) break;
#pragma unroll
        for (int a = 0; a < 2; ++a)
#pragma unroll
            for (int b = 0; b < 2; ++b)
#pragma unroll
                for (int m = 0; m < 4; ++m)
#pragma unroll
                    for (int n = 0; n < 2; ++n) acc[a][b][m][n] = (f32x4){0.f, 0.f, 0.f, 0.f};
        cur = nxt; cA = nA; cB = nB; ++ui;
        if constexpr (ALIGN_EPI) { if (wr == 1) PG8_BAR; }
    }
    PG8_WAIT_V(0);
    if constexpr (!ALIGN_EPI) { if (wr == 0) PG8_BAR; }
    PG8_BAR;
    if constexpr (Epi::AFTER_DRAIN) { E.fused(acc, cur, wr, wc, fr, fq, lds, wid, lane); S.done(cur); }
#undef PG8_SA
#undef PG8_SB
#undef PG8_STAGE
#undef PG8_LDA
#undef PG8_LDB
#undef PG8_MMA
#undef PG8_WAIT_V
#undef PG8_WAIT_L
#undef PG8_BAR
#undef PG8_SCHED
}
}

#define XB_TMO      128
#define XB_XCNT(j)  (256  + 64 * (j))
#define XB_XSUB(j)  (1280 + 64 * (j))
#define XB_XGEN(j)  (2304 + 64 * (j))
#define XB_TOP      3328
#define XB_TOPGEN   3392
#define XCD_BAR_WORDS 3456
#define XB_SPIN_CAP (1u << 18)

__device__ __forceinline__ unsigned xb_ld(unsigned* p)              { return __hip_atomic_load(p, __ATOMIC_RELAXED, __HIP_MEMORY_SCOPE_AGENT); }
__device__ __forceinline__ unsigned xb_add(unsigned* p, unsigned v) { return __hip_atomic_fetch_add(p, v, __ATOMIC_RELAXED, __HIP_MEMORY_SCOPE_AGENT); }
__device__ __forceinline__ unsigned xb_xcc_id() { return (unsigned)__builtin_amdgcn_s_getreg((3 << 11) | 20) & 0xFu; }
#define XB_SPIN(cond, bar) do { unsigned _sp = 0; while (cond) { __builtin_amdgcn_s_sleep(1); \
    if ((++_sp & 255u) == 0u) { if (xb_ld(&(bar)[XB_TMO])) break; if (_sp > XB_SPIN_CAP) { atomicAdd(&(bar)[XB_TMO], 1u); break; } } } } while (0)

struct XcdBarrier {
    unsigned* bar; unsigned x;
    volatile LAS unsigned* st;
};

__device__ __forceinline__ XcdBarrier xcd_barrier_post(unsigned* bar, volatile LAS unsigned* st) {
    XcdBarrier b; b.bar = bar; b.x = xb_xcc_id(); b.st = st;
    if (threadIdx.x == 0) (void)xb_add(&bar[XB_XCNT(b.x)], 1u);
    return b;
}
__device__ __forceinline__ void xcd_barrier_complete(unsigned* bar, unsigned x, unsigned& nloc, unsigned& nx) {
    const unsigned G = gridDim.x * gridDim.y * gridDim.z;
    unsigned sum, cnt, mine, sp = 0u;
    for (;;) {
        sum = 0u; cnt = 0u; mine = 0u;
#pragma unroll
        for (unsigned j = 0; j < 16; ++j) { const unsigned c = xb_ld(&bar[XB_XCNT(j)]); sum += c; cnt += (c > 0u) ? 1u : 0u; mine = (j == x) ? c : mine; }
        if (sum == G) break;
        __builtin_amdgcn_s_sleep(1);
        if ((++sp & 255u) == 0u) { if (xb_ld(&bar[XB_TMO])) break; if (sp > XB_SPIN_CAP) { atomicAdd(&bar[XB_TMO], 1u); break; } }
    }
    nloc = mine > 0u ? mine : 1u; nx = cnt > 0u ? cnt : 1u;
}

__device__ __forceinline__ void xcd_barrier(const XcdBarrier& b) {
    asm volatile("s_waitcnt vmcnt(0)" ::: "memory");
    __syncthreads();
    if (threadIdx.x == 0) {
        unsigned* bar = b.bar;
        __builtin_amdgcn_s_waitcnt(0);
        unsigned nloc = b.st[0], nx = b.st[1];
        if (nloc == 0u) { xcd_barrier_complete(bar, b.x, nloc, nx); b.st[0] = nloc; b.st[1] = nx; }
        const unsigned old = xb_add(&bar[XB_XSUB(b.x)], 1u);
        const unsigned gen = old / nloc;
        if (old + 1u == (gen + 1u) * nloc) {
            __builtin_amdgcn_fence(__ATOMIC_RELEASE, "agent");
            asm volatile("s_waitcnt vmcnt(0)" ::: "memory");
            const unsigned og = xb_add(&bar[XB_TOP], 1u);
            const unsigned tg = og / nx;
            if (og + 1u == (tg + 1u) * nx) xb_add(&bar[XB_TOPGEN], 1u);
            else XB_SPIN(xb_ld(&bar[XB_TOPGEN]) == tg, bar);
            __builtin_amdgcn_fence(__ATOMIC_ACQUIRE, "agent");
            xb_add(&bar[XB_XGEN(b.x)], 1u);
            asm volatile("s_waitcnt vmcnt(0)" ::: "memory");
        } else {
            XB_SPIN(xb_ld(&bar[XB_XGEN(b.x)]) == gen, bar);
            __builtin_amdgcn_fence(__ATOMIC_ACQUIRE, "agent");
            asm volatile("s_waitcnt vmcnt(0)" ::: "memory");
        }
    }
    __syncthreads();
}


struct Frame {
    LAS unsigned char* lds;
    volatile LAS unsigned* MISC;
    unsigned* ctl;
    int tid, lane, wave, vcu, G, bx;
    float* out;
    unsigned char* ws;
};
enum { I_XP = 0, I_XS, I_CK, I_CV, I_SCONV, I_SDELTA, I_CP, I_CS, I_LNG, I_LNB, I_RELB, I_WADA, I_BADA, I_WIN, I_CONVW, I_ALOG, I_DTB, I_NORMA, I_LAM, I_SUBLN, I_WO, I_LN1G, I_LN1B, I_WFI, I_WFO, I_LN2G, I_LN2B };

constexpr int LDS_INP_OFF = LDSCTL_OFF + 256;
__device__ __forceinline__ const float* inp(const Frame& F, int i) {
    const unsigned long long v = *((volatile LAS unsigned long long*)(F.lds + LDS_INP_OFF) + i);
    const unsigned lo = __builtin_amdgcn_readfirstlane((unsigned)v), hi = __builtin_amdgcn_readfirstlane((unsigned)(v >> 32));
    return (const float*)(const GAS float*)(((unsigned long long)hi << 32) | lo);
}
template <class T> __device__ __forceinline__ T* as_global(T* p) { return (T*)(GAS T*)(unsigned long long)p; }
__device__ __forceinline__ int hw_lane() { int l; asm volatile("v_mbcnt_lo_u32_b32 %0, -1, 0\n\tv_mbcnt_hi_u32_b32 %0, -1, %0" : "=v"(l)); return l; }
#define PHASE_FRAME(P) Frame P = F; P.lane = hw_lane(); \
    asm volatile("" : "+s"(P.ws), "+s"(P.out), "+s"(P.ctl), "+s"(P.G), "+s"(P.vcu), "+s"(P.bx), "+s"(P.wave)); P.tid = P.wave * 64 + P.lane; \
    P.ws = as_global(P.ws); P.out = as_global(P.out); P.ctl = as_global(P.ctl)
__device__ __forceinline__ unsigned char* ws_of(const Frame& F) { unsigned char* w = F.ws; asm volatile("" : "+s"(w)); return as_global(w); }
__device__ __forceinline__ float wave_sum(float v) {
#pragma unroll
    for (int o = 1; o < 64; o <<= 1) v += __shfl_xor(v, o);
    return v;
}
__device__ __forceinline__ f32x16 mfma32(f16x8 a, f16x8 b, f32x16 c) { return __builtin_amdgcn_mfma_f32_32x32x16_f16(a, b, c, 0, 0, 0); }
__device__ __forceinline__ f16x8 cvt8(const f32x16& v, int o) {
    u32x4 w; w.x = pk2h(v[o], v[o + 1]); w.y = pk2h(v[o + 2], v[o + 3]); w.z = pk2h(v[o + 4], v[o + 5]); w.w = pk2h(v[o + 6], v[o + 7]); return __builtin_bit_cast(f16x8, w);
}

__device__ __forceinline__ int bb_of_row(int row) { return row < MP ? (row >> 11) : NB + ((row - MP) >> 5); }

#define EPI_ROWS(BODY) _Pragma("unroll") for (int ai = 0; ai < 2; ++ai) _Pragma("unroll") for (int m = 0; m < 4; ++m) { const int row = u.pm * 256 + ai * 128 + wr * 64 + m * 16 + fr; \
        _Pragma("unroll") for (int bj = 0; bj < 2; ++bj) { const int c = cb0 + bj * 128; const f32x4 v0 = acc[ai][bj][m][0], v1 = acc[ai][bj][m][1]; BODY } }
struct EpiProj {
    static constexpr bool PERM = true, AFTER_DRAIN = false;
    f16 *QKVA, *Z, *QB, *KB, *VB, *GAB; float* BG; f16 *KS, *VS; float* out; int layer;
    __device__ __forceinline__ void operator()(const f32x4 (&acc)[2][2][4][2], const pg8::Unit& u, int wr, int wc, int fr, int fq) const {
        asm volatile("" : "+v"(fr), "+v"(fq));
        const int pn = u.pn; const bool samp = u.pm == MP / 256;
        const int cb0 = (pn * 256 + wc * 32 + 8 * fq) - (pn < 12 ? 0 : pn < 24 ? 5120 : pn < 28 ? 6144 : pn < 32 ? 7168 : pn < 36 ? 8192 : 9216);
        if (pn < 12) {
            EPI_ROWS( *(u32x4*)(QKVA + (size_t)row * CONVC + c) = pk8h(v0, v1);
                      const int t = samp ? ((row - MP) & 31) - 29 : (row & 2047) - 2045;
                      if (t >= 0) { float* o = out + (samp ? OUT_CS + ((size_t)(layer * NSB + ((row - MP) >> 5)) * 3 + t) * CONVC : OUT_CP + ((size_t)(layer * NB + (row >> 11)) * 3 + t) * CONVC) + c;
                                    __builtin_nontemporal_store(v0, (f32x4*)o); __builtin_nontemporal_store(v1, (f32x4*)(o + 4)); } )
        } else if (pn < 20) {
            _Pragma("unroll") for (int ai = 0; ai < 2; ++ai) _Pragma("unroll") for (int m = 0; m < 4; ++m) { const int row = u.pm * 256 + ai * 128 + wr * 64 + m * 16 + fr;
                f32x4 a0, a1;
                _Pragma("unroll") for (int i = 0; i < 4; ++i) { a0[i] = siluf_(acc[ai][0][m][0][i]) * sigmoidf_(acc[ai][1][m][0][i]); a1[i] = siluf_(acc[ai][0][m][1][i]) * sigmoidf_(acc[ai][1][m][1][i]); }
                *(u32x4*)(Z + (size_t)row * D + (pn - 12) * 128 + wc * 32 + 8 * fq) = pk8h(a0, a1); }
        } else if (pn < 24) {
            const float sc = 0.125f * LOG2E;
            EPI_ROWS( *(u32x4*)(QB + (size_t)row * D + c) = pk8h(v0 * sc, v1 * sc); )
        } else if (pn < 32) {
            const bool isk = pn < 28;
            if (!samp) { f16* dst = isk ? KB : VB;
                EPI_ROWS( *(u32x4*)(dst + (size_t)row * D + c) = pk8h(v0, v1); )
            } else { f16* dst = isk ? KS : VS; float* ob = out + (isk ? OUT_KS : OUT_VS) + (size_t)layer * MS * D;
                EPI_ROWS( const int sr = row - MP; *(u32x4*)(dst + ((size_t)(sr >> 5) * KSROWS + PAST + (sr & 31)) * D + c) = pk8h(v0, v1); float* o = ob + (size_t)sr * D + c; __builtin_nontemporal_store(v0, (f32x4*)o); __builtin_nontemporal_store(v1, (f32x4*)(o + 4)); )
            }
        } else if (pn < 36) {
            EPI_ROWS( f32x4 s0; f32x4 s1;
                      _Pragma("unroll") for (int i = 0; i < 4; ++i) { s0[i] = sigmoidf_(v0[i]); s1[i] = sigmoidf_(v1[i]); }
                      *(u32x4*)(GAB + (size_t)row * D + c) = pk8h(s0, s1); )
        } else {
            if (wc == 0 && fq < 2) {
                EPI_ROWS( if (bj == 0) { *(f32x4*)(BG + (size_t)row * 16 + c) = v0; *(f32x4*)(BG + (size_t)row * 16 + c + 4) = v1; } )
            }
        }
    }
};
#undef EPI_ROWS
struct EpiRes {
    static constexpr bool PERM = false, AFTER_DRAIN = false;
    f16* X; const float* gate;
    __device__ __forceinline__ void operator()(const f32x4 (&acc)[2][2][4][2], const pg8::Unit& u, int wr, int wc, int fr, int fq) const {
        asm volatile("" : "+v"(fr), "+v"(fq));
#pragma unroll
        for (int ai = 0; ai < 2; ++ai)
#pragma unroll
            for (int m = 0; m < 4; ++m) {
                const int row = u.pm * 256 + ai * 128 + wr * 64 + m * 16 + fr;
                const float* gp = gate + (size_t)bb_of_row(row) * 6144; f16* xp = X + (size_t)row * D;
#pragma unroll
                for (int bj = 0; bj < 2; ++bj)
#pragma unroll
                    for (int n = 0; n < 2; ++n) {
                        const int c = u.pn * 256 + bj * 128 + wc * 32 + n * 16 + 4 * fq;
                        const f32x4 g = *(const f32x4*)(gp + c); const f16x4 xh = *(const f16x4*)(xp + c);
                        const f32x4 x = (f32x4){(float)xh[0], (float)xh[1], (float)xh[2], (float)xh[3]} * ALPHA + g * acc[ai][bj][m][n];
                        u32x2 w; w.x = pk2h(x[0], x[1]); w.y = pk2h(x[2], x[3]); *(u32x2*)(xp + c) = w;
                    }
                asm volatile("" ::: "memory");
            }
    }
};
struct EpiSwiGLU {
    static constexpr bool PERM = true, AFTER_DRAIN = false;
    f16* ACT;
    __device__ __forceinline__ void operator()(const f32x4 (&acc)[2][2][4][2], const pg8::Unit& u, int wr, int wc, int fr, int fq) const {
        asm volatile("" : "+v"(fr), "+v"(fq));
#pragma unroll
        for (int ai = 0; ai < 2; ++ai)
#pragma unroll
            for (int m = 0; m < 4; ++m) {
                const int row = u.pm * 256 + ai * 128 + wr * 64 + m * 16 + fr;
                f32x4 a0, a1;
#pragma unroll
                for (int i = 0; i < 4; ++i) { a0[i] = siluf_(acc[ai][0][m][0][i]) * acc[ai][1][m][0][i]; a1[i] = siluf_(acc[ai][0][m][1][i]) * acc[ai][1][m][1][i]; }
                *(u32x4*)(ACT + (size_t)row * DFF + u.pn * 128 + wc * 32 + 8 * fq) = pk8h(a0, a1);
            }
    }
};

__device__ __forceinline__ void cache_slice_load(Frame& F, int layer, int k, f32x4 (&v)[4]) {
#pragma unroll
    for (int j = 0; j < 2; ++j) {
        const size_t c = (size_t)F.vcu * 16384 + (size_t)k * 1024 + F.tid + 512 * j;
        const bool isv = c >= (size_t)NSB * PAST * D / 8; const size_t cc = isv ? c - (size_t)NSB * PAST * D / 8 : c;
        const float* src = inp(F, isv ? I_CV : I_CK) + (size_t)layer * NSB * PAST * D + cc * 8;
        v[2 * j] = *(const f32x4*)src; v[2 * j + 1] = *(const f32x4*)(src + 4);
    }
}
__device__ __forceinline__ void cache_slice_store(Frame& F, int layer, int k, const f32x4 (&v)[4]) {
#pragma unroll
    for (int j = 0; j < 2; ++j) {
        const size_t c = (size_t)F.vcu * 16384 + (size_t)k * 1024 + F.tid + 512 * j;
        const bool isv = c >= (size_t)NSB * PAST * D / 8; const size_t cc = isv ? c - (size_t)NSB * PAST * D / 8 : c;
        const size_t sb = cc / (PAST * D / 8), rem = cc % (PAST * D / 8);
        f16* dst = (f16*)(F.ws + (isv ? WS_VS : WS_KS)) + ((size_t)layer * NSB + sb) * KSROWS * D + rem * 8;
        *(u32x4*)dst = pk8h(v[2 * j], v[2 * j + 1]);
    }
}

template <int NSTEP  > __device__ __forceinline__ void thin_gemm(Frame& F, const f16* A, int lda, const f16* Bt, int K) {
    const int w = F.vcu * NWAVES + F.wave; if (w >= 2048) return;
    const int rb = w & 7, cg = (w >> 3) & 31, ks = w >> 8, r32 = F.lane & 31, hi = F.lane >> 5;
    const f16* ap = A + (size_t)(32 * rb + r32) * lda + ks * (16 * NSTEP) + 8 * hi;
    const f16* bp = Bt + (size_t)(32 * cg + r32) * K + ks * (16 * NSTEP) + 8 * hi;
    f32x16 acc = {};
    constexpr int HB = NSTEP / 2;
#pragma unroll
    for (int h0 = 0; h0 < NSTEP; h0 += HB) {
        f16x8 av[HB], bv[HB];
#pragma unroll
        for (int s = 0; s < HB; ++s) { av[s] = *(const f16x8*)(ap + 16 * (h0 + s)); bv[s] = *(const f16x8*)(bp + 16 * (h0 + s)); }
#pragma unroll
        for (int s = 0; s < HB; ++s) acc = mfma32(av[s], bv[s], acc);
    }
    float* pp = (float*)(F.ws + WS_PART) + ((size_t)ks * MS + 32 * rb) * D + 32 * cg + r32;
#pragma unroll
    for (int r = 0; r < 16; ++r) pp[(size_t)crow(r, hi) * D] = acc[r];
}

__device__ __forceinline__ int win_src_col(int d) {
    if (d < 3072) return d;
    if (d < 5120) { const int t = (d - 3072) >> 8, j = (d - 3072) & 255; return j < 128 ? 3072 + 128 * t + j : 7184 + 128 * t + (j - 128); }
    if (d < 8192) return d - 5120 + 4112;
    if (d < 9216) return d - 8192 + 8208;
    if (d < 9232) return d - 9216 + 4096;
    return -1;
}
__device__ __forceinline__ int wfi_src_col(int d) { const int t = d >> 8, w = d & 255; return w < 128 ? 128 * t + w : DFF + 128 * t + (w - 128); }
__device__ __forceinline__ void transpose_item(const float* W, int ldw, int ksrc0, int srccol, f16* WT, int ldwt, int drow0, int kdst0, LAS float* scr, int lane) {
#pragma unroll 8
    for (int i = 0; i < 32; ++i) { const int kk = 2 * i + (lane >> 5); scr[kk * 33 + (lane & 31)] = srccol >= 0 ? W[(size_t)(ksrc0 + kk) * ldw + srccol] : 0.f; }
    LDS_WAIT(); asm volatile("" ::: "memory");
    const int c = lane & 7;
#pragma unroll
    for (int j = 0; j < 4; ++j) { const int n = (lane >> 3) + 8 * j; const LAS float* s = scr + (8 * c) * 33 + n;
        u32x4 o; o.x = pk2h(s[0 * 33], s[1 * 33]); o.y = pk2h(s[2 * 33], s[3 * 33]); o.z = pk2h(s[4 * 33], s[5 * 33]); o.w = pk2h(s[6 * 33], s[7 * 33]);
        *(u32x4*)(WT + (size_t)(drow0 + n) * ldwt + kdst0 + 8 * c) = o; }
    LDS_WAIT(); asm volatile("" ::: "memory");
}
__device__ __forceinline__ int t5_bucket(int rel) {
    const int n = rel < 0 ? -rel : rel;
    const int large = 8 + (n >= 12) + (n >= 16) + (n >= 23) + (n >= 32) + (n >= 46) + (n >= 64) + (n >= 91);
    return (rel > 0 ? 16 : 0) + (n < 8 ? n : large);
}
__device__ __forceinline__ void p0a_prologue(Frame& F) {
    const int gw = F.vcu * NWAVES + F.wave, NGW = F.G * NWAVES;
    const int gt = F.vcu * 512 + F.tid, NGT = F.G * 512;
    if (F.vcu < 192) {
        LAS float* sT = (LAS float*)F.lds;
        LAS float* red = (LAS float*)(F.lds + 98304);
        for (int i = F.tid; i < NBB * D; i += 512) { const int bb = i >> 10, d = i & 1023; const float c = bb < NB ? inp(F, I_CP)[bb * D + d] : inp(F, I_CS)[(bb - NB) * D + d]; sT[d * NBB + bb] = siluf_(c); }
        __syncthreads();
        const int cidx = F.vcu * 128 + (F.tid & 127), l = cidx / 6144, e = cidx % 6144, dq = F.tid >> 7;
        float acc[NBB];
#pragma unroll
        for (int b = 0; b < NBB; ++b) acc[b] = 0.f;
        const float* wp = inp(F, I_WADA) + ((size_t)l * D + dq * 256) * 6144 + e;
#pragma unroll 4
        for (int d = 0; d < 256; ++d) {
            const float w = wp[(size_t)d * 6144];
            const LAS f32x4* sp = (const LAS f32x4*)(sT + (dq * 256 + d) * NBB);
#pragma unroll
            for (int q = 0; q < 6; ++q) { const f32x4 s = sp[q]; acc[4 * q] += s[0] * w; acc[4 * q + 1] += s[1] * w; acc[4 * q + 2] += s[2] * w; acc[4 * q + 3] += s[3] * w; }
        }
        for (int r = 0; r < 4; ++r) {
            if (dq == r) {
#pragma unroll
                for (int b = 0; b < NBB; ++b) { LAS float* p = red + b * 128 + (F.tid & 127); *p = (r == 0 ? 0.f : *p) + acc[b]; }
            }
            __syncthreads();
        }
        float* mod = (float*)(F.ws + WS_MOD);
        for (int i = F.tid; i < NBB * 128; i += 512) { const int b = i >> 7, cc = i & 127; const int ci = F.vcu * 128 + cc, ll = ci / 6144, ee = ci % 6144;
            mod[((size_t)ll * NBB + b) * 6144 + ee] = red[b * 128 + cc] + inp(F, I_BADA)[ll * 6144 + ee]; }
        __syncthreads();
    }
    {
        LAS float* scr = (LAS float*)(F.lds + F.wave * 16384);
        constexpr int I_IN = 16 * (NPROJ / 32), I_O = 32 * 32, I_FI = 16 * (2 * DFF / 32), I_FO = (DFF / 64) * 32, I_L = I_IN + I_O + I_FI + I_FO;
        for (int it = gw; it < DEPTH * I_L; it += NGW) {
            const int l = it / I_L; int r = it % I_L;
            if (r < I_IN) { const int kb = r / (NPROJ / 32), nb = r % (NPROJ / 32);
                transpose_item(inp(F, I_WIN) + (size_t)l * D * DIN, DIN, 64 * kb, win_src_col(32 * nb + (F.lane & 31)), (f16*)(F.ws + WS_WIN) + (size_t)l * NPROJ * D, D, 32 * nb, 64 * kb, scr, F.lane); continue; }
            r -= I_IN;
            if (r < I_O) { const int kb = r / 32, nb = r % 32;
                transpose_item(inp(F, I_WO) + (size_t)l * D * D, D, (64 * kb) & 1023, 32 * nb + (F.lane & 31), (f16*)(F.ws + WS_WO2) + (size_t)l * D * 2048, 2048, 32 * nb, 64 * kb, scr, F.lane); continue; }
            r -= I_O;
            if (r < I_FI) { const int kb = r / (2 * DFF / 32), nb = r % (2 * DFF / 32);
                transpose_item(inp(F, I_WFI) + (size_t)l * D * 2 * DFF, 2 * DFF, 64 * kb, wfi_src_col(32 * nb + (F.lane & 31)), (f16*)(F.ws + WS_WFI) + (size_t)l * 2 * DFF * D, D, 32 * nb, 64 * kb, scr, F.lane); continue; }
            r -= I_FI;
            { const int kb = r / 32, nb = r % 32;
                transpose_item(inp(F, I_WFO) + (size_t)l * DFF * D, D, 64 * kb, 32 * nb + (F.lane & 31), (f16*)(F.ws + WS_WFO) + (size_t)l * D * DFF, DFF, 32 * nb, 64 * kb, scr, F.lane); }
        }
    }
    {
        const int nz = DEPTH * NSB * 32 * D / 8;
        for (int i = gt; i < 2 * nz; i += NGT) {
            const bool isv = i >= nz; const int j = isv ? i - nz : i;
            const int lsb = j / (32 * D / 8), rem = j % (32 * D / 8);
            f16* dst = (f16*)(F.ws + (isv ? WS_VS : WS_KS)) + ((size_t)lsb * KSROWS + PAST + 32) * D + rem * 8;
            *(u32x4*)dst = (u32x4){0u, 0u, 0u, 0u};
        }
    }
    if (F.vcu == F.G - 1) {
        float* misc = (float*)(F.ws + WS_MISC);
        if (F.wave < DEPTH) {
            const float* lp = inp(F, I_LAM) + F.wave * 4 * 64;
            const float s01 = wave_sum(lp[F.lane] * lp[64 + F.lane]), s23 = wave_sum(lp[128 + F.lane] * lp[192 + F.lane]);
            const float lam_init = 0.8f - 0.6f * expf(-0.3f * (float)F.wave);
            if (F.lane == 0) { misc[F.wave] = expf(s01) - expf(s23) + lam_init; misc[8 + F.wave] = 1.0f - lam_init; }
        }
        for (int i = F.tid; i < NH * 256; i += 512) { const int h = i >> 8, rel = (i & 255) - 128; misc[64 + i] = inp(F, I_RELB)[t5_bucket(rel) * NH + h] * LOG2E; }
    }
}
__device__ __forceinline__ void ld8(const float* p, float (&v)[8]) { const f32x4 a = *(const f32x4*)p, c = *(const f32x4*)(p + 4); v[0] = a[0]; v[1] = a[1]; v[2] = a[2]; v[3] = a[3]; v[4] = c[0]; v[5] = c[1]; v[6] = c[2]; v[7] = c[3]; }
__device__ __forceinline__ void ld8(const f16* p, float (&v)[8]) { const f16x8 a = *(const f16x8*)p;
#pragma unroll
    for (int e = 0; e < 8; ++e) v[e] = (float)a[e]; }
__device__ __forceinline__ void st8(float* p, const float (&v)[8]) { *(f32x4*)p = (f32x4){v[0], v[1], v[2], v[3]}; *(f32x4*)(p + 4) = (f32x4){v[4], v[5], v[6], v[7]}; }
__device__ __forceinline__ void st8(f16* p, const float (&v)[8]) { *(u32x4*)p = (u32x4){pk2h(v[0], v[1]), pk2h(v[2], v[3]), pk2h(v[4], v[5]), pk2h(v[6], v[7])}; }
template <class TS, class TD> __device__ __forceinline__ void ln_row(const TS* src, const float* g, const float* b, TD* dst, f16* hrow, const float* sh, const float* sc, int lane, const float* part, const float* gate) {
    float v[2][8]; float s = 0.f;
#pragma unroll
    for (int j = 0; j < 2; ++j) ld8(src + 8 * lane + 512 * j, v[j]);
    if (part) {
#pragma unroll
        for (int j = 0; j < 2; ++j) { const int c = 8 * lane + 512 * j; float y[8], t[8], gt[8]; ld8(part + c, y);
#pragma unroll
            for (int k = 1; k < 8; ++k) { ld8(part + (size_t)k * MS * D + c, t);
#pragma unroll
                for (int e = 0; e < 8; ++e) y[e] += t[e]; }
            ld8(gate + c, gt);
#pragma unroll
            for (int e = 0; e < 8; ++e) v[j][e] = v[j][e] * ALPHA + gt[e] * y[e]; }
    }
#pragma unroll
    for (int j = 0; j < 2; ++j)
#pragma unroll
        for (int e = 0; e < 8; ++e) s += v[j][e];
    const float mean = wave_sum(s) * (1.f / D); float s2 = 0.f;
#pragma unroll
    for (int j = 0; j < 2; ++j)
#pragma unroll
        for (int e = 0; e < 8; ++e) { v[j][e] -= mean; s2 += v[j][e] * v[j][e]; }
    const float rstd = 1.0f / sqrtf(wave_sum(s2) * (1.f / D) + LN_EPS);
#pragma unroll
    for (int j = 0; j < 2; ++j) {
        const int c = 8 * lane + 512 * j; float gg[8], bb[8], x[8];
        ld8(g + c, gg); ld8(b + c, bb);
#pragma unroll
        for (int e = 0; e < 8; ++e) x[e] = v[j][e] * rstd * gg[e] + bb[e];
        st8(dst + c, x);
        if (hrow) { float s1[8], s0[8], hh[8]; ld8(sc + c, s1); ld8(sh + c, s0);
#pragma unroll
            for (int e = 0; e < 8; ++e) hh[e] = x[e] * (s1[e] + 1.0f) + s0[e];
            st8(hrow + c, hh); }
    }
}
__device__ __forceinline__ void ln_phase(Frame& F, bool first, bool last, const float* g, const float* b, const float* modl, int sh_off, int sc_off, const float* gate_l = nullptr) {
    const int gw = F.vcu * NWAVES + F.wave, NGW = F.G * NWAVES;
    f16* X = (f16*)(F.ws + WS_X); f16* H = (f16*)(F.ws + WS_H);
    for (int m = gw; m < M; m += NGW) {
        const float* mb = modl + (size_t)bb_of_row(m) * 6144;
        const bool sp = gate_l != nullptr && m >= MP;
        const float* part = sp ? (const float*)(F.ws + WS_PART) + (size_t)(m - MP) * D : nullptr; const float* gate = sp ? gate_l + (size_t)bb_of_row(m) * 6144 : nullptr;
        if (first) ln_row(m < MP ? inp(F, I_XP) + (size_t)m * D : inp(F, I_XS) + (size_t)(m - MP) * D, g, b, X + (size_t)m * D, H + (size_t)m * D, mb + sh_off, mb + sc_off, F.lane, part, gate);
        else if (last) ln_row(X + (size_t)m * D, g, b, m < MP ? F.out + OUT_YP + (size_t)m * D : F.out + OUT_YS + (size_t)(m - MP) * D, (f16*)nullptr, mb + sh_off, mb + sc_off, F.lane, part, gate);
        else ln_row(X + (size_t)m * D, g, b, X + (size_t)m * D, H + (size_t)m * D, mb + sh_off, mb + sc_off, F.lane, part, gate);
    }
}

constexpr int D1_KN = 0, D1_QN = 17408, D1_RT0 = 34816, D1_RT1 = 71680, D1_AM = 108544, D1_TM = 125952, D1_SC = 135168, D1_SS = 137216, D1_AH = 141312, D1_W = 143872;
struct D1Task { int row0, nvalid, n, unit; const float* hist; };

#define LDS_BARRIER() do { __builtin_amdgcn_fence(__ATOMIC_RELEASE, "workgroup", "local"); __builtin_amdgcn_s_barrier(); __builtin_amdgcn_fence(__ATOMIC_ACQUIRE, "workgroup", "local"); } while (0)
#define D1_LOCALS \
    LAS unsigned char* L = F.lds; \
    LAS f16* Kn = (LAS f16*)(L + D1_KN); LAS f16* Qn = (LAS f16*)(L + D1_QN); LAS f16* RT = (LAS f16*)(L + (rtb ? D1_RT1 : D1_RT0)); \
    LAS float* Am = (LAS float*)(L + D1_AM); LAS f16* Tm = (LAS f16*)(L + D1_TM); \
    LAS float* sBeta = (LAS float*)(L + D1_SC); LAS float* sG = sBeta + 64; \
    LAS float* sSS = (LAS float*)(L + D1_SS); LAS f16* Ah = (LAS f16*)(L + D1_AH); \
    int lane = hw_lane(), wave = F.wave; asm volatile("" : "+s"(wave));        \
    const int r32 = lane & 31, hi = lane >> 5, l = lane; \
    const f16* QKVA = (const f16*)(F.ws + WS_QKVA); const float* BG = (const float*)(F.ws + WS_BG); \
    unsigned char* img = F.ws + WS_DIMG + (size_t)T.unit * DIMG_BYTES; \
    (void)Kn; (void)Qn; (void)RT; (void)Am; (void)Tm; (void)sBeta; (void)sG; (void)sSS; (void)Ah; (void)r32; (void)hi; (void)l; (void)QKVA; (void)BG; (void)img; (void)wave

__device__ __forceinline__ void d1_wload(Frame& F, int h, int layer, float (&w)[3]) {
    const float* cw = inp(F, I_CONVW) + (size_t)layer * 4 * CONVC;
    const int tid = F.wave * 64 + hw_lane();
#pragma unroll
    for (int j = 0; j < 3; ++j) { const int idx = tid + 512 * j; w[j] = cw[((idx >> 7) & 3) * CONVC + (idx >> 9) * 1024 + h * 128 + (idx & 127)]; }
}
__device__ __forceinline__ void d1_wstore(Frame& F, const float (&w)[3]) {
    LAS float* Wl = (LAS float*)(F.lds + D1_W);
    const int tid = F.wave * 64 + hw_lane();
#pragma unroll
    for (int j = 0; j < 3; ++j) Wl[tid + 512 * j] = w[j];
}
__device__ __forceinline__ void d1_s1(Frame& F, const D1Task& T, int h, int layer, int rtb, float (&xq)[16], float (&xk)[16], float& beta_o, float& eg_o, float& egl_o) {
    D1_LOCALS;
    const bool valid = l < T.nvalid, first = T.n == 0;
    f16x8 rm[3][2], rh[3][2];
    const int lr = l < T.nvalid ? l : T.nvalid - 1; const float vmask = valid ? 1.f : 0.f;
#pragma unroll
    for (int tz = 0; tz < 3; ++tz) {
        const f16* p = QKVA + (size_t)(T.row0 + lr) * CONVC + tz * 1024 + h * 128 + 16 * wave;
        rm[tz][0] = *(const f16x8*)p; rm[tz][1] = *(const f16x8*)(p + 8);
        if (!first) { const f16* ph = QKVA + (size_t)(T.row0 + (l >= 3 ? l : l - 3)) * CONVC + tz * 1024 + h * 128 + 16 * wave; rh[tz][0] = *(const f16x8*)ph; rh[tz][1] = *(const f16x8*)(ph + 8); }
        else if (T.hist) { const float* ph = T.hist + (size_t)(l < 3 ? l : 0) * CONVC + tz * 1024 + h * 128 + 16 * wave;
            const f32x4 a = *(const f32x4*)ph, b4 = *(const f32x4*)(ph + 4), c4 = *(const f32x4*)(ph + 8), d4 = *(const f32x4*)(ph + 12);
            rh[tz][0] = __builtin_bit_cast(f16x8, pk8h(a, b4)); rh[tz][1] = __builtin_bit_cast(f16x8, pk8h(c4, d4)); }
        else { rh[tz][0] = f16x8{}; rh[tz][1] = f16x8{}; }
    }
    float beta = 0.f, g = 0.f;
    if (valid) {
        const float braw = BG[(size_t)(T.row0 + lane) * 16 + h], araw = BG[(size_t)(T.row0 + lane) * 16 + 8 + h];
        beta = 1.0f / (1.0f + __expf(-braw));
        const float x = araw + inp(F, I_DTB)[layer * NH + h];
        const float y = __expf(x);
        const float sp = x > 20.f ? x : (y < 0.01f ? y * (1.0f - y * (0.5f - y * 0.333333343f)) : __logf(1.0f + y));
        g = -__expf(inp(F, I_ALOG)[layer * NH + h]) * sp;
    }
#pragma unroll
    for (int o = 1; o < 64; o <<= 1) {
        const float t = __builtin_bit_cast(float, __builtin_amdgcn_ds_bpermute(4 * (lane >= o ? lane - o : lane), __builtin_bit_cast(int, g)));
        if (lane >= o) g += t;
    }
    const float glast = __builtin_bit_cast(float, __builtin_amdgcn_readlane(__builtin_bit_cast(int, g), 63));
    const float eg = __expf(g), egl = __expf(glast - g);
    if (wave == 0) {
        sBeta[lane] = beta; sG[lane] = g;
        if (lane == 0) ((float*)(F.ws + WS_MISC))[4096 + T.unit] = __expf(glast);
    }
    const LAS float* Wl = (const LAS float*)(L + D1_W) + 16 * wave; asm volatile("" : "+v"(Wl));
#pragma unroll
    for (int tz = 0; tz < 3; ++tz) {
        LAS f16* slab = (LAS f16*)(L + D1_KN) + wave * (68 * 16);
        *(LAS f16x8*)(slab + (l + 3) * 16) = rm[tz][0]; *(LAS f16x8*)(slab + (l + 3) * 16 + 8) = rm[tz][1];
        if (l < 3) { *(LAS f16x8*)(slab + l * 16) = rh[tz][0]; *(LAS f16x8*)(slab + l * 16 + 8) = rh[tz][1]; }
        f16x8 raw[4][2];
#pragma unroll
        for (int i = 0; i < 4; ++i) { raw[i][0] = *(const LAS f16x8*)(slab + (l + i) * 16); raw[i][1] = *(const LAS f16x8*)(slab + (l + i) * 16 + 8); }
        float x[16];
#pragma unroll
        for (int e = 0; e < 16; ++e) x[e] = 0.f;
#pragma unroll
        for (int i = 0; i < 4; ++i) {
            const LAS f32x4* wp = (const LAS f32x4*)(Wl + (tz * 4 + i) * 128); const f32x4 w0 = wp[0], w1 = wp[1], w2 = wp[2], w3 = wp[3];
#pragma unroll
            for (int e = 0; e < 4; ++e) { x[e] = __builtin_fmaf((float)raw[i][0][e], w0[e], x[e]); x[4 + e] = __builtin_fmaf((float)raw[i][0][4 + e], w1[e], x[4 + e]);
                x[8 + e] = __builtin_fmaf((float)raw[i][1][e], w2[e], x[8 + e]); x[12 + e] = __builtin_fmaf((float)raw[i][1][4 + e], w3[e], x[12 + e]); }
        }
        float ss = 0.f;
#pragma unroll
        for (int e = 0; e < 16; ++e) { x[e] = siluf_(x[e]) * vmask; ss += x[e] * x[e]; }
        if (tz == 0) {
#pragma unroll
            for (int e = 0; e < 16; ++e) xq[e] = x[e];
            sSS[(0 * 8 + wave) * 64 + l] = ss;
        } else if (tz == 1) {
#pragma unroll
            for (int e = 0; e < 16; ++e) xk[e] = x[e];
            sSS[(1 * 8 + wave) * 64 + l] = ss;
        } else {
#pragma unroll
            for (int e = 0; e < 16; ++e) RT[(16 * wave + e) * 72 + l] = (f16)(x[e] * beta);
        }
    }
    beta_o = beta; eg_o = eg; egl_o = egl;
}
__device__ __forceinline__ void d1_s1b(Frame& F, const D1Task& T, int h, int rtb, float (&xq)[16], float (&xk)[16], float beta, float eg, float egl) {
    D1_LOCALS;
    {
        float sq = 0.f, sk = 0.f;
#pragma unroll
        for (int w = 0; w < 8; ++w) { sq += sSS[(0 * 8 + w) * 64 + l]; sk += sSS[(1 * 8 + w) * 64 + l]; }
        const float rq = rsqrtf(sq + 1e-6f) * 0.08838834764831845f, rk = rsqrtf(sk + 1e-6f);
        float qg[16], kt[16];
#pragma unroll
        for (int e = 0; e < 16; ++e) { xq[e] *= rq; xk[e] *= rk; qg[e] = xq[e] * eg; kt[e] = xk[e] * egl; }
        u32x4 w0, w1;
        w0 = (u32x4){pk2h(xq[0], xq[1]), pk2h(xq[2], xq[3]), pk2h(xq[4], xq[5]), pk2h(xq[6], xq[7])}; w1 = (u32x4){pk2h(xq[8], xq[9]), pk2h(xq[10], xq[11]), pk2h(xq[12], xq[13]), pk2h(xq[14], xq[15])};
        *(LAS u32x4*)(Qn + l * 136 + 16 * wave) = w0; *(LAS u32x4*)(Qn + l * 136 + 16 * wave + 8) = w1;
        w0 = (u32x4){pk2h(xk[0], xk[1]), pk2h(xk[2], xk[3]), pk2h(xk[4], xk[5]), pk2h(xk[6], xk[7])}; w1 = (u32x4){pk2h(xk[8], xk[9]), pk2h(xk[10], xk[11]), pk2h(xk[12], xk[13]), pk2h(xk[14], xk[15])};
        *(LAS u32x4*)(Kn + l * 136 + 16 * wave) = w0; *(LAS u32x4*)(Kn + l * 136 + 16 * wave + 8) = w1;
        f16* qgi = (f16*)(img + IMG_QG) + ((size_t)((l >> 5) * 8 + wave) * 64 + (l & 31)) * 8;
        *(u32x4*)qgi = (u32x4){pk2h(qg[0], qg[1]), pk2h(qg[2], qg[3]), pk2h(qg[8], qg[9]), pk2h(qg[10], qg[11])};
        *(u32x4*)(qgi + 32 * 8) = (u32x4){pk2h(qg[4], qg[5]), pk2h(qg[6], qg[7]), pk2h(qg[12], qg[13]), pk2h(qg[14], qg[15])};
        f16* kti = (f16*)(img + IMG_KT) + l * 128 + 16 * wave;
        *(u32x4*)kti = (u32x4){pk2h(kt[0], kt[1]), pk2h(kt[2], kt[3]), pk2h(kt[4], kt[5]), pk2h(kt[6], kt[7])};
        *(u32x4*)(kti + 8) = (u32x4){pk2h(kt[8], kt[9]), pk2h(kt[10], kt[11]), pk2h(kt[12], kt[13]), pk2h(kt[14], kt[15])};
        const float be = beta * eg;
#pragma unroll
        for (int e = 0; e < 16; ++e) RT[(128 + 16 * wave + e) * 72 + l] = (f16)(xk[e] * be);
    }
}
__device__ __forceinline__ void d1_s2(Frame& F, const D1Task& T) {
    const int rtb = 0; D1_LOCALS;
    if ((wave & 3) < 3) {
        const bool isqk = wave >= 4; const int w3 = wave & 3;
        const int ta = isqk ? (w3 == 2 ? 1 : 0) : (w3 == 0 ? 0 : 1);
        const int tb = isqk ? (w3 == 0 ? 0 : 1) : (w3 == 2 ? 1 : 0);
        const LAS f16* Bm = isqk ? Qn : Kn;
        f32x16 acc = {};
#pragma unroll
        for (int s = 0; s < 8; ++s) {
            const f16x8 a = *(const LAS f16x8*)(Kn + (32 * ta + r32) * 136 + 16 * s + 8 * hi);
            const f16x8 b = *(const LAS f16x8*)(Bm + (32 * tb + r32) * 136 + 16 * s + 8 * hi);
            acc = mfma32(a, b, acc);
        }
        const int cj = 32 * tb + r32;
        const float gj = sG[cj];
        if (!isqk) {
#pragma unroll
            for (int r = 0; r < 16; ++r) { const int i = 32 * ta + crow(r, hi);
                const float v = i > cj ? sBeta[i] * acc[r] * __expf(sG[i] - gj) : 0.f;
                Am[i * 68 + cj] = v;
                if (w3 == 1) Ah[(i - 32) * 40 + cj] = (f16)v; }
        } else {
            f32x16 v;
#pragma unroll
            for (int r = 0; r < 16; ++r) { const int lp = 32 * ta + crow(r, hi);
                v[r] = cj >= lp ? acc[r] * __expf(gj - sG[lp]) : 0.f; }
            f16* qki = (f16*)(img + IMG_QK);
#pragma unroll
            for (int sp = 0; sp < 2; ++sp) *(f16x8*)(qki + ((size_t)(tb * 4 + 2 * ta + sp) * 64 + lane) * 8) = cvt8(v, 8 * sp);
        }
    } else if (wave == 7) {
        f16* qki = (f16*)(img + IMG_QK);
#pragma unroll
        for (int ks = 2; ks < 4; ++ks) *(u32x4*)(qki + ((size_t)(0 * 4 + ks) * 64 + lane) * 8) = (u32x4){0u, 0u, 0u, 0u};
    }
}
__device__ __forceinline__ void d1_s3(Frame& F) {
    const int rtb = 0; D1Task T; T.unit = 0; D1_LOCALS;
    if (wave == 0) {
        const int hb = lane >> 5, c = lane & 31;
        const LAS float* Ab = Am + (32 * hb) * 68 + 32 * hb; asm volatile("" : "+v"(Ab));
        float t[32];
#pragma unroll
        for (int i = 0; i < 32; ++i) t[i] = 0.f;
        f32x4 cur[8];
#pragma unroll
        for (int i = 0; i < 32; ++i) {
            f32x4 nxt[8];
            if (i + 1 < 32) {
                const LAS float* Ar = Ab;
                if (i > 0) asm volatile("" : "+v"(Ar) : "v"(t[i - 1]));
#pragma unroll
                for (int g = 0; g < (i + 4) / 4; ++g) nxt[g] = *(const LAS f32x4*)(Ar + (i + 1) * 68 + 4 * g);
            }
            float a0 = (i == c) ? 1.f : 0.f, a1 = 0.f, a2 = 0.f, a3 = 0.f;
#pragma unroll
            for (int g = 0; g < (i + 3) / 4; ++g) { a0 -= cur[g][0] * t[4 * g]; a1 -= cur[g][1] * t[4 * g + 1]; a2 -= cur[g][2] * t[4 * g + 2]; a3 -= cur[g][3] * t[4 * g + 3]; }
            t[i] = (a0 + a1) + (a2 + a3);
#pragma unroll
            for (int g = 0; g < 8; ++g) cur[g] = nxt[g];
        }
#pragma unroll
        for (int i = 0; i < 32; ++i) Tm[(32 * hb + i) * 72 + 32 * hb + c] = (f16)t[i];
        f32x16 P = {};
#pragma unroll
        for (int s = 0; s < 2; ++s) {
            float bv[8];
#pragma unroll
            for (int e = 0; e < 8; ++e) { const float x = __shfl(t[16 * s + 8 + e], c); bv[e] = hb ? x : t[16 * s + e]; }
            const u32x4 bw = {pk2h(bv[0], bv[1]), pk2h(bv[2], bv[3]), pk2h(bv[4], bv[5]), pk2h(bv[6], bv[7])};
            const f16x8 af = *(const LAS f16x8*)(Ah + c * 40 + 16 * s + 8 * hb);
            P = mfma32(af, __builtin_bit_cast(f16x8, bw), P);
        }
        f32x16 Q = {};
#pragma unroll
        for (int s = 0; s < 2; ++s) {
            const LAS f16* tp = Tm + (32 + c) * 72 + 32 + 16 * s + 4 * hb;
            const f16x4 lo = *(const LAS f16x4*)tp, h4 = *(const LAS f16x4*)(tp + 8);
            Q = mfma32((f16x8){lo[0], lo[1], lo[2], lo[3], h4[0], h4[1], h4[2], h4[3]}, cvt8(P, 8 * s), Q);
        }
#pragma unroll
        for (int r = 0; r < 16; ++r) Tm[(32 + crow(r, hb)) * 72 + c] = (f16)(-Q[r]);
    }
}
__device__ __forceinline__ void d1_s4(Frame& F, const D1Task& T, int rtb) {
    D1_LOCALS;
    {
        const int rt = wave & 1, tq = wave >> 1;
        f32x16 au = {}, aw = {};
        const int ns = rt == 0 ? 2 : 4;
#pragma unroll
        for (int s = 0; s < 4; ++s) if (s < ns) {
            const f16x8 tf = *(const LAS f16x8*)(Tm + (32 * rt + r32) * 72 + 16 * s + 8 * hi);
            const f16x8 bv = *(const LAS f16x8*)(RT + (32 * tq + r32) * 72 + 16 * s + 8 * hi);
            const f16x8 ak = *(const LAS f16x8*)(RT + (128 + 32 * tq + r32) * 72 + 16 * s + 8 * hi);
            au = mfma32(tf, bv, au);
            aw = mfma32(ak, tf, aw);
        }
        f16* uvi = (f16*)(img + IMG_UV) + ((size_t)(tq * 2 + rt) * 64 + lane) * 16;
        *(f16x8*)uvi = cvt8(au, 0); *(f16x8*)(uvi + 8) = cvt8(au, 8);
        f16* wki = (f16*)(img + IMG_WK);
#pragma unroll
        for (int sp = 0; sp < 2; ++sp) *(f16x8*)(wki + ((size_t)(rt * 8 + 2 * tq + sp) * 64 + lane) * 8) = cvt8(aw, 8 * sp);
    }
}

constexpr int SC_BUF = 57344, SC_OB = 2 * SC_BUF, SC_OBB = 16384;
__device__ __forceinline__ int vswz(int row, int ch) { return row * 256 + ((ch ^ (((row & 3) << 2) | ((row >> 2) & 3))) << 4); }
__device__ __forceinline__ f16x4 tr_read(const LAS unsigned char* p) { return __builtin_bit_cast(f16x4, __builtin_amdgcn_ds_read_tr16_b64_v4i16((LAS v4i16_t*)p)); }
struct TrAddr { int a[2][4]; };
__device__ __forceinline__ TrAddr tr_addr(int lane) {
    const int g = lane >> 4, i = lane & 15, q = i >> 2, p = i & 3, hi = g >> 1; TrAddr t;
#pragma unroll
    for (int sec = 0; sec < 2; ++sec)
#pragma unroll
        for (int cb = 0; cb < 4; ++cb)
            t.a[sec][cb] = (4 * hi + q + 8 * sec) * 256 + (((((cb ^ q) << 2) | ((((g & 1) << 1) | (p >> 1)) ^ ((hi + 2 * sec) & 3)))) << 4) + 8 * (p & 1);
    return t;
}
__device__ __forceinline__ f16x8 tr_frag(const LAS unsigned char* base, const TrAddr& t, int k0, int cb) {
    const f16x4 lo = tr_read(base + t.a[0][cb] + k0 * 256);
    const f16x4 hh = tr_read(base + t.a[1][cb] + k0 * 256);
    return (f16x8){lo[0], lo[1], lo[2], lo[3], hh[0], hh[1], hh[2], hh[3]};
}

__device__ __forceinline__ void scan_task(Frame& F, bool samp, int b, int h, int layer, unsigned* qh) {
    LAS unsigned char* L = F.lds;
    int lane = hw_lane(), wave = F.wave; asm volatile("" : "+s"(wave));
    const int tid = wave * 64 + lane, r32 = lane & 31, hi = lane >> 5;
    const bool cwv = wave < 4; const int w = wave & 3;
    const TrAddr TA = tr_addr(lane);
    const int nch = samp ? 1 : 32, unit0 = samp ? NB * NH * 32 + b * NH + h : (b * NH + h) * 32;
    const int row00 = samp ? MP + b * SSEQ : b * SEQ, nvalid = samp ? SSEQ : 64;
    const unsigned char* img0 = F.ws + WS_DIMG + (size_t)unit0 * DIMG_BYTES;
    const float* glast = (const float*)(F.ws + WS_MISC) + 4096 + unit0;
    f32x16 S[4];
#pragma unroll
    for (int t = 0; t < 4; ++t) S[t] = f32x16{};
    if (samp && cwv) {
        const float* sd = inp(F, I_SDELTA) + ((size_t)(layer * NSB + b) * NH + h) * DK * DK;
#pragma unroll
        for (int t = 0; t < 4; ++t)
#pragma unroll
            for (int r = 0; r < 16; ++r) S[t][r] = sd[(32 * t + crow(r, hi)) * DK + 32 * w + r32];
    }
    const int st0 = tid - 256;
    int st = st0;
#define SC_STAGE_LOAD(nn, RG) do { const unsigned char* im_ = img0 + (size_t)(nn) * DIMG_BYTES; \
        _Pragma("unroll") for (int i_ = 0; i_ < 14; ++i_) RG[i_] = *(const u32x4*)(im_ + (size_t)(st + 256 * i_) * 16); } while (0)
#define SC_STAGE_STORE(bufo, RG) do { _Pragma("unroll") for (int i_ = 0; i_ < 14; ++i_) { const int c_ = st + 256 * i_; \
            const int o_ = c_ < (IMG_KT / 16) ? c_ * 16 : IMG_KT + vswz((c_ - IMG_KT / 16) >> 4, (c_ - IMG_KT / 16) & 15); \
            *(LAS u32x4*)(L + (bufo) + o_) = RG[i_]; } } while (0)
#define SC_ZLOAD(nn, Z_) do { const int l_ = st >> 2, part_ = st & 3; \
        const size_t row_ = (size_t)row00 + 64 * (nn) + (l_ < nvalid ? l_ : 0); \
        const f16* zp_ = (const f16*)(F.ws + WS_Z) + row_ * D + h * 128 + 32 * part_;      \
        _Pragma("unroll") for (int q_ = 0; q_ < 4; ++q_) Z_[q_] = *(const f16x8*)(zp_ + 8 * q_); } while (0)
#define SC_EPI(nn, z_, live_) do { const int l_ = st >> 2, part_ = st & 3; \
        const LAS f16* ob_ = (const LAS f16*)(L + SC_OB + ((nn) & 1) * SC_OBB) + l_ * 128 + 32 * part_; \
        const size_t row_ = (size_t)row00 + 64 * (nn) + (l_ < nvalid ? l_ : 0); const int c_ = h * 128 + 32 * part_; \
        float ss_ = 0.f; \
        _Pragma("unroll") for (int q_ = 0; q_ < 4; ++q_) { const f16x8 a1_ = *(const LAS f16x8*)(ob_ + 8 * q_); _Pragma("unroll") for (int e_ = 0; e_ < 8; ++e_) { const float v_ = (float)a1_[e_]; ss_ += v_ * v_; } } \
        const LAS f16* ob2_ = ob_; asm volatile("" : "+v"(ob2_));        \
        ss_ += __shfl_xor(ss_, 1); ss_ += __shfl_xor(ss_, 2); \
        const float rstd_ = rsqrtf(ss_ * (1.0f / 128.0f) + LN_EPS); \
        const LAS f32x4* na_ = (const LAS f32x4*)(L + LDSCTL_OFF + 1024 + 4 * 132) + 8 * part_;     \
        f16* op_ = (live_) ? (f16*)(F.ws + WS_MAB) + row_ * 2048 + c_ : (f16*)(F.ws + WS_PART) + st * 32;     \
        _Pragma("unroll") for (int q_ = 0; q_ < 4; ++q_) { float r_[8]; const f32x4 n0_ = na_[2 * q_], n1_ = na_[2 * q_ + 1]; const f16x8 a2_ = *(const LAS f16x8*)(ob2_ + 8 * q_); \
            _Pragma("unroll") for (int e_ = 0; e_ < 8; ++e_) r_[e_] = (float)a2_[e_] * rstd_ * (e_ < 4 ? n0_[e_ & 3] : n1_[e_ & 3]) * (float)z_[q_][e_]; \
            if (!samp || l_ < nvalid) *(u32x4*)(op_ + 8 * q_) = (u32x4){pk2h(r_[0], r_[1]), pk2h(r_[2], r_[3]), pk2h(r_[4], r_[5]), pk2h(r_[6], r_[7])}; } } while (0)
    f16x8 uvn[2][2] = {}; float gln = 0.f;
    u32x4 rga[14], rgb[14];
    if (!cwv) { SC_STAGE_LOAD(0, rga); SC_STAGE_STORE(0, rga); SC_STAGE_LOAD(nch > 1 ? 1 : 0, rgb); }
    else {
        const f16* uvp = (const f16*)(img0 + IMG_UV);
#pragma unroll
        for (int rt = 0; rt < 2; ++rt) { const f16* p = uvp + ((size_t)(w * 2 + rt) * 64 + lane) * 16; uvn[rt][0] = *(const f16x8*)p; uvn[rt][1] = *(const f16x8*)(p + 8); }
        gln = glast[0];
    }
    __syncthreads();
    if (cwv) {
        for (int n = 0; n < nch; ++n) {
            const int bo = (n & 1) * SC_BUF;
            const LAS unsigned char* B = L + bo;
            f16x8 uv[2][2];
#pragma unroll
            for (int rt = 0; rt < 2; ++rt) { uv[rt][0] = uvn[rt][0]; uv[rt][1] = uvn[rt][1]; }
            const float gl = gln;
            f32x16 up[2] = {f32x16{}, f32x16{}}, o[2] = {f32x16{}, f32x16{}};
#define SB() __builtin_amdgcn_sched_barrier(0)
#define SC_REQ1(ks, W) do { _Pragma("unroll") for (int rt = 0; rt < 2; ++rt) { wkf[W][rt] = *(const LAS f16x8*)(B + IMG_WK + ((rt * 8 + (ks)) * 64 + lane) * 16); qgf[W][rt] = *(const LAS f16x8*)(B + IMG_QG + ((rt * 8 + (ks)) * 64 + lane) * 16); } } while (0)
#define SC_MMA1(ks, W) do { const f16x8 bf = cvt8(S[(ks) >> 1], 8 * ((ks) & 1)); _Pragma("unroll") for (int rt = 0; rt < 2; ++rt) { up[rt] = mfma32(wkf[W][rt], bf, up[rt]); o[rt] = mfma32(qgf[W][rt], bf, o[rt]); } } while (0)
            {
                f16x8 wkf[1][2], qgf[1][2];
#pragma unroll
                for (int ks = 0; ks < 8; ++ks) { SC_REQ1(ks, 0); SB(); SC_MMA1(ks, 0); SB(); }
            }
#pragma unroll
            for (int rt = 0; rt < 2; ++rt)
#pragma unroll
                for (int r = 0; r < 16; ++r) up[rt][r] = (float)uv[rt][r >> 3][r & 7] - up[rt][r];
#pragma unroll
            for (int t = 0; t < 4; ++t) S[t] = S[t] * gl;
            if (n + 1 < nch) {
                const f16* uvp = (const f16*)(img0 + (size_t)(n + 1) * DIMG_BYTES + IMG_UV);
#pragma unroll
                for (int rt = 0; rt < 2; ++rt) { const f16* p = uvp + ((size_t)(w * 2 + rt) * 64 + lane) * 16; uvn[rt][0] = *(const f16x8*)p; uvn[rt][1] = *(const f16x8*)(p + 8); }
                gln = glast[n + 1];
            }
#define SC_REQ2(ks, W) do { qk1[W] = *(const LAS f16x8*)(B + IMG_QK + ((1 * 4 + (ks)) * 64 + lane) * 16); if ((ks) < 2) qk0[W] = *(const LAS f16x8*)(B + IMG_QK + ((0 * 4 + (ks)) * 64 + lane) * 16); \
        _Pragma("unroll") for (int t = 0; t < 4; ++t) { ktl[W][t] = tr_read(B + IMG_KT + TA.a[0][t] + (16 * (ks)) * 256); kth[W][t] = tr_read(B + IMG_KT + TA.a[1][t] + (16 * (ks)) * 256); } } while (0)
#define SC_MMA2(ks, W) do { const f16x8 bf = cvt8(up[(ks) >> 1], 8 * ((ks) & 1)); o[1] = mfma32(qk1[W], bf, o[1]); if ((ks) < 2) o[0] = mfma32(qk0[W], bf, o[0]); \
        _Pragma("unroll") for (int t = 0; t < 4; ++t) S[t] = mfma32((f16x8){ktl[W][t][0], ktl[W][t][1], ktl[W][t][2], ktl[W][t][3], kth[W][t][0], kth[W][t][1], kth[W][t][2], kth[W][t][3]}, bf, S[t]); } while (0)
            {
                f16x8 qk1[1], qk0[1]; f16x4 ktl[1][4], kth[1][4];
#pragma unroll
                for (int ks = 0; ks < 4; ++ks) { SC_REQ2(ks, 0); SB(); SC_MMA2(ks, 0); SB(); }
            }
#undef SC_REQ1
#undef SC_MMA1
#undef SC_REQ2
#undef SC_MMA2
#undef SB
            LAS f16* ob = (LAS f16*)(L + SC_OB + (n & 1) * SC_OBB);
#pragma unroll
            for (int rt = 0; rt < 2; ++rt)
#pragma unroll
                for (int r = 0; r < 16; ++r) ob[(32 * rt + crow(r, hi)) * 128 + 32 * w + r32] = (f16)o[rt][r];
            LDS_BARRIER();
        }
        {
        float* od = F.out + (samp ? OUT_DS + ((size_t)(layer * NSB + b) * NH + h) * DK * DK : OUT_DP + ((size_t)(layer * NB + b) * NH + h) * DK * DK);
#pragma unroll
        for (int t = 0; t < 4; ++t)
#pragma unroll
            for (int r = 0; r < 16; ++r) od[(32 * t + crow(r, hi)) * DK + 32 * w + r32] = S[t][r];
        }
    } else {
        const int nl = nch - 1;
        f16x8 zg[4] = {};
        for (int n = 0; n < nch; n += 2) {
            st = st0; asm volatile("" : "+v"(st));
            SC_STAGE_LOAD(n + 2 < nl ? n + 2 : nl, rga);
            SC_EPI(n > 0 ? n - 1 : 0, zg, n > 0);
            SC_ZLOAD(n, zg);
            if (n + 1 < nch) SC_STAGE_STORE(SC_BUF, rgb);
            LDS_BARRIER();
            if (n + 1 >= nch) break;
            st = st0; asm volatile("" : "+v"(st));
            SC_STAGE_LOAD(n + 3 < nl ? n + 3 : nl, rgb);
            SC_EPI(n, zg, true);
            SC_ZLOAD(n + 1, zg);
            if (n + 2 < nch) SC_STAGE_STORE(0, rga);
            LDS_BARRIER();
        }
        st = st0; asm volatile("" : "+v"(st));
        SC_EPI(nch - 1, zg, true);
    }
#undef SC_STAGE_LOAD
#undef SC_STAGE_STORE
#undef SC_EPI
#undef SC_ZLOAD
    if (wave == 0 && lane == 0) F.MISC[0] = __hip_atomic_fetch_add(qh, 1u, __ATOMIC_RELAXED, __HIP_MEMORY_SCOPE_AGENT);
    __syncthreads();
}

constexpr int AT_K0 = 0, AT_V0 = 32768, AT_XCH = 65536, AT_BT = 147456;
struct AttnTask { const f16* Q; const f16* K; const f16* V; const f16* G; f16* O; float* OK; float* OV; int q0, nqw, nkeys, ntiles, h, wr0; };

__device__ __forceinline__ float max3f_(float a, float b, float c) { return __builtin_fmaxf(__builtin_fmaxf(a, b), c); }
constexpr float AT_THR = 4.0f;
__device__ __forceinline__ void attn_task(Frame& F, const AttnTask& T, int layer, unsigned* qh) {
    LAS unsigned char* L = F.lds;
    int lane = hw_lane(), wave = F.wave; asm volatile("" : "+s"(wave));
    const int tid = wave * 64 + lane, r32 = lane & 31, hi = lane >> 5;
    const int map = wave >> 2, wq = wave & 3;
    const TrAddr TA = tr_addr(lane);
    const bool active = wq < T.nqw;
    const int qbase = T.q0 + 32 * wq, qpos = qbase + r32, cwv = qbase >> 6;
    const float* misc = (const float*)(F.ws + WS_MISC);
    const LAS float* BT = (const LAS float*)(L + AT_BT) + T.h * 256;
    float cfar = BT[0];
    f16x8 qf[4];
#pragma unroll
    for (int s = 0; s < 4; ++s) qf[s] = active ? *(const f16x8*)(T.Q + (size_t)qpos * D + map * 64 + 16 * s + 8 * hi) : f16x8{};
    int kadr[4];
#pragma unroll
    for (int s = 0; s < 4; ++s) kadr[s] = r32 * 256 + (((map * 8 + 2 * s + hi) ^ (r32 & 15)) << 4);
    const int srow0 = tid >> 4, srow1 = srow0 + 32, sch = tid & 15;
    const int kdo0 = srow0 * 256 + ((sch ^ (srow0 & 15)) << 4), kdo1 = srow1 * 256 + ((sch ^ (srow1 & 15)) << 4);
    const int vdo0 = vswz(srow0, sch), vdo1 = vswz(srow1, sch);
    u32x4 ka0, ka1, va0, va1, kb0, kb1, vb0, vb1;
#define AT_LOAD(j, S) do { const size_t o0_ = ((size_t)(64 * (j) + srow0)) * D + sch * 8, o1_ = o0_ + (size_t)32 * D; \
        k##S##0 = *(const u32x4*)(T.K + o0_); k##S##1 = *(const u32x4*)(T.K + o1_); v##S##0 = *(const u32x4*)(T.V + o0_); v##S##1 = *(const u32x4*)(T.V + o1_); } while (0)
#define AT_OUT8(P_, W_) do { const f16x8 h_ = __builtin_bit_cast(f16x8, W_); \
        __builtin_nontemporal_store((f32x4){(float)h_[0], (float)h_[1], (float)h_[2], (float)h_[3]}, (f32x4*)(P_)); __builtin_nontemporal_store((f32x4){(float)h_[4], (float)h_[5], (float)h_[6], (float)h_[7]}, (f32x4*)((P_) + 4)); } while (0)
#define AT_STORE(bo, S, jt) do { *(LAS u32x4*)(L + AT_K0 + (bo) + kdo0) = k##S##0; *(LAS u32x4*)(L + AT_K0 + (bo) + kdo1) = k##S##1; \
        *(LAS u32x4*)(L + AT_V0 + (bo) + vdo0) = v##S##0; *(LAS u32x4*)(L + AT_V0 + (bo) + vdo1) = v##S##1; \
        if ((jt) >= T.wr0) {                                       \
            const size_t q0_ = ((size_t)(64 * (jt) + srow0)) * D + sch * 8, q1_ = q0_ + (size_t)32 * D; \
            AT_OUT8(T.OK + q0_, k##S##0); AT_OUT8(T.OK + q1_, k##S##1); AT_OUT8(T.OV + q0_, v##S##0); AT_OUT8(T.OV + q1_, v##S##1); } } while (0)
    AT_LOAD(0, a); AT_STORE(0, a, 0);
    asm volatile("s_waitcnt vmcnt(0)" ::: "memory");
    asm volatile("" : "+v"(qf[0]), "+v"(qf[1]), "+v"(qf[2]), "+v"(qf[3]), "+v"(cfar));
    const int jlast = T.ntiles - 1;
    AT_LOAD(jlast < 1 ? jlast : 1, b);
    LDS_BARRIER();
    float m = 0.f, lsum = 0.f;
    bool firstt = true;
    f32x16 o[4];
#pragma unroll
    for (int d = 0; d < 4; ++d) o[d] = f32x16{};
#define SB() __builtin_amdgcn_sched_barrier(0)
#define AT_VREQ(g, W) do { _Pragma("unroll") for (int d = 0; d < 4; ++d) { vl[W][d] = tr_read(vb + TA.a[0][d] + (16 * (g)) * 256); vh[W][d] = tr_read(vb + TA.a[1][d] + (16 * (g)) * 256); } } while (0)
#define AT_PV(g, W) do { const f16x8 pf = cvt8((g) < 2 ? p0 : p1, 8 * ((g) & 1)); \
        _Pragma("unroll") for (int d = 0; d < 4; ++d) o[d] = mfma32((f16x8){vl[W][d][0], vl[W][d][1], vl[W][d][2], vl[W][d][3], vh[W][d][0], vh[W][d][1], vh[W][d][2], vh[W][d][3]}, pf, o[d]); } while (0)
#define AT_TILE(j, bo) do { if (active && (j) <= cwv) { \
            const LAS unsigned char* kb = L + AT_K0 + (bo); \
            const LAS unsigned char* vb = L + AT_V0 + (bo); \
            f16x8 ka[4], kc[4]; f16x4 vl[2][4], vh[2][4]; \
            _Pragma("unroll") for (int s = 0; s < 2; ++s) { ka[s] = *(const LAS f16x8*)(kb + kadr[s]); kc[s] = *(const LAS f16x8*)(kb + kadr[s] + 8192); } \
            SB(); \
            _Pragma("unroll") for (int s = 2; s < 4; ++s) { ka[s] = *(const LAS f16x8*)(kb + kadr[s]); kc[s] = *(const LAS f16x8*)(kb + kadr[s] + 8192); } \
            f32x16 p0 = f32x16{}, p1 = f32x16{}; \
            _Pragma("unroll") for (int s = 0; s < 2; ++s) { p0 = mfma32(ka[s], qf[s], p0); p1 = mfma32(kc[s], qf[s], p1); } \
            SB(); \
            AT_VREQ(0, 0); \
            _Pragma("unroll") for (int s = 2; s < 4; ++s) { p0 = mfma32(ka[s], qf[s], p0); p1 = mfma32(kc[s], qf[s], p1); } \
            SB(); \
            const bool near_ = 64 * (j) + 191 > qbase; \
            float cm = (near_ ? 0.f : cfar) - m;                   \
            if (near_) {                                           \
                const int ib = 64 * (j) - qpos + 128 + 4 * hi; \
                const bool tail = 64 * (j) + 64 > T.nkeys; \
                _Pragma("unroll") for (int hb = 0; hb < 2; ++hb) { float b0[8], b1[8]; \
                    _Pragma("unroll") for (int r8 = 0; r8 < 8; ++r8) { const int r = 8 * hb + r8; const int i0 = ib + (r & 3) + 8 * (r >> 2), i1 = i0 + 32; b0[r8] = BT[i0 < 0 ? 0 : i0]; b1[r8] = BT[i1 < 0 ? 0 : i1]; } \
                    SB(); \
                    _Pragma("unroll") for (int r8 = 0; r8 < 8; ++r8) { const int r = 8 * hb + r8; const int i0 = ib + (r & 3) + 8 * (r >> 2), i1 = i0 + 32; \
                        p0[r] += b0[r8]; p1[r] += b1[r8]; \
                        if (tail) { if (i0 + qpos - 128 >= T.nkeys) p0[r] = -INFINITY; if (i1 + qpos - 128 >= T.nkeys) p1[r] = -INFINITY; } } \
                    SB(); } } \
            float mx = max3f_(p0[0], p0[1], p1[0]); mx = max3f_(mx, p1[1], p0[2]); \
            _Pragma("unroll") for (int r = 2; r < 16; r += 2) { mx = max3f_(mx, p0[r], p0[r + 1]); mx = max3f_(mx, p1[r], p1[r + 1]); } \
            mx = __builtin_fmaxf(mx, __shfl_xor(mx, 32)) + cm; \
            if (firstt || __any(mx > AT_THR)) {                    \
                const float dl = firstt ? mx : __builtin_fmaxf(mx, 0.f); \
                const float alpha = firstt ? 1.0f : __builtin_amdgcn_exp2f(-dl); \
                m += dl; lsum *= alpha; cm -= dl; \
                _Pragma("unroll") for (int d = 0; d < 4; ++d) o[d] = o[d] * alpha; \
                firstt = false; } \
            f32x2 ps2 = {0.f, 0.f}; const f32x2 cm2 = {cm, cm}; \
            _Pragma("unroll") for (int r = 0; r < 16; r += 2) { \
                const f32x2 x0 = (f32x2){p0[r], p0[r + 1]} + cm2, x1 = (f32x2){p1[r], p1[r + 1]} + cm2; \
                p0[r] = __builtin_amdgcn_exp2f(x0[0]); p0[r + 1] = __builtin_amdgcn_exp2f(x0[1]); p1[r] = __builtin_amdgcn_exp2f(x1[0]); p1[r + 1] = __builtin_amdgcn_exp2f(x1[1]); \
                ps2 += (f32x2){p0[r], p0[r + 1]}; ps2 += (f32x2){p1[r], p1[r + 1]}; } \
            lsum += ps2[0] + ps2[1]; \
            SB(); AT_VREQ(1, 1); SB(); AT_PV(0, 0); SB(); AT_VREQ(2, 0); SB(); AT_PV(1, 1); SB(); AT_VREQ(3, 1); SB(); AT_PV(2, 0); SB(); AT_PV(3, 1); SB(); \
        } } while (0)
    for (int j = 0; j < T.ntiles; j += 2) {
        AT_LOAD(j + 2 < jlast ? j + 2 : jlast, a);
        AT_TILE(j, 0);
        if (j + 1 < T.ntiles) AT_STORE(16384, b, j + 1);
        LDS_BARRIER();
        if (j + 1 >= T.ntiles) break;
        AT_LOAD(j + 3 < jlast ? j + 3 : jlast, b);
        AT_TILE(j + 1, 16384);
        if (j + 2 < T.ntiles) AT_STORE(0, a, j + 2);
        LDS_BARRIER();
    }
#undef AT_LOAD
#undef AT_STORE
#undef AT_OUT8
#undef AT_TILE
#undef AT_VREQ
#undef AT_PV
#undef SB
    unsigned tk = 0;
    const bool qlead = wave == 0 && lane == 0;
    if (qlead) tk = __hip_atomic_fetch_add(qh, 1u, __ATOMIC_RELAXED, __HIP_MEMORY_SCOPE_AGENT);
    lsum += __shfl_xor(lsum, 32);
    const LAS float* PC = (const LAS float*)(L + LDSCTL_OFF + 1024);
    const float lam = PC[0];
    const float scl = (map == 0 ? 1.0f : lam) / lsum;
    LAS float* XC = (LAS float*)(L + AT_XCH) + wq * 4096;
    f16x4 gg[4][4];
    if (active && map == 0) {
        const f16* gp = T.G + (size_t)qpos * D;
#pragma unroll
        for (int d = 0; d < 4; ++d)
#pragma unroll
            for (int g4 = 0; g4 < 4; ++g4) gg[d][g4] = *(const f16x4*)(gp + 32 * d + 8 * g4 + 4 * hi);
    }
    if (active && map == 1) {
#pragma unroll
        for (int d = 0; d < 4; ++d)
#pragma unroll
            for (int r = 0; r < 16; ++r) XC[(d * 16 + r) * 64 + lane] = o[d][r] * scl;
    }
    LDS_BARRIER();
    if (active && map == 0) {
        float ss = 0.f;
#pragma unroll
        for (int d = 0; d < 4; ++d)
#pragma unroll
            for (int r = 0; r < 16; ++r) { const float v = o[d][r] * scl - XC[(d * 16 + r) * 64 + lane]; o[d][r] = v; ss += v * v; }
        ss += __shfl_xor(ss, 32);
        const float rs = rsqrtf(ss * (1.0f / 128.0f) + LN_EPS) * PC[1];
        f16* op = T.O + (size_t)qpos * 2048;
#pragma unroll
        for (int d = 0; d < 4; ++d)
#pragma unroll
            for (int g4 = 0; g4 < 4; ++g4) {
                const int dv = 32 * d + 8 * g4 + 4 * hi;
                const f32x4 s4 = *(const LAS f32x4*)(PC + 4 + dv);
                u32x2 wv; wv.x = pk2h(o[d][4 * g4] * rs * s4[0] * (float)gg[d][g4][0], o[d][4 * g4 + 1] * rs * s4[1] * (float)gg[d][g4][1]);
                wv.y = pk2h(o[d][4 * g4 + 2] * rs * s4[2] * (float)gg[d][g4][2], o[d][4 * g4 + 3] * rs * s4[3] * (float)gg[d][g4][3]);
                *(u32x2*)(op + dv) = wv;
            }
    }
    if (qlead) F.MISC[0] = tk;
    LDS_BARRIER();
}

#ifndef MK_PER_PHASE
#define MK_PER_PHASE 0
#endif
constexpr int N_PHASES = 2 + 8 * DEPTH;
constexpr int QN_SCANP = 2 * NH, QN_ATTS = NH, QN_ATTP = 2 * NH * 16, QN_SCANS = NH, QN_TOTAL = QN_SCANP + QN_ATTS + QN_ATTP + QN_SCANS;
static_assert(NB == 16 && NSB == 8, "queue partition");
struct Args { const float* in[27]; float* out; unsigned char* ws; int ph_lo, ph_hi; };

__global__ void __launch_bounds__(NWAVES * 64, 2) mk_fwd(Args args) {
    extern __shared__ __attribute__((aligned(16))) unsigned char lds[];
    Frame F;
    F.lds = (LAS unsigned char*)lds;
    F.MISC = (volatile LAS unsigned*)(F.lds + LDSCTL_OFF);
    F.tid = threadIdx.x; F.lane = F.tid & 63; F.wave = __builtin_amdgcn_readfirstlane(F.tid >> 6);
    F.G = gridDim.x; F.bx = blockIdx.x; { const int bx = blockIdx.x; F.vcu = (F.G % 8 == 0) ? (bx % 8) * (F.G / 8) + bx / 8 : bx; }
    F.out = args.out; F.ws = args.ws; F.ctl = (unsigned*)(args.ws + WS_CTL);
    for (int u = F.tid; u < 64; u += NWAVES * 64) ((LAS unsigned*)(F.lds + LDSCTL_OFF))[u] = 0u;
    if (F.tid < 27) ((LAS unsigned long long*)(F.lds + LDS_INP_OFF))[F.tid] = (unsigned long long)args.in[F.tid];
    __syncthreads();
    XcdBarrier bar; bar.bar = F.ctl + CW_BAR; bar.x = 0; bar.st = nullptr;
    if (!MK_PER_PHASE) bar = xcd_barrier_post(F.ctl + CW_BAR, F.MISC + 8);
    const int lo = args.ph_lo, hi = args.ph_hi;
#define IN(k) (lo <= (k) && (k) < hi)
#ifndef PROBE_PHASE
#define PROBE_PHASE -1
#endif
#define PROBE_T0() const unsigned long long pt0_ = (PROBE_PHASE >= 0) ? __builtin_amdgcn_s_memrealtime() : 0ull
#define PROBE_T1(k) do { if (PROBE_PHASE == (k)) { const unsigned long long pt1_ = __builtin_amdgcn_s_memrealtime(); while (__builtin_amdgcn_s_memrealtime() - pt1_ < pt1_ - pt0_) __builtin_amdgcn_s_sleep(8); } } while (0)
#define SEAM(k) do { if (!MK_PER_PHASE && IN(k) && IN((k) + 1)) { XcdBarrier b2_ = bar; asm volatile("" : "+s"(b2_.bar)); b2_.bar = as_global(b2_.bar); xcd_barrier(b2_); if (PROBE_PHASE == 30) xcd_barrier(b2_); } } while (0)

    if (IN(0)) { PROBE_T0();
#ifndef DIS_P0A
 { PHASE_FRAME(P); p0a_prologue(P); }
#endif
 PROBE_T1(8); }
    SEAM(0);
    if (IN(1)) { PROBE_T0(); PHASE_FRAME(P); ln_phase(P, true, false, inp(P, I_LNG), inp(P, I_LNB), (const float*)(P.ws + WS_MOD), 0, 1024); PROBE_T1(9); }
    SEAM(1);

    for (int l = 0; l < DEPTH; ++l) {
        const int p = 2 + 8 * l;
        if (IN(p)) { asm volatile("; PHASE_MARK P1"); PROBE_T0(); PHASE_FRAME(P);
            pg8::Gemm g{(const pg8::bf16_t*)(P.ws + WS_H), (const pg8::bf16_t*)(P.ws + WS_WIN) + (size_t)l * NPROJ * D, M, NPROJ, D};
            pg8::StaticOrder S; S.init(M, NPROJ, P.G, P.bx); S.rot = 33;
            EpiProj E{(f16*)(P.ws + WS_QKVA), (f16*)(P.ws + WS_Z), (f16*)(P.ws + WS_QB), (f16*)(P.ws + WS_KB), (f16*)(P.ws + WS_VB), (f16*)(P.ws + WS_GAB), (float*)(P.ws + WS_BG),
                      (f16*)(P.ws + WS_KS) + (size_t)l * NSB * KSROWS * D, (f16*)(P.ws + WS_VS) + (size_t)l * NSB * KSROWS * D, P.out, l};

#ifndef DIS_G1
 pg8::gemm_phase<EpiProj, pg8::StaticOrder, true, true>(P.lds, g, S, E, P.tid);
#endif

        PROBE_T1(0); }
        SEAM(p);
        if (IN(p + 1)) { asm volatile("; PHASE_MARK P2"); PROBE_T0(); PHASE_FRAME(P);
            float xq[16], xk[16]; float beta = 0.f, eg = 0.f, egl = 0.f;
#pragma unroll
            for (int e = 0; e < 16; ++e) { xq[e] = 0.f; xk[e] = 0.f; }
            D1Task Tc, Tn; int hn = 0, rtb = 0; bool cur = false;
            Tc.row0 = 0; Tc.nvalid = 0; Tc.n = 0; Tc.unit = 0; Tc.hist = nullptr; Tn = Tc;
            if (P.vcu < N_DUNITS) { float w3[3]; d1_wload(P, P.vcu < NB * NH * 32 ? (P.vcu >> 5) & 7 : (P.vcu - NB * NH * 32) & 7, l, w3); d1_wstore(P, w3); }
            LDS_BARRIER();
            for (int uu = P.vcu; ; uu += P.G) {
                int u = uu; asm volatile("" : "+s"(u));
                const bool nxt = u < N_DUNITS;
                if (!cur && !nxt) break;
                const int kstep = (uu - P.vcu) / P.G;
                const bool cvt = kstep < 16 && P.G == 256;
                if (nxt) {
                    if (u < NB * NH * 32) { const int n = u & 31, bh = u >> 5; hn = bh & 7; const int b = bh >> 3; Tn.row0 = b * SEQ + 64 * n; Tn.nvalid = 64; Tn.n = n; Tn.unit = u; Tn.hist = nullptr; }
                    else { const int v = u - NB * NH * 32, sb = v >> 3; hn = v & 7; Tn.row0 = MP + sb * SSEQ; Tn.nvalid = SSEQ; Tn.n = 0; Tn.unit = u; Tn.hist = inp(P, I_SCONV) + (size_t)(l * NSB + sb) * 3 * CONVC; }
                }
#ifndef DIS_D1
#define D1_PROBE(k, BODY) do { const unsigned long long d0_ = (PROBE_PHASE == (k)) ? __builtin_amdgcn_s_memrealtime() : 0ull; BODY; \
        if (PROBE_PHASE == (k)) { const unsigned long long d1_ = __builtin_amdgcn_s_memrealtime(); while (__builtin_amdgcn_s_memrealtime() - d1_ < d1_ - d0_) __builtin_amdgcn_s_sleep(4); } } while (0)
                D1_PROBE(20, if (cur) d1_s3(P));
                D1_PROBE(21, if (nxt) d1_s1(P, Tn, hn, l, rtb ^ 1, xq, xk, beta, eg, egl));
                LDS_BARRIER();
                D1_PROBE(22, if (cur) d1_s4(P, Tc, rtb));
                D1_PROBE(23, if (nxt) d1_s1b(P, Tn, hn, rtb ^ 1, xq, xk, beta, eg, egl));
                LDS_BARRIER();
                { const int u2 = u + P.G; const bool nn = u2 < N_DUNITS; float w3[3] = {0.f, 0.f, 0.f}; f32x4 cv[4] = {f32x4{}, f32x4{}, f32x4{}, f32x4{}};
                  if (nn) d1_wload(P, u2 < NB * NH * 32 ? (u2 >> 5) & 7 : (u2 - NB * NH * 32) & 7, l, w3);
                  if (cvt) cache_slice_load(P, l, kstep, cv);
                  D1_PROBE(24, if (nxt) d1_s2(P, Tn));
                  if (nn) d1_wstore(P, w3);
                  if (cvt) cache_slice_store(P, l, kstep, cv); }
                LDS_BARRIER();
#endif
                Tc = Tn; cur = nxt; rtb ^= 1;
            }
                PROBE_T1(1);
            asm volatile("s_waitcnt vmcnt(0)" ::: "memory"); __syncthreads();
            if (P.wave == 0 && hw_lane() == 0) { __builtin_amdgcn_fence(__ATOMIC_RELEASE, "agent"); asm volatile("s_waitcnt vmcnt(0)" ::: "memory"); (void)xb_add(P.ctl + CW_Q + 2048 + l * 32, 1u); } }
        if (IN(p + 2)) { asm volatile("; PHASE_MARK P3"); PROBE_T0(); PHASE_FRAME(P);
            const int qx = P.bx & 7;
            unsigned* qh = P.ctl + CW_Q + 1024 + (l * 8 + qx) * 32;
            { LAS float* bt = (LAS float*)(P.lds + AT_BT); const float* misc = (const float*)(P.ws + WS_MISC);
#pragma unroll
              for (int i = 0; i < 4; ++i) bt[P.tid + 512 * i] = misc[64 + P.tid + 512 * i];
              LAS float* pc = (LAS float*)(P.lds + LDSCTL_OFF + 1024);
              if (P.tid == 0) { pc[0] = misc[l]; pc[1] = misc[8 + l]; }
              if (P.tid < 128) { pc[4 + P.tid] = inp(P, I_SUBLN)[l * 128 + P.tid]; pc[132 + P.tid] = inp(P, I_NORMA)[l * 128 + P.tid]; } }
            if (P.wave == 0 && hw_lane() == 0) P.MISC[0] = __hip_atomic_fetch_add(qh, 1u, __ATOMIC_RELAXED, __HIP_MEMORY_SCOPE_AGENT);
            __syncthreads();
            for (;;) {
                int t = (int)P.MISC[0];
                if (t >= QN_TOTAL) break;
                t = t < 32 ? t + (QN_SCANP + QN_ATTS) : t < 32 + QN_SCANP + QN_ATTS ? t - 32 : t;
                if ((t < QN_SCANP + QN_ATTS || t >= QN_SCANP + QN_ATTS + QN_ATTP) && P.MISC[16] != (unsigned)(l + 1)) {
                    if (P.wave == 0 && hw_lane() == 0) { unsigned* dc = P.ctl + CW_Q + 2048 + l * 32; unsigned sp = 0u;
                        while (xb_ld(dc) < (unsigned)P.G) { __builtin_amdgcn_s_sleep(1); if (++sp > (1u << 22)) break; }
                        __builtin_amdgcn_fence(__ATOMIC_ACQUIRE, "agent"); asm volatile("s_waitcnt vmcnt(0)" ::: "memory"); }
                    __syncthreads();
                    if (P.wave == 0 && hw_lane() == 0) { unsigned lv = (unsigned)(l + 1); asm volatile("" : "+s"(lv)); P.MISC[16] = lv; }
                    __syncthreads();
                }
                if (t < QN_SCANP) { asm volatile("; PHASE_MARK SCANP");
#ifndef DIS_SCAN
 { const unsigned long long q0_ = (PROBE_PHASE == 10) ? __builtin_amdgcn_s_memrealtime() : 0ull; scan_task(P, false, 2 * qx + (t >> 3), t & 7, l, qh); if (PROBE_PHASE == 10) { const unsigned long long q1_ = __builtin_amdgcn_s_memrealtime(); while (__builtin_amdgcn_s_memrealtime() - q1_ < q1_ - q0_) __builtin_amdgcn_s_sleep(8); } }
#endif
 }
                else if (t < QN_SCANP + QN_ATTS + QN_ATTP) {
                    asm volatile("; PHASE_MARK ATTN"); AttnTask A; const int t2 = t - QN_SCANP;
                    if (t2 < QN_ATTS) { const int sb = qx, h = t2 & 7;
                        A.Q = (const f16*)(P.ws + WS_QB) + ((ptrdiff_t)(MP + sb * SSEQ) - PAST) * D + h * 128;
                        A.K = (const f16*)(P.ws + WS_KS) + ((size_t)(l * NSB + sb) * KSROWS) * D + h * 128; A.V = (const f16*)(P.ws + WS_VS) + ((size_t)(l * NSB + sb) * KSROWS) * D + h * 128;
                        A.G = (const f16*)(P.ws + WS_GAB) + ((ptrdiff_t)(MP + sb * SSEQ) - PAST) * D + h * 128; A.O = (f16*)(P.ws + WS_MAB) + ((ptrdiff_t)(MP + sb * SSEQ) - PAST) * 2048 + 1024 + h * 128;
                        A.q0 = PAST; A.nqw = 1; A.nkeys = PAST + SSEQ; A.ntiles = 33; A.h = h; A.OK = nullptr; A.OV = nullptr; A.wr0 = 1 << 20; }
                    else { const int t3 = t2 - QN_ATTS, r = t3 & 63, qb = 4 * (3 - (t3 >> 6)) + 3 - (r & 3), bhl = r >> 2, b = 2 * qx + (bhl >> 3), h = bhl & 7;
                        A.Q = (const f16*)(P.ws + WS_QB) + (size_t)b * SEQ * D + h * 128; A.K = (const f16*)(P.ws + WS_KB) + (size_t)b * SEQ * D + h * 128; A.V = (const f16*)(P.ws + WS_VB) + (size_t)b * SEQ * D + h * 128;
                        A.G = (const f16*)(P.ws + WS_GAB) + (size_t)b * SEQ * D + h * 128; A.O = (f16*)(P.ws + WS_MAB) + (size_t)b * SEQ * 2048 + 1024 + h * 128;
                        A.q0 = 128 * qb; A.nqw = 4; A.nkeys = SEQ; A.ntiles = 2 * qb + 2; A.h = h; A.wr0 = 2 * qb;
                        A.OK = P.out + OUT_KP + ((size_t)(l * NB + b) * SEQ) * D + h * 128; A.OV = P.out + OUT_VP + ((size_t)(l * NB + b) * SEQ) * D + h * 128; }

#ifndef DIS_ATT
 attn_task(P, A, l, qh);
#endif

                } else { const int t2 = t - (QN_SCANP + QN_ATTS + QN_ATTP);
#ifndef DIS_SCAN
 scan_task(P, true, qx, t2 & 7, l, qh);
#endif
 }
            }
        PROBE_T1(2); }
        SEAM(p + 2);
        if (IN(p + 3)) { asm volatile("; PHASE_MARK P4"); PROBE_T0(); PHASE_FRAME(P);
            pg8::Gemm g{(const pg8::bf16_t*)(P.ws + WS_MAB), (const pg8::bf16_t*)(P.ws + WS_WO2) + (size_t)l * D * 2048, MP, D, 2048};
            pg8::StaticOrder S; S.init(MP, D, P.G, P.bx);
            thin_gemm<16>(P, (const f16*)(P.ws + WS_MAB) + (size_t)MP * 2048, 2048, (const f16*)(P.ws + WS_WO2) + (size_t)l * D * 2048, 2048);
            EpiRes E{(f16*)(P.ws + WS_X), (const float*)(P.ws + WS_MOD) + (size_t)l * NBB * 6144 + 2048};

#ifndef DIS_G2
 pg8::gemm_phase<EpiRes, pg8::StaticOrder, true, true>(P.lds, g, S, E, P.tid);
#endif

        PROBE_T1(3); }
        SEAM(p + 3);
        if (IN(p + 4)) { asm volatile("; PHASE_MARK P5"); PROBE_T0(); PHASE_FRAME(P); ln_phase(P, false, false, inp(P, I_LN1G) + l * D, inp(P, I_LN1B) + l * D, (const float*)(P.ws + WS_MOD) + (size_t)l * NBB * 6144, 3072, 4096, (const float*)(P.ws + WS_MOD) + (size_t)l * NBB * 6144 + 2048); PROBE_T1(4); }
        SEAM(p + 4);
        if (IN(p + 5)) { asm volatile("; PHASE_MARK P6"); PROBE_T0(); PHASE_FRAME(P);
            pg8::Gemm g{(const pg8::bf16_t*)(P.ws + WS_H), (const pg8::bf16_t*)(P.ws + WS_WFI) + (size_t)l * 2 * DFF * D, M, 2 * DFF, D};
            pg8::StaticOrder S; S.init(M, 2 * DFF, P.G, P.bx);
            EpiSwiGLU E{(f16*)(P.ws + WS_ACT)};

#ifndef DIS_G3
 pg8::gemm_phase<EpiSwiGLU, pg8::StaticOrder, true, true>(P.lds, g, S, E, P.tid);
#endif

        PROBE_T1(5); }
        SEAM(p + 5);
        if (IN(p + 6)) { asm volatile("; PHASE_MARK P7"); PROBE_T0(); PHASE_FRAME(P);
            pg8::Gemm g{(const pg8::bf16_t*)(P.ws + WS_ACT), (const pg8::bf16_t*)(P.ws + WS_WFO) + (size_t)l * D * DFF, MP, D, DFF};
            pg8::StaticOrder S; S.init(MP, D, P.G, P.bx);
            thin_gemm<22>(P, (const f16*)(P.ws + WS_ACT) + (size_t)MP * DFF, DFF, (const f16*)(P.ws + WS_WFO) + (size_t)l * D * DFF, DFF);
            EpiRes E{(f16*)(P.ws + WS_X), (const float*)(P.ws + WS_MOD) + (size_t)l * NBB * 6144 + 5120};

#ifndef DIS_G2
 pg8::gemm_phase<EpiRes, pg8::StaticOrder, true, true>(P.lds, g, S, E, P.tid);
#endif

        PROBE_T1(6); }
        SEAM(p + 6);
        if (IN(p + 7)) { asm volatile("; PHASE_MARK P8"); PROBE_T0(); PHASE_FRAME(P); ln_phase(P, false, l == DEPTH - 1, inp(P, I_LN2G) + l * D, inp(P, I_LN2B) + l * D, (const float*)(P.ws + WS_MOD) + (size_t)(l == DEPTH - 1 ? l : l + 1) * NBB * 6144, 0, 1024, (const float*)(P.ws + WS_MOD) + (size_t)l * NBB * 6144 + 5120); PROBE_T1(7); }
        SEAM(p + 7);
    }
#undef IN
#undef SEAM
}

extern "C" void kernel_launch(void* const* d_in, const int* in_sizes, int n_in, void* d_out, int out_size, void* d_ws, size_t ws_size, hipStream_t stream) {
    static int grid = 0;
    if (grid == 0) {
        if (n_in != 27 || (size_t)out_size != OUT_END || ws_size < WS_END) { fprintf(stderr, "kernel_launch: unexpected shapes (n_in %d, out %d, ws %zu)\n", n_in, out_size, ws_size); grid = -1; return; }
        int dev = 0, cus = 0, per_cu = 0;
        if (hipGetDevice(&dev) != hipSuccess || hipDeviceGetAttribute(&cus, hipDeviceAttributeMultiprocessorCount, dev) != hipSuccess) { grid = -1; return; }
        if (hipFuncSetAttribute((const void*)mk_fwd, hipFuncAttributeMaxDynamicSharedMemorySize, LDS_BYTES) != hipSuccess) { fprintf(stderr, "kernel_launch: hipFuncSetAttribute failed\n"); grid = -1; return; }
        if (hipOccupancyMaxActiveBlocksPerMultiprocessor(&per_cu, (const void*)mk_fwd, NWAVES * 64, LDS_BYTES) != hipSuccess || per_cu < 1) { fprintf(stderr, "kernel_launch: occupancy query reports %d\n", per_cu); }
        (void)hipGetLastError();
        grid = cus;
    }
    if (grid < 0) return;
    if (hipMemsetAsync((char*)d_ws + WS_CTL, 0, CTL_ZERO_BYTES, stream) != hipSuccess) return;
    Args a{};
    for (int i = 0; i < 27; ++i) a.in[i] = (const float*)d_in[i];
    a.out = (float*)d_out; a.ws = (unsigned char*)d_ws;
#if MK_PER_PHASE
    for (int p = 0; p < N_PHASES; ++p) { a.ph_lo = p; a.ph_hi = p + 1; hipLaunchKernelGGL(mk_fwd, dim3(grid), dim3(NWAVES * 64), LDS_BYTES, stream, a); }
#else
    a.ph_lo = 0; a.ph_hi = N_PHASES;
    hipLaunchKernelGGL(mk_fwd, dim3(grid), dim3(NWAVES * 64), LDS_BYTES, stream, a);
#endif
}
```

```cpp
#include <hip/hip_runtime.h>
#include <cstdio>
#include <cstdint>

#define LAS __attribute__((address_space(3)))
#define GAS __attribute__((address_space(1)))
typedef _Float16 f16;
typedef _Float16 f16x2 __attribute__((ext_vector_type(2)));
typedef _Float16 f16x4 __attribute__((ext_vector_type(4)));
typedef _Float16 f16x8 __attribute__((ext_vector_type(8)));
typedef float f32x2 __attribute__((ext_vector_type(2)));
typedef float f32x4 __attribute__((ext_vector_type(4)));
typedef float f32x16 __attribute__((ext_vector_type(16)));
typedef unsigned u32x2 __attribute__((ext_vector_type(2)));
typedef unsigned u32x4 __attribute__((ext_vector_type(4)));
typedef short v4i16_t __attribute__((ext_vector_type(4)));

constexpr int D = 1024, NB = 16, SEQ = 2048, MP = NB * SEQ, NSB = 8, SSEQ = 32, MS = NSB * SSEQ, M = MP + MS, PAST = 2048, DEPTH = 4;
constexpr int NH = 8, DK = 128, CONVC = 3072, DFF = 2816, DIN = 9232, NPROJ = 9472;
constexpr int KSROWS = 2112;
constexpr float LN_EPS = 1e-5f;
constexpr float ALPHA = 1.6817928305074290f;
constexpr float LOG2E = 1.4426950408889634f;
constexpr int NBB = NB + NSB;

constexpr size_t OUT_YP = 0;
constexpr size_t OUT_YS = OUT_YP + (size_t)MP * D;
constexpr size_t OUT_KP = OUT_YS + (size_t)MS * D;
constexpr size_t OUT_VP = OUT_KP + (size_t)DEPTH * MP * D;
constexpr size_t OUT_CP = OUT_VP + (size_t)DEPTH * MP * D;
constexpr size_t OUT_DP = OUT_CP + (size_t)DEPTH * NB * 3 * CONVC;
constexpr size_t OUT_KS = OUT_DP + (size_t)DEPTH * NB * NH * DK * DK;
constexpr size_t OUT_VS = OUT_KS + (size_t)DEPTH * MS * D;
constexpr size_t OUT_CS = OUT_VS + (size_t)DEPTH * MS * D;
constexpr size_t OUT_DS = OUT_CS + (size_t)DEPTH * NSB * 3 * CONVC;
constexpr size_t OUT_END = OUT_DS + (size_t)DEPTH * NSB * NH * DK * DK;

constexpr size_t MiB = 1u << 20;
constexpr size_t WS_CTL = 0, CTL_ZERO_BYTES = 1 * MiB;
constexpr size_t WS_MOD = 1 * MiB;
constexpr size_t WS_MISC = 4 * MiB;
constexpr size_t WS_WIN = 5 * MiB;
constexpr size_t WS_WO2 = WS_WIN + 74 * MiB;
constexpr size_t WS_WFI = WS_WO2 + 16 * MiB;
constexpr size_t WS_WFO = WS_WFI + 44 * MiB;
constexpr size_t WS_X = WS_WFO + 22 * MiB;
constexpr size_t WS_H = WS_X + 129 * MiB;
constexpr size_t WS_QKVA = WS_H + 65 * MiB;
constexpr size_t WS_Z = WS_QKVA + 194 * MiB;
constexpr size_t WS_QB = WS_Z + 65 * MiB;
constexpr size_t WS_KB = WS_QB + 65 * MiB;
constexpr size_t WS_VB = WS_KB + 65 * MiB;
constexpr size_t WS_GAB = WS_VB + 65 * MiB;
constexpr size_t WS_BG = WS_GAB + 129 * MiB;
constexpr size_t WS_MAB = WS_BG + 3 * MiB;
constexpr size_t WS_ACT = WS_MAB + 129 * MiB;
constexpr size_t WS_DIMG = WS_ACT + 178 * MiB;
constexpr size_t WS_KS = WS_DIMG + 293 * MiB;
constexpr size_t WS_VS = WS_KS + 132 * MiB;
constexpr size_t WS_PART = WS_VS + 132 * MiB;
constexpr size_t WS_END = WS_PART + 8 * MiB;
static_assert(WS_END <= 2048 * MiB, "d_ws map");
constexpr int DIMG_BYTES = 73728, IMG_WK = 0, IMG_QG = 16384, IMG_QK = 32768, IMG_KT = 40960, IMG_UV = 57344, IMG_STAGE = 57344;
constexpr int N_DUNITS = NB * NH * 32 + NSB * NH;
constexpr int CW_BAR = 4096;
constexpr int CW_Q = 16384;

constexpr int RING_BYTES = 155648;
constexpr int LDSCTL_OFF = RING_BYTES;
constexpr int LDS_BYTES = 159 * 1024;
constexpr int NWAVES = 8;

__device__ __forceinline__ unsigned pk2h(float lo, float hi) { f32x2 v = {lo, hi}; f16x2 h = __builtin_convertvector(v, f16x2); return __builtin_bit_cast(unsigned, h); }
__device__ __forceinline__ u32x4 pk8h(f32x4 a, f32x4 b) { u32x4 w; w.x = pk2h(a[0], a[1]); w.y = pk2h(a[2], a[3]); w.z = pk2h(b[0], b[1]); w.w = pk2h(b[2], b[3]); return w; }
__device__ __forceinline__ float sigmoidf_(float x) { return __builtin_amdgcn_rcpf(1.0f + __expf(-x)); }
__device__ __forceinline__ float siluf_(float x) { return x * __builtin_amdgcn_rcpf(1.0f + __expf(-x)); }
__device__ __forceinline__ int crow(int r, int hi) { return (r & 3) + 8 * (r >> 2) + 4 * hi; }
#define LDS_WAIT() asm volatile("s_waitcnt lgkmcnt(0)" ::: "memory")
#define VM_WAIT() asm volatile("s_waitcnt vmcnt(0)" ::: "memory")

namespace pg8 {
#define PG8_LAS __attribute__((address_space(3)))
typedef unsigned short bf16_t;
typedef _Float16 bf16x8 __attribute__((ext_vector_type(8)));
typedef float f32x4 __attribute__((ext_vector_type(4)));
typedef unsigned u32x4 __attribute__((ext_vector_type(4)));
constexpr int BM = 256, BK = 64, HALF = 128, HTB = HALF * BK * 2  , STAGE_BYTES = 8 * HTB, NXCD = 8, WGM = 8;

__host__ __device__ __forceinline__ int lds_byte(int r, int c) { const int st = (r >> 4) * 2 + (c >> 5), rr = r & 15, cc = c & 31, ob = rr * 64 + cc * 2; return st * 1024 + (ob ^ (((ob >> 9) & 1) << 5)); }
__host__ __device__ __forceinline__ void stage_rc(int b, int& R, int& C) { const int st = b / 1024, sb = b % 1024, swz = sb ^ (((sb >> 9) & 1) << 5); R = (st >> 1) * 16 + swz / 64; C = (st & 1) * 32 + (swz % 64) / 2; }
__host__ __device__ __forceinline__ int perm32(int rho) { const int n = rho >> 4, i = rho & 15; return 8 * (i >> 2) + 4 * n + (i & 3); }

struct Unit { int pm, pn; };
struct Gemm { const bf16_t* A; const bf16_t* Bt; int M, N, K; };

struct StaticOrder {
    int nM, nN, nwg, G, c, rot = 0;
    __host__ __device__ void init(int M, int N, int G_, int c_) { nM = M / BM; nN = N / BM; nwg = nM * nN; G = G_; c = c_; }
    __host__ __device__ bool next(int i, Unit& u) const {
        const long L = (long)i * G + c; if (L >= nwg) return false;
        int wgid = (int)L; { const int q = nwg / NXCD, r = nwg % NXCD, xcd = wgid % NXCD; int off = wgid / NXCD; if (rot) off = (off + xcd * rot) % (q + (xcd < r ? 1 : 0)); wgid = (xcd < r ? xcd * (q + 1) : r * (q + 1) + (xcd - r) * q) + off; }
        const int nig = WGM * nN, gid = wgid / nig, fm = gid * WGM, gsz = (nM - fm) < WGM ? (nM - fm) : WGM;
        u.pm = fm + ((wgid % nig) % gsz); u.pn = (wgid % nig) / gsz; return true;
    }
    __device__ __forceinline__ void a_ready(const Unit&) const {}
    __device__ __forceinline__ void done(const Unit&) const {}
};
template <class Epi, class Sched, bool ALIGN_EPI = false, bool SP2 = false>
__device__ __forceinline__ void gemm_phase(PG8_LAS unsigned char* lds, const Gemm g, const Sched& S, const Epi& E, int tid_in) {
    int tid_ = tid_in; asm volatile("" : "+v"(tid_));
    const int tid = tid_, wid = __builtin_amdgcn_readfirstlane(tid >> 6), lane = tid & 63, wr = wid >> 2, wc = wid & 3, fr = lane & 15, fq = lane >> 4;
    const int K = g.K, nt = K / BK;
    unsigned voffA[2], voffB[2];
#pragma unroll
    for (int i = 0; i < 2; ++i) { int R, C; stage_rc(tid * 16 + i * 8192, R, C); const int Rb = Epi::PERM ? ((R & ~31) + perm32(R & 31)) : R;
        voffA[i] = (unsigned)(R * K + C) * 2u; voffB[i] = (unsigned)(Rb * K + C) * 2u; }
    const size_t kstep = (size_t)(BK * 2);
    const size_t hstep = (size_t)HALF * K * 2;
    const size_t tstep = 2 * hstep;
    const unsigned ldsw = (unsigned)wid * 1024u;
    const int aoff = lds_byte(wr * 64 + fr, fq * 8), boff = lds_byte(wc * 32 + fr, fq * 8);
#define PG8_SA(b, h) (((b) * 2 + (h)) * HTB)
#define PG8_SB(b, h) ((4 + (b) * 2 + (h)) * HTB)
#define PG8_STAGE(bufoff, gbase, voff) do { _Pragma("unroll") for (int _i = 0; _i < 2; ++_i) \
        __builtin_amdgcn_global_load_lds((const unsigned*)((const char*)(gbase) + (voff)[_i]), (PG8_LAS unsigned*)(lds + (bufoff) + ldsw + _i * 8192), 16, 0, 0); } while (0)
#define PG8_LDA(dst, b, h) do { _Pragma("unroll") for (int m = 0; m < 4; ++m) _Pragma("unroll") for (int k = 0; k < 2; ++k) dst[m][k] = *(const PG8_LAS bf16x8*)(lds + PG8_SA(b, h) + aoff + m * 2048 + k * 1024); } while (0)
#define PG8_LDB(dst, b, h) do { _Pragma("unroll") for (int n = 0; n < 2; ++n) _Pragma("unroll") for (int k = 0; k < 2; ++k) dst[n][k] = *(const PG8_LAS bf16x8*)(lds + PG8_SB(b, h) + boff + n * 2048 + k * 1024); } while (0)
#define PG8_MMA(ai, bj, At, Bt) do { __builtin_amdgcn_s_setprio(1); _Pragma("unroll") for (int m = 0; m < 4; ++m) _Pragma("unroll") for (int n = 0; n < 2; ++n) _Pragma("unroll") for (int k = 0; k < 2; ++k) \
        acc[ai][bj][m][n] = __builtin_amdgcn_mfma_f32_16x16x32_f16(Bt[n][k], At[m][k], acc[ai][bj][m][n], 0, 0, 0); __builtin_amdgcn_s_setprio(0); } while (0)
#define PG8_WAIT_V(n) asm volatile("s_waitcnt vmcnt(" #n ")" ::: "memory")
#define PG8_WAIT_L(n) asm volatile("s_waitcnt lgkmcnt(" #n ")" ::: "memory")
#define PG8_BAR __builtin_amdgcn_s_barrier()
#define PG8_SCHED __builtin_amdgcn_sched_barrier(0)
    Unit cur, nxt; int ui = 0;
    if (!S.next(0, cur)) return;
    f32x4 acc[2][2][4][2];
#pragma unroll
    for (int a = 0; a < 2; ++a)
#pragma unroll
        for (int b = 0; b < 2; ++b)
#pragma unroll
            for (int m = 0; m < 4; ++m)
#pragma unroll
                for (int n = 0; n < 2; ++n) acc[a][b][m][n] = (f32x4){0.f, 0.f, 0.f, 0.f};
    bf16x8 At[4][2], B0[2][2], B1[2][2];
    const char* cA = (const char*)g.A + (size_t)cur.pm * tstep; const char* cB = (const char*)g.Bt + (size_t)cur.pn * tstep;
    S.a_ready(cur);
    if constexpr (SP2) {
        PG8_STAGE(PG8_SB(0, 0), cB, voffB); PG8_STAGE(PG8_SB(0, 1), cB + hstep, voffB); PG8_STAGE(PG8_SA(0, 0), cA, voffA); PG8_STAGE(PG8_SA(0, 1), cA + hstep, voffA);
        if (wr == 1) PG8_BAR;
        PG8_WAIT_V(2); PG8_BAR;
        PG8_STAGE(PG8_SB(1, 0), cB + kstep, voffB); PG8_STAGE(PG8_SA(1, 0), cA + kstep, voffA); PG8_STAGE(PG8_SB(1, 1), cB + hstep + kstep, voffB);
        PG8_WAIT_V(6); PG8_BAR;
    } else {
        PG8_STAGE(PG8_SB(0, 0), cB, voffB); PG8_STAGE(PG8_SA(0, 0), cA, voffA); PG8_STAGE(PG8_SB(0, 1), cB + hstep, voffB); PG8_STAGE(PG8_SA(0, 1), cA + hstep, voffA);
        if (wr == 1) PG8_BAR;
        PG8_WAIT_V(4); PG8_BAR;
        PG8_STAGE(PG8_SB(1, 0), cB + kstep, voffB); PG8_STAGE(PG8_SA(1, 0), cA + kstep, voffA); PG8_STAGE(PG8_SB(1, 1), cB + hstep + kstep, voffB);
        PG8_WAIT_V(6); PG8_BAR;
    }
    for (;;) {
        const bool has_next = S.next(ui + 1, nxt);
        const char* nA = has_next ? (const char*)g.A + (size_t)nxt.pm * tstep : cA; const char* nB = has_next ? (const char*)g.Bt + (size_t)nxt.pn * tstep : cB;
        for (int t = 0; t < nt; t += 2) {
            const bool last = (t == nt - 2);
            const char* a1 = cA + (size_t)(t + 1) * kstep;
            const char* a2 = last ? nA : cA + (size_t)(t + 2) * kstep; const char* b2 = last ? nB : cB + (size_t)(t + 2) * kstep;
            const char* a3 = a2 + kstep; const char* b3 = b2 + kstep;
            if (last && has_next) S.a_ready(nxt);
            if constexpr (SP2) {
            PG8_LDB(B0, 0, 0); PG8_LDB(B1, 0, 1); PG8_SCHED; PG8_LDA(At, 0, 0); PG8_STAGE(PG8_SA(1, 1), a1 + hstep, voffA);
            PG8_WAIT_V(8); PG8_WAIT_L(0); PG8_BAR; PG8_MMA(0, 0, At, B0); PG8_MMA(0, 1, At, B1); PG8_BAR; PG8_SCHED;
            PG8_LDA(At, 0, 1); PG8_STAGE(PG8_SB(0, 0), b2, voffB); PG8_STAGE(PG8_SB(0, 1), b2 + hstep, voffB); PG8_STAGE(PG8_SA(0, 0), a2, voffA);
            PG8_WAIT_V(8); PG8_WAIT_L(0); PG8_BAR; PG8_MMA(1, 0, At, B0); PG8_MMA(1, 1, At, B1); PG8_BAR; PG8_SCHED;
            PG8_LDB(B0, 1, 0); PG8_LDB(B1, 1, 1); PG8_SCHED; PG8_LDA(At, 1, 0); PG8_STAGE(PG8_SA(0, 1), a2 + hstep, voffA);
            PG8_WAIT_V(8); PG8_WAIT_L(0); PG8_BAR; PG8_MMA(0, 0, At, B0); PG8_MMA(0, 1, At, B1); PG8_BAR; PG8_SCHED;
            PG8_LDA(At, 1, 1); PG8_STAGE(PG8_SB(1, 0), b3, voffB); PG8_STAGE(PG8_SB(1, 1), b3 + hstep, voffB); PG8_STAGE(PG8_SA(1, 0), a3, voffA);
            PG8_WAIT_V(8); PG8_WAIT_L(0); PG8_BAR; PG8_MMA(1, 0, At, B0); PG8_MMA(1, 1, At, B1); PG8_BAR; PG8_SCHED;
            } else {
            PG8_LDB(B0, 0, 0); PG8_SCHED; PG8_LDA(At, 0, 0); PG8_STAGE(PG8_SA(1, 1), a1 + hstep, voffA);
            PG8_WAIT_L(8); PG8_BAR; PG8_WAIT_L(0); PG8_MMA(0, 0, At, B0); PG8_BAR; PG8_SCHED;
            PG8_LDB(B1, 0, 1); PG8_STAGE(PG8_SB(0, 0), b2, voffB);
            PG8_BAR; PG8_WAIT_L(0); PG8_MMA(0, 1, At, B1); PG8_BAR;
            PG8_LDA(At, 0, 1); PG8_STAGE(PG8_SA(0, 0), a2, voffA);
            PG8_BAR; PG8_WAIT_L(0); PG8_MMA(1, 0, At, B0); PG8_BAR; PG8_SCHED;
            PG8_STAGE(PG8_SB(0, 1), b2 + hstep, voffB);
            PG8_WAIT_V(6); PG8_BAR; PG8_MMA(1, 1, At, B1); PG8_BAR;
            PG8_LDB(B0, 1, 0); PG8_SCHED; PG8_LDA(At, 1, 0); PG8_STAGE(PG8_SA(0, 1), a2 + hstep, voffA);
            PG8_WAIT_L(8); PG8_BAR; PG8_WAIT_L(0); PG8_MMA(0, 0, At, B0); PG8_BAR; PG8_SCHED;
            PG8_LDB(B1, 1, 1); PG8_STAGE(PG8_SB(1, 0), b3, voffB);
            PG8_BAR; PG8_WAIT_L(0); PG8_MMA(0, 1, At, B1); PG8_BAR;
            PG8_LDA(At, 1, 1); PG8_STAGE(PG8_SA(1, 0), a3, voffA);
            PG8_BAR; PG8_WAIT_L(0); PG8_MMA(1, 0, At, B0); PG8_BAR; PG8_SCHED;
            PG8_STAGE(PG8_SB(1, 1), b3 + hstep, voffB);
            PG8_WAIT_V(6); PG8_BAR; PG8_MMA(1, 1, At, B1); PG8_BAR;
            }
        }
        if constexpr (ALIGN_EPI) { if (wr == 0) PG8_BAR; }
        if constexpr (!Epi::AFTER_DRAIN) { E(acc, cur, wr, wc, fr, fq); S.done(cur); }
        if (!has_next) break;
#pragma unroll
        for (int a = 0; a < 2; ++a)
#pragma unroll
            for (int b = 0; b < 2; ++b)
#pragma unroll
                for (int m = 0; m < 4; ++m)
#pragma unroll
                    for (int n = 0; n < 2; ++n) acc[a][b][m][n] = (f32x4){0.f, 0.f, 0.f, 0.f};
        cur = nxt; cA = nA; cB = nB; ++ui;
        if constexpr (ALIGN_EPI) { if (wr == 1) PG8_BAR; }
    }
    PG8_WAIT_V(0);
    if constexpr (!ALIGN_EPI) { if (wr == 0) PG8_BAR; }
    PG8_BAR;
    if constexpr (Epi::AFTER_DRAIN) { E.fused(acc, cur, wr, wc, fr, fq, lds, wid, lane); S.done(cur); }
#undef PG8_SA
#undef PG8_SB
#undef PG8_STAGE
#undef PG8_LDA
#undef PG8_LDB
#undef PG8_MMA
#undef PG8_WAIT_V
#undef PG8_WAIT_L
#undef PG8_BAR
#undef PG8_SCHED
}
}

#define XB_TMO      128
#define XB_XCNT(j)  (256  + 64 * (j))
#define XB_XSUB(j)  (1280 + 64 * (j))
#define XB_XGEN(j)  (2304 + 64 * (j))
#define XB_TOP      3328
#define XB_TOPGEN   3392
#define XCD_BAR_WORDS 3456
#define XB_SPIN_CAP (1u << 18)

__device__ __forceinline__ unsigned xb_ld(unsigned* p)              { return __hip_atomic_load(p, __ATOMIC_RELAXED, __HIP_MEMORY_SCOPE_AGENT); }
__device__ __forceinline__ unsigned xb_add(unsigned* p, unsigned v) { return __hip_atomic_fetch_add(p, v, __ATOMIC_RELAXED, __HIP_MEMORY_SCOPE_AGENT); }
__device__ __forceinline__ unsigned xb_xcc_id() { return (unsigned)__builtin_amdgcn_s_getreg((3 << 11) | 20) & 0xFu; }
#define XB_SPIN(cond, bar) do { unsigned _sp = 0; while (cond) { __builtin_amdgcn_s_sleep(1); \
    if ((++_sp & 255u) == 0u) { if (xb_ld(&(bar)[XB_TMO])) break; if (_sp > XB_SPIN_CAP) { atomicAdd(&(bar)[XB_TMO], 1u); break; } } } } while (0)

struct XcdBarrier {
    unsigned* bar; unsigned x;
    volatile LAS unsigned* st;
};

__device__ __forceinline__ XcdBarrier xcd_barrier_post(unsigned* bar, volatile LAS unsigned* st) {
    XcdBarrier b; b.bar = bar; b.x = xb_xcc_id(); b.st = st;
    if (threadIdx.x == 0) (void)xb_add(&bar[XB_XCNT(b.x)], 1u);
    return b;
}
__device__ __forceinline__ void xcd_barrier_complete(unsigned* bar, unsigned x, unsigned& nloc, unsigned& nx) {
    const unsigned G = gridDim.x * gridDim.y * gridDim.z;
    unsigned sum, cnt, mine, sp = 0u;
    for (;;) {
        sum = 0u; cnt = 0u; mine = 0u;
#pragma unroll
        for (unsigned j = 0; j < 16; ++j) { const unsigned c = xb_ld(&bar[XB_XCNT(j)]); sum += c; cnt += (c > 0u) ? 1u : 0u; mine = (j == x) ? c : mine; }
        if (sum == G) break;
        __builtin_amdgcn_s_sleep(1);
        if ((++sp & 255u) == 0u) { if (xb_ld(&bar[XB_TMO])) break; if (sp > XB_SPIN_CAP) { atomicAdd(&bar[XB_TMO], 1u); break; } }
    }
    nloc = mine > 0u ? mine : 1u; nx = cnt > 0u ? cnt : 1u;
}

__device__ __forceinline__ void xcd_barrier(const XcdBarrier& b) {
    asm volatile("s_waitcnt vmcnt(0)" ::: "memory");
    __syncthreads();
    if (threadIdx.x == 0) {
        unsigned* bar = b.bar;
        __builtin_amdgcn_s_waitcnt(0);
        unsigned nloc = b.st[0], nx = b.st[1];
        if (nloc == 0u) { xcd_barrier_complete(bar, b.x, nloc, nx); b.st[0] = nloc; b.st[1] = nx; }
        const unsigned old = xb_add(&bar[XB_XSUB(b.x)], 1u);
        const unsigned gen = old / nloc;
        if (old + 1u == (gen + 1u) * nloc) {
            __builtin_amdgcn_fence(__ATOMIC_RELEASE, "agent");
            asm volatile("s_waitcnt vmcnt(0)" ::: "memory");
            const unsigned og = xb_add(&bar[XB_TOP], 1u);
            const unsigned tg = og / nx;
            if (og + 1u == (tg + 1u) * nx) xb_add(&bar[XB_TOPGEN], 1u);
            else XB_SPIN(xb_ld(&bar[XB_TOPGEN]) == tg, bar);
            __builtin_amdgcn_fence(__ATOMIC_ACQUIRE, "agent");
            xb_add(&bar[XB_XGEN(b.x)], 1u);
            asm volatile("s_waitcnt vmcnt(0)" ::: "memory");
        } else {
            XB_SPIN(xb_ld(&bar[XB_XGEN(b.x)]) == gen, bar);
            __builtin_amdgcn_fence(__ATOMIC_ACQUIRE, "agent");
            asm volatile("s_waitcnt vmcnt(0)" ::: "memory");
        }
    }
    __syncthreads();
}


struct Frame {
    LAS unsigned char* lds;
    volatile LAS unsigned* MISC;
    unsigned* ctl;
    int tid, lane, wave, vcu, G, bx;
    float* out;
    unsigned char* ws;
};
enum { I_XP = 0, I_XS, I_CK, I_CV, I_SCONV, I_SDELTA, I_CP, I_CS, I_LNG, I_LNB, I_RELB, I_WADA, I_BADA, I_WIN, I_CONVW, I_ALOG, I_DTB, I_NORMA, I_LAM, I_SUBLN, I_WO, I_LN1G, I_LN1B, I_WFI, I_WFO, I_LN2G, I_LN2B };

constexpr int LDS_INP_OFF = LDSCTL_OFF + 256;
__device__ __forceinline__ const float* inp(const Frame& F, int i) {
    const unsigned long long v = *((volatile LAS unsigned long long*)(F.lds + LDS_INP_OFF) + i);
    const unsigned lo = __builtin_amdgcn_readfirstlane((unsigned)v), hi = __builtin_amdgcn_readfirstlane((unsigned)(v >> 32));
    return (const float*)(const GAS float*)(((unsigned long long)hi << 32) | lo);
}
template <class T> __device__ __forceinline__ T* as_global(T* p) { return (T*)(GAS T*)(unsigned long long)p; }
__device__ __forceinline__ int hw_lane() { int l; asm volatile("v_mbcnt_lo_u32_b32 %0, -1, 0\n\tv_mbcnt_hi_u32_b32 %0, -1, %0" : "=v"(l)); return l; }
#define PHASE_FRAME(P) Frame P = F; P.lane = hw_lane(); \
    asm volatile("" : "+s"(P.ws), "+s"(P.out), "+s"(P.ctl), "+s"(P.G), "+s"(P.vcu), "+s"(P.bx), "+s"(P.wave)); P.tid = P.wave * 64 + P.lane; \
    P.ws = as_global(P.ws); P.out = as_global(P.out); P.ctl = as_global(P.ctl)
__device__ __forceinline__ unsigned char* ws_of(const Frame& F) { unsigned char* w = F.ws; asm volatile("" : "+s"(w)); return as_global(w); }
__device__ __forceinline__ float wave_sum(float v) {
#pragma unroll
    for (int o = 1; o < 64; o <<= 1) v += __shfl_xor(v, o);
    return v;
}
__device__ __forceinline__ f32x16 mfma32(f16x8 a, f16x8 b, f32x16 c) { return __builtin_amdgcn_mfma_f32_32x32x16_f16(a, b, c, 0, 0, 0); }
__device__ __forceinline__ f16x8 cvt8(const f32x16& v, int o) {
    u32x4 w; w.x = pk2h(v[o], v[o + 1]); w.y = pk2h(v[o + 2], v[o + 3]); w.z = pk2h(v[o + 4], v[o + 5]); w.w = pk2h(v[o + 6], v[o + 7]); return __builtin_bit_cast(f16x8, w);
}

__device__ __forceinline__ int bb_of_row(int row) { return row < MP ? (row >> 11) : NB + ((row - MP) >> 5); }

#define EPI_ROWS(BODY) _Pragma("unroll") for (int ai = 0; ai < 2; ++ai) _Pragma("unroll") for (int m = 0; m < 4; ++m) { const int row = u.pm * 256 + ai * 128 + wr * 64 + m * 16 + fr; \
        _Pragma("unroll") for (int bj = 0; bj < 2; ++bj) { const int c = cb0 + bj * 128; const f32x4 v0 = acc[ai][bj][m][0], v1 = acc[ai][bj][m][1]; BODY } }
struct EpiProj {
    static constexpr bool PERM = true, AFTER_DRAIN = false;
    f16 *QKVA, *Z, *QB, *KB, *VB, *GAB; float* BG; f16 *KS, *VS; float* out; int layer;
    __device__ __forceinline__ void operator()(const f32x4 (&acc)[2][2][4][2], const pg8::Unit& u, int wr, int wc, int fr, int fq) const {
        asm volatile("" : "+v"(fr), "+v"(fq));
        const int pn = u.pn; const bool samp = u.pm == MP / 256;
        const int cb0 = (pn * 256 + wc * 32 + 8 * fq) - (pn < 12 ? 0 : pn < 24 ? 5120 : pn < 28 ? 6144 : pn < 32 ? 7168 : pn < 36 ? 8192 : 9216);
        if (pn < 12) {
            EPI_ROWS( *(u32x4*)(QKVA + (size_t)row * CONVC + c) = pk8h(v0, v1);
                      const int t = samp ? ((row - MP) & 31) - 29 : (row & 2047) - 2045;
                      if (t >= 0) { float* o = out + (samp ? OUT_CS + ((size_t)(layer * NSB + ((row - MP) >> 5)) * 3 + t) * CONVC : OUT_CP + ((size_t)(layer * NB + (row >> 11)) * 3 + t) * CONVC) + c;
                                    __builtin_nontemporal_store(v0, (f32x4*)o); __builtin_nontemporal_store(v1, (f32x4*)(o + 4)); } )
        } else if (pn < 20) {
            _Pragma("unroll") for (int ai = 0; ai < 2; ++ai) _Pragma("unroll") for (int m = 0; m < 4; ++m) { const int row = u.pm * 256 + ai * 128 + wr * 64 + m * 16 + fr;
                f32x4 a0, a1;
                _Pragma("unroll") for (int i = 0; i < 4; ++i) { a0[i] = siluf_(acc[ai][0][m][0][i]) * sigmoidf_(acc[ai][1][m][0][i]); a1[i] = siluf_(acc[ai][0][m][1][i]) * sigmoidf_(acc[ai][1][m][1][i]); }
                *(u32x4*)(Z + (size_t)row * D + (pn - 12) * 128 + wc * 32 + 8 * fq) = pk8h(a0, a1); }
        } else if (pn < 24) {
            const float sc = 0.125f * LOG2E;
            EPI_ROWS( *(u32x4*)(QB + (size_t)row * D + c) = pk8h(v0 * sc, v1 * sc); )
        } else if (pn < 32) {
            const bool isk = pn < 28;
            if (!samp) { f16* dst = isk ? KB : VB;
                EPI_ROWS( *(u32x4*)(dst + (size_t)row * D + c) = pk8h(v0, v1); )
            } else { f16* dst = isk ? KS : VS; float* ob = out + (isk ? OUT_KS : OUT_VS) + (size_t)layer * MS * D;
                EPI_ROWS( const int sr = row - MP; *(u32x4*)(dst + ((size_t)(sr >> 5) * KSROWS + PAST + (sr & 31)) * D + c) = pk8h(v0, v1); float* o = ob + (size_t)sr * D + c; __builtin_nontemporal_store(v0, (f32x4*)o); __builtin_nontemporal_store(v1, (f32x4*)(o + 4)); )
            }
        } else if (pn < 36) {
            EPI_ROWS( f32x4 s0; f32x4 s1;
                      _Pragma("unroll") for (int i = 0; i < 4; ++i) { s0[i] = sigmoidf_(v0[i]); s1[i] = sigmoidf_(v1[i]); }
                      *(u32x4*)(GAB + (size_t)row * D + c) = pk8h(s0, s1); )
        } else {
            if (wc == 0 && fq < 2) {
                EPI_ROWS( if (bj == 0) { *(f32x4*)(BG + (size_t)row * 16 + c) = v0; *(f32x4*)(BG + (size_t)row * 16 + c + 4) = v1; } )
            }
        }
    }
};
#undef EPI_ROWS
struct EpiRes {
    static constexpr bool PERM = false, AFTER_DRAIN = false;
    f16* X; const float* gate;
    __device__ __forceinline__ void operator()(const f32x4 (&acc)[2][2][4][2], const pg8::Unit& u, int wr, int wc, int fr, int fq) const {
        asm volatile("" : "+v"(fr), "+v"(fq));
#pragma unroll
        for (int ai = 0; ai < 2; ++ai)
#pragma unroll
            for (int m = 0; m < 4; ++m) {
                const int row = u.pm * 256 + ai * 128 + wr * 64 + m * 16 + fr;
                const float* gp = gate + (size_t)bb_of_row(row) * 6144; f16* xp = X + (size_t)row * D;
#pragma unroll
                for (int bj = 0; bj < 2; ++bj)
#pragma unroll
                    for (int n = 0; n < 2; ++n) {
                        const int c = u.pn * 256 + bj * 128 + wc * 32 + n * 16 + 4 * fq;
                        const f32x4 g = *(const f32x4*)(gp + c); const f16x4 xh = *(const f16x4*)(xp + c);
                        const f32x4 x = (f32x4){(float)xh[0], (float)xh[1], (float)xh[2], (float)xh[3]} * ALPHA + g * acc[ai][bj][m][n];
                        u32x2 w; w.x = pk2h(x[0], x[1]); w.y = pk2h(x[2], x[3]); *(u32x2*)(xp + c) = w;
                    }
                asm volatile("" ::: "memory");
            }
    }
};
struct EpiSwiGLU {
    static constexpr bool PERM = true, AFTER_DRAIN = false;
    f16* ACT;
    __device__ __forceinline__ void operator()(const f32x4 (&acc)[2][2][4][2], const pg8::Unit& u, int wr, int wc, int fr, int fq) const {
        asm volatile("" : "+v"(fr), "+v"(fq));
#pragma unroll
        for (int ai = 0; ai < 2; ++ai)
#pragma unroll
            for (int m = 0; m < 4; ++m) {
                const int row = u.pm * 256 + ai * 128 + wr * 64 + m * 16 + fr;
                f32x4 a0, a1;
#pragma unroll
                for (int i = 0; i < 4; ++i) { a0[i] = siluf_(acc[ai][0][m][0][i]) * acc[ai][1][m][0][i]; a1[i] = siluf_(acc[ai][0][m][1][i]) * acc[ai][1][m][1][i]; }
                *(u32x4*)(ACT + (size_t)row * DFF + u.pn * 128 + wc * 32 + 8 * fq) = pk8h(a0, a1);
            }
    }
};

__device__ __forceinline__ void cache_slice_load(Frame& F, int layer, int k, f32x4 (&v)[4]) {
#pragma unroll
    for (int j = 0; j < 2; ++j) {
        const size_t c = (size_t)F.vcu * 16384 + (size_t)k * 1024 + F.tid + 512 * j;
        const bool isv = c >= (size_t)NSB * PAST * D / 8; const size_t cc = isv ? c - (size_t)NSB * PAST * D / 8 : c;
        const float* src = inp(F, isv ? I_CV : I_CK) + (size_t)layer * NSB * PAST * D + cc * 8;
        v[2 * j] = *(const f32x4*)src; v[2 * j + 1] = *(const f32x4*)(src + 4);
    }
}
__device__ __forceinline__ void cache_slice_store(Frame& F, int layer, int k, const f32x4 (&v)[4]) {
#pragma unroll
    for (int j = 0; j < 2; ++j) {
        const size_t c = (size_t)F.vcu * 16384 + (size_t)k * 1024 + F.tid + 512 * j;
        const bool isv = c >= (size_t)NSB * PAST * D / 8; const size_t cc = isv ? c - (size_t)NSB * PAST * D / 8 : c;
        const size_t sb = cc / (PAST * D / 8), rem = cc % (PAST * D / 8);
        f16* dst = (f16*)(F.ws + (isv ? WS_VS : WS_KS)) + ((size_t)layer * NSB + sb) * KSROWS * D + rem * 8;
        *(u32x4*)dst = pk8h(v[2 * j], v[2 * j + 1]);
    }
}

template <int NSTEP  > __device__ __forceinline__ void thin_gemm(Frame& F, const f16* A, int lda, const f16* Bt, int K) {
    const int w = F.vcu * NWAVES + F.wave; if (w >= 2048) return;
    const int rb = w & 7, cg = (w >> 3) & 31, ks = w >> 8, r32 = F.lane & 31, hi = F.lane >> 5;
    const f16* ap = A + (size_t)(32 * rb + r32) * lda + ks * (16 * NSTEP) + 8 * hi;
    const f16* bp = Bt + (size_t)(32 * cg + r32) * K + ks * (16 * NSTEP) + 8 * hi;
    f32x16 acc = {};
    constexpr int HB = NSTEP / 2;
#pragma unroll
    for (int h0 = 0; h0 < NSTEP; h0 += HB) {
        f16x8 av[HB], bv[HB];
#pragma unroll
        for (int s = 0; s < HB; ++s) { av[s] = *(const f16x8*)(ap + 16 * (h0 + s)); bv[s] = *(const f16x8*)(bp + 16 * (h0 + s)); }
#pragma unroll
        for (int s = 0; s < HB; ++s) acc = mfma32(av[s], bv[s], acc);
    }
    float* pp = (float*)(F.ws + WS_PART) + ((size_t)ks * MS + 32 * rb) * D + 32 * cg + r32;
#pragma unroll
    for (int r = 0; r < 16; ++r) pp[(size_t)crow(r, hi) * D] = acc[r];
}

__device__ __forceinline__ int win_src_col(int d) {
    if (d < 3072) return d;
    if (d < 5120) { const int t = (d - 3072) >> 8, j = (d - 3072) & 255; return j < 128 ? 3072 + 128 * t + j : 7184 + 128 * t + (j - 128); }
    if (d < 8192) return d - 5120 + 4112;
    if (d < 9216) return d - 8192 + 8208;
    if (d < 9232) return d - 9216 + 4096;
    return -1;
}
__device__ __forceinline__ int wfi_src_col(int d) { const int t = d >> 8, w = d & 255; return w < 128 ? 128 * t + w : DFF + 128 * t + (w - 128); }
__device__ __forceinline__ void transpose_item(const float* W, int ldw, int ksrc0, int srccol, f16* WT, int ldwt, int drow0, int kdst0, LAS float* scr, int lane) {
#pragma unroll 8
    for (int i = 0; i < 32; ++i) { const int kk = 2 * i + (lane >> 5); scr[kk * 33 + (lane & 31)] = srccol >= 0 ? W[(size_t)(ksrc0 + kk) * ldw + srccol] : 0.f; }
    LDS_WAIT(); asm volatile("" ::: "memory");
    const int c = lane & 7;
#pragma unroll
    for (int j = 0; j < 4; ++j) { const int n = (lane >> 3) + 8 * j; const LAS float* s = scr + (8 * c) * 33 + n;
        u32x4 o; o.x = pk2h(s[0 * 33], s[1 * 33]); o.y = pk2h(s[2 * 33], s[3 * 33]); o.z = pk2h(s[4 * 33], s[5 * 33]); o.w = pk2h(s[6 * 33], s[7 * 33]);
        *(u32x4*)(WT + (size_t)(drow0 + n) * ldwt + kdst0 + 8 * c) = o; }
    LDS_WAIT(); asm volatile("" ::: "memory");
}
__device__ __forceinline__ int t5_bucket(int rel) {
    const int n = rel < 0 ? -rel : rel;
    const int large = 8 + (n >= 12) + (n >= 16) + (n >= 23) + (n >= 32) + (n >= 46) + (n >= 64) + (n >= 91);
    return (rel > 0 ? 16 : 0) + (n < 8 ? n : large);
}
__device__ __forceinline__ void p0a_prologue(Frame& F) {
    const int gw = F.vcu * NWAVES + F.wave, NGW = F.G * NWAVES;
    const int gt = F.vcu * 512 + F.tid, NGT = F.G * 512;
    if (F.vcu < 192) {
        LAS float* sT = (LAS float*)F.lds;
        LAS float* red = (LAS float*)(F.lds + 98304);
        for (int i = F.tid; i < NBB * D; i += 512) { const int bb = i >> 10, d = i & 1023; const float c = bb < NB ? inp(F, I_CP)[bb * D + d] : inp(F, I_CS)[(bb - NB) * D + d]; sT[d * NBB + bb] = siluf_(c); }
        __syncthreads();
        const int cidx = F.vcu * 128 + (F.tid & 127), l = cidx / 6144, e = cidx % 6144, dq = F.tid >> 7;
        float acc[NBB];
#pragma unroll
        for (int b = 0; b < NBB; ++b) acc[b] = 0.f;
        const float* wp = inp(F, I_WADA) + ((size_t)l * D + dq * 256) * 6144 + e;
#pragma unroll 4
        for (int d = 0; d < 256; ++d) {
            const float w = wp[(size_t)d * 6144];
            const LAS f32x4* sp = (const LAS f32x4*)(sT + (dq * 256 + d) * NBB);
#pragma unroll
            for (int q = 0; q < 6; ++q) { const f32x4 s = sp[q]; acc[4 * q] += s[0] * w; acc[4 * q + 1] += s[1] * w; acc[4 * q + 2] += s[2] * w; acc[4 * q + 3] += s[3] * w; }
        }
        for (int r = 0; r < 4; ++r) {
            if (dq == r) {
#pragma unroll
                for (int b = 0; b < NBB; ++b) { LAS float* p = red + b * 128 + (F.tid & 127); *p = (r == 0 ? 0.f : *p) + acc[b]; }
            }
            __syncthreads();
        }
        float* mod = (float*)(F.ws + WS_MOD);
        for (int i = F.tid; i < NBB * 128; i += 512) { const int b = i >> 7, cc = i & 127; const int ci = F.vcu * 128 + cc, ll = ci / 6144, ee = ci % 6144;
            mod[((size_t)ll * NBB + b) * 6144 + ee] = red[b * 128 + cc] + inp(F, I_BADA)[ll * 6144 + ee]; }
        __syncthreads();
    }
    {
        LAS float* scr = (LAS float*)(F.lds + F.wave * 16384);
        constexpr int I_IN = 16 * (NPROJ / 32), I_O = 32 * 32, I_FI = 16 * (2 * DFF / 32), I_FO = (DFF / 64) * 32, I_L = I_IN + I_O + I_FI + I_FO;
        for (int it = gw; it < DEPTH * I_L; it += NGW) {
            const int l = it / I_L; int r = it % I_L;
            if (r < I_IN) { const int kb = r / (NPROJ / 32), nb = r % (NPROJ / 32);
                transpose_item(inp(F, I_WIN) + (size_t)l * D * DIN, DIN, 64 * kb, win_src_col(32 * nb + (F.lane & 31)), (f16*)(F.ws + WS_WIN) + (size_t)l * NPROJ * D, D, 32 * nb, 64 * kb, scr, F.lane); continue; }
            r -= I_IN;
            if (r < I_O) { const int kb = r / 32, nb = r % 32;
                transpose_item(inp(F, I_WO) + (size_t)l * D * D, D, (64 * kb) & 1023, 32 * nb + (F.lane & 31), (f16*)(F.ws + WS_WO2) + (size_t)l * D * 2048, 2048, 32 * nb, 64 * kb, scr, F.lane); continue; }
            r -= I_O;
            if (r < I_FI) { const int kb = r / (2 * DFF / 32), nb = r % (2 * DFF / 32);
                transpose_item(inp(F, I_WFI) + (size_t)l * D * 2 * DFF, 2 * DFF, 64 * kb, wfi_src_col(32 * nb + (F.lane & 31)), (f16*)(F.ws + WS_WFI) + (size_t)l * 2 * DFF * D, D, 32 * nb, 64 * kb, scr, F.lane); continue; }
            r -= I_FI;
            { const int kb = r / 32, nb = r % 32;
                transpose_item(inp(F, I_WFO) + (size_t)l * DFF * D, D, 64 * kb, 32 * nb + (F.lane & 31), (f16*)(F.ws + WS_WFO) + (size_t)l * D * DFF, DFF, 32 * nb, 64 * kb, scr, F.lane); }
        }
    }
    {
        const int nz = DEPTH * NSB * 32 * D / 8;
        for (int i = gt; i < 2 * nz; i += NGT) {
            const bool isv = i >= nz; const int j = isv ? i - nz : i;
            const int lsb = j / (32 * D / 8), rem = j % (32 * D / 8);
            f16* dst = (f16*)(F.ws + (isv ? WS_VS : WS_KS)) + ((size_t)lsb * KSROWS + PAST + 32) * D + rem * 8;
            *(u32x4*)dst = (u32x4){0u, 0u, 0u, 0u};
        }
    }
    if (F.vcu == F.G - 1) {
        float* misc = (float*)(F.ws + WS_MISC);
        if (F.wave < DEPTH) {
            const float* lp = inp(F, I_LAM) + F.wave * 4 * 64;
            const float s01 = wave_sum(lp[F.lane] * lp[64 + F.lane]), s23 = wave_sum(lp[128 + F.lane] * lp[192 + F.lane]);
            const float lam_init = 0.8f - 0.6f * expf(-0.3f * (float)F.wave);
            if (F.lane == 0) { misc[F.wave] = expf(s01) - expf(s23) + lam_init; misc[8 + F.wave] = 1.0f - lam_init; }
        }
        for (int i = F.tid; i < NH * 256; i += 512) { const int h = i >> 8, rel = (i & 255) - 128; misc[64 + i] = inp(F, I_RELB)[t5_bucket(rel) * NH + h] * LOG2E; }
    }
}
__device__ __forceinline__ void ld8(const float* p, float (&v)[8]) { const f32x4 a = *(const f32x4*)p, c = *(const f32x4*)(p + 4); v[0] = a[0]; v[1] = a[1]; v[2] = a[2]; v[3] = a[3]; v[4] = c[0]; v[5] = c[1]; v[6] = c[2]; v[7] = c[3]; }
__device__ __forceinline__ void ld8(const f16* p, float (&v)[8]) { const f16x8 a = *(const f16x8*)p;
#pragma unroll
    for (int e = 0; e < 8; ++e) v[e] = (float)a[e]; }
__device__ __forceinline__ void st8(float* p, const float (&v)[8]) { *(f32x4*)p = (f32x4){v[0], v[1], v[2], v[3]}; *(f32x4*)(p + 4) = (f32x4){v[4], v[5], v[6], v[7]}; }
__device__ __forceinline__ void st8(f16* p, const float (&v)[8]) { *(u32x4*)p = (u32x4){pk2h(v[0], v[1]), pk2h(v[2], v[3]), pk2h(v[4], v[5]), pk2h(v[6], v[7])}; }
template <class TS, class TD> __device__ __forceinline__ void ln_row(const TS* src, const float* g, const float* b, TD* dst, f16* hrow, const float* sh, const float* sc, int lane, const float* part, const float* gate) {
    float v[2][8]; float s = 0.f;
#pragma unroll
    for (int j = 0; j < 2; ++j) ld8(src + 8 * lane + 512 * j, v[j]);
    if (part) {
#pragma unroll
        for (int j = 0; j < 2; ++j) { const int c = 8 * lane + 512 * j; float y[8], t[8], gt[8]; ld8(part + c, y);
#pragma unroll
            for (int k = 1; k < 8; ++k) { ld8(part + (size_t)k * MS * D + c, t);
#pragma unroll
                for (int e = 0; e < 8; ++e) y[e] += t[e]; }
            ld8(gate + c, gt);
#pragma unroll
            for (int e = 0; e < 8; ++e) v[j][e] = v[j][e] * ALPHA + gt[e] * y[e]; }
    }
#pragma unroll
    for (int j = 0; j < 2; ++j)
#pragma unroll
        for (int e = 0; e < 8; ++e) s += v[j][e];
    const float mean = wave_sum(s) * (1.f / D); float s2 = 0.f;
#pragma unroll
    for (int j = 0; j < 2; ++j)
#pragma unroll
        for (int e = 0; e < 8; ++e) { v[j][e] -= mean; s2 += v[j][e] * v[j][e]; }
    const float rstd = 1.0f / sqrtf(wave_sum(s2) * (1.f / D) + LN_EPS);
#pragma unroll
    for (int j = 0; j < 2; ++j) {
        const int c = 8 * lane + 512 * j; float gg[8], bb[8], x[8];
        ld8(g + c, gg); ld8(b + c, bb);
#pragma unroll
        for (int e = 0; e < 8; ++e) x[e] = v[j][e] * rstd * gg[e] + bb[e];
        st8(dst + c, x);
        if (hrow) { float s1[8], s0[8], hh[8]; ld8(sc + c, s1); ld8(sh + c, s0);
#pragma unroll
            for (int e = 0; e < 8; ++e) hh[e] = x[e] * (s1[e] + 1.0f) + s0[e];
            st8(hrow + c, hh); }
    }
}
__device__ __forceinline__ void ln_phase(Frame& F, bool first, bool last, const float* g, const float* b, const float* modl, int sh_off, int sc_off, const float* gate_l = nullptr) {
    const int gw = F.vcu * NWAVES + F.wave, NGW = F.G * NWAVES;
    f16* X = (f16*)(F.ws + WS_X); f16* H = (f16*)(F.ws + WS_H);
    for (int m = gw; m < M; m += NGW) {
        const float* mb = modl + (size_t)bb_of_row(m) * 6144;
        const bool sp = gate_l != nullptr && m >= MP;
        const float* part = sp ? (const float*)(F.ws + WS_PART) + (size_t)(m - MP) * D : nullptr; const float* gate = sp ? gate_l + (size_t)bb_of_row(m) * 6144 : nullptr;
        if (first) ln_row(m < MP ? inp(F, I_XP) + (size_t)m * D : inp(F, I_XS) + (size_t)(m - MP) * D, g, b, X + (size_t)m * D, H + (size_t)m * D, mb + sh_off, mb + sc_off, F.lane, part, gate);
        else if (last) ln_row(X + (size_t)m * D, g, b, m < MP ? F.out + OUT_YP + (size_t)m * D : F.out + OUT_YS + (size_t)(m - MP) * D, (f16*)nullptr, mb + sh_off, mb + sc_off, F.lane, part, gate);
        else ln_row(X + (size_t)m * D, g, b, X + (size_t)m * D, H + (size_t)m * D, mb + sh_off, mb + sc_off, F.lane, part, gate);
    }
}

constexpr int D1_KN = 0, D1_QN = 17408, D1_RT0 = 34816, D1_RT1 = 71680, D1_AM = 108544, D1_TM = 125952, D1_SC = 135168, D1_SS = 137216, D1_AH = 141312, D1_W = 143872;
struct D1Task { int row0, nvalid, n, unit; const float* hist; };

#define LDS_BARRIER() do { __builtin_amdgcn_fence(__ATOMIC_RELEASE, "workgroup", "local"); __builtin_amdgcn_s_barrier(); __builtin_amdgcn_fence(__ATOMIC_ACQUIRE, "workgroup", "local"); } while (0)
#define D1_LOCALS \
    LAS unsigned char* L = F.lds; \
    LAS f16* Kn = (LAS f16*)(L + D1_KN); LAS f16* Qn = (LAS f16*)(L + D1_QN); LAS f16* RT = (LAS f16*)(L + (rtb ? D1_RT1 : D1_RT0)); \
    LAS float* Am = (LAS float*)(L + D1_AM); LAS f16* Tm = (LAS f16*)(L + D1_TM); \
    LAS float* sBeta = (LAS float*)(L + D1_SC); LAS float* sG = sBeta + 64; \
    LAS float* sSS = (LAS float*)(L + D1_SS); LAS f16* Ah = (LAS f16*)(L + D1_AH); \
    int lane = hw_lane(), wave = F.wave; asm volatile("" : "+s"(wave));        \
    const int r32 = lane & 31, hi = lane >> 5, l = lane; \
    const f16* QKVA = (const f16*)(F.ws + WS_QKVA); const float* BG = (const float*)(F.ws + WS_BG); \
    unsigned char* img = F.ws + WS_DIMG + (size_t)T.unit * DIMG_BYTES; \
    (void)Kn; (void)Qn; (void)RT; (void)Am; (void)Tm; (void)sBeta; (void)sG; (void)sSS; (void)Ah; (void)r32; (void)hi; (void)l; (void)QKVA; (void)BG; (void)img; (void)wave

__device__ __forceinline__ void d1_wload(Frame& F, int h, int layer, float (&w)[3]) {
    const float* cw = inp(F, I_CONVW) + (size_t)layer * 4 * CONVC;
    const int tid = F.wave * 64 + hw_lane();
#pragma unroll
    for (int j = 0; j < 3; ++j) { const int idx = tid + 512 * j; w[j] = cw[((idx >> 7) & 3) * CONVC + (idx >> 9) * 1024 + h * 128 + (idx & 127)]; }
}
__device__ __forceinline__ void d1_wstore(Frame& F, const float (&w)[3]) {
    LAS float* Wl = (LAS float*)(F.lds + D1_W);
    const int tid = F.wave * 64 + hw_lane();
#pragma unroll
    for (int j = 0; j < 3; ++j) Wl[tid + 512 * j] = w[j];
}
__device__ __forceinline__ void d1_s1(Frame& F, const D1Task& T, int h, int layer, int rtb, float (&xq)[16], float (&xk)[16], float& beta_o, float& eg_o, float& egl_o) {
    D1_LOCALS;
    const bool valid = l < T.nvalid, first = T.n == 0;
    f16x8 rm[3][2], rh[3][2];
    const int lr = l < T.nvalid ? l : T.nvalid - 1; const float vmask = valid ? 1.f : 0.f;
#pragma unroll
    for (int tz = 0; tz < 3; ++tz) {
        const f16* p = QKVA + (size_t)(T.row0 + lr) * CONVC + tz * 1024 + h * 128 + 16 * wave;
        rm[tz][0] = *(const f16x8*)p; rm[tz][1] = *(const f16x8*)(p + 8);
        if (!first) { const f16* ph = QKVA + (size_t)(T.row0 + (l >= 3 ? l : l - 3)) * CONVC + tz * 1024 + h * 128 + 16 * wave; rh[tz][0] = *(const f16x8*)ph; rh[tz][1] = *(const f16x8*)(ph + 8); }
        else if (T.hist) { const float* ph = T.hist + (size_t)(l < 3 ? l : 0) * CONVC + tz * 1024 + h * 128 + 16 * wave;
            const f32x4 a = *(const f32x4*)ph, b4 = *(const f32x4*)(ph + 4), c4 = *(const f32x4*)(ph + 8), d4 = *(const f32x4*)(ph + 12);
            rh[tz][0] = __builtin_bit_cast(f16x8, pk8h(a, b4)); rh[tz][1] = __builtin_bit_cast(f16x8, pk8h(c4, d4)); }
        else { rh[tz][0] = f16x8{}; rh[tz][1] = f16x8{}; }
    }
    float beta = 0.f, g = 0.f;
    if (valid) {
        const float braw = BG[(size_t)(T.row0 + lane) * 16 + h], araw = BG[(size_t)(T.row0 + lane) * 16 + 8 + h];
        beta = 1.0f / (1.0f + __expf(-braw));
        const float x = araw + inp(F, I_DTB)[layer * NH + h];
        const float y = __expf(x);
        const float sp = x > 20.f ? x : (y < 0.01f ? y * (1.0f - y * (0.5f - y * 0.333333343f)) : __logf(1.0f + y));
        g = -__expf(inp(F, I_ALOG)[layer * NH + h]) * sp;
    }
#pragma unroll
    for (int o = 1; o < 64; o <<= 1) {
        const float t = __builtin_bit_cast(float, __builtin_amdgcn_ds_bpermute(4 * (lane >= o ? lane - o : lane), __builtin_bit_cast(int, g)));
        if (lane >= o) g += t;
    }
    const float glast = __builtin_bit_cast(float, __builtin_amdgcn_readlane(__builtin_bit_cast(int, g), 63));
    const float eg = __expf(g), egl = __expf(glast - g);
    if (wave == 0) {
        sBeta[lane] = beta; sG[lane] = g;
        if (lane == 0) ((float*)(F.ws + WS_MISC))[4096 + T.unit] = __expf(glast);
    }
    const LAS float* Wl = (const LAS float*)(L + D1_W) + 16 * wave; asm volatile("" : "+v"(Wl));
#pragma unroll
    for (int tz = 0; tz < 3; ++tz) {
        LAS f16* slab = (LAS f16*)(L + D1_KN) + wave * (68 * 16);
        *(LAS f16x8*)(slab + (l + 3) * 16) = rm[tz][0]; *(LAS f16x8*)(slab + (l + 3) * 16 + 8) = rm[tz][1];
        if (l < 3) { *(LAS f16x8*)(slab + l * 16) = rh[tz][0]; *(LAS f16x8*)(slab + l * 16 + 8) = rh[tz][1]; }
        f16x8 raw[4][2];
#pragma unroll
        for (int i = 0; i < 4; ++i) { raw[i][0] = *(const LAS f16x8*)(slab + (l + i) * 16); raw[i][1] = *(const LAS f16x8*)(slab + (l + i) * 16 + 8); }
        float x[16];
#pragma unroll
        for (int e = 0; e < 16; ++e) x[e] = 0.f;
#pragma unroll
        for (int i = 0; i < 4; ++i) {
            const LAS f32x4* wp = (const LAS f32x4*)(Wl + (tz * 4 + i) * 128); const f32x4 w0 = wp[0], w1 = wp[1], w2 = wp[2], w3 = wp[3];
#pragma unroll
            for (int e = 0; e < 4; ++e) { x[e] = __builtin_fmaf((float)raw[i][0][e], w0[e], x[e]); x[4 + e] = __builtin_fmaf((float)raw[i][0][4 + e], w1[e], x[4 + e]);
                x[8 + e] = __builtin_fmaf((float)raw[i][1][e], w2[e], x[8 + e]); x[12 + e] = __builtin_fmaf((float)raw[i][1][4 + e], w3[e], x[12 + e]); }
        }
        float ss = 0.f;
#pragma unroll
        for (int e = 0; e < 16; ++e) { x[e] = siluf_(x[e]) * vmask; ss += x[e] * x[e]; }
        if (tz == 0) {
#pragma unroll
            for (int e = 0; e < 16; ++e) xq[e] = x[e];
            sSS[(0 * 8 + wave) * 64 + l] = ss;
        } else if (tz == 1) {
#pragma unroll
            for (int e = 0; e < 16; ++e) xk[e] = x[e];
            sSS[(1 * 8 + wave) * 64 + l] = ss;
        } else {
#pragma unroll
            for (int e = 0; e < 16; ++e) RT[(16 * wave + e) * 72 + l] = (f16)(x[e] * beta);
        }
    }
    beta_o = beta; eg_o = eg; egl_o = egl;
}
__device__ __forceinline__ void d1_s1b(Frame& F, const D1Task& T, int h, int rtb, float (&xq)[16], float (&xk)[16], float beta, float eg, float egl) {
    D1_LOCALS;
    {
        float sq = 0.f, sk = 0.f;
#pragma unroll
        for (int w = 0; w < 8; ++w) { sq += sSS[(0 * 8 + w) * 64 + l]; sk += sSS[(1 * 8 + w) * 64 + l]; }
        const float rq = rsqrtf(sq + 1e-6f) * 0.08838834764831845f, rk = rsqrtf(sk + 1e-6f);
        float qg[16], kt[16];
#pragma unroll
        for (int e = 0; e < 16; ++e) { xq[e] *= rq; xk[e] *= rk; qg[e] = xq[e] * eg; kt[e] = xk[e] * egl; }
        u32x4 w0, w1;
        w0 = (u32x4){pk2h(xq[0], xq[1]), pk2h(xq[2], xq[3]), pk2h(xq[4], xq[5]), pk2h(xq[6], xq[7])}; w1 = (u32x4){pk2h(xq[8], xq[9]), pk2h(xq[10], xq[11]), pk2h(xq[12], xq[13]), pk2h(xq[14], xq[15])};
        *(LAS u32x4*)(Qn + l * 136 + 16 * wave) = w0; *(LAS u32x4*)(Qn + l * 136 + 16 * wave + 8) = w1;
        w0 = (u32x4){pk2h(xk[0], xk[1]), pk2h(xk[2], xk[3]), pk2h(xk[4], xk[5]), pk2h(xk[6], xk[7])}; w1 = (u32x4){pk2h(xk[8], xk[9]), pk2h(xk[10], xk[11]), pk2h(xk[12], xk[13]), pk2h(xk[14], xk[15])};
        *(LAS u32x4*)(Kn + l * 136 + 16 * wave) = w0; *(LAS u32x4*)(Kn + l * 136 + 16 * wave + 8) = w1;
        f16* qgi = (f16*)(img + IMG_QG) + ((size_t)((l >> 5) * 8 + wave) * 64 + (l & 31)) * 8;
        *(u32x4*)qgi = (u32x4){pk2h(qg[0], qg[1]), pk2h(qg[2], qg[3]), pk2h(qg[8], qg[9]), pk2h(qg[10], qg[11])};
        *(u32x4*)(qgi + 32 * 8) = (u32x4){pk2h(qg[4], qg[5]), pk2h(qg[6], qg[7]), pk2h(qg[12], qg[13]), pk2h(qg[14], qg[15])};
        f16* kti = (f16*)(img + IMG_KT) + l * 128 + 16 * wave;
        *(u32x4*)kti = (u32x4){pk2h(kt[0], kt[1]), pk2h(kt[2], kt[3]), pk2h(kt[4], kt[5]), pk2h(kt[6], kt[7])};
        *(u32x4*)(kti + 8) = (u32x4){pk2h(kt[8], kt[9]), pk2h(kt[10], kt[11]), pk2h(kt[12], kt[13]), pk2h(kt[14], kt[15])};
        const float be = beta * eg;
#pragma unroll
        for (int e = 0; e < 16; ++e) RT[(128 + 16 * wave + e) * 72 + l] = (f16)(xk[e] * be);
    }
}
__device__ __forceinline__ void d1_s2(Frame& F, const D1Task& T) {
    const int rtb = 0; D1_LOCALS;
    if ((wave & 3) < 3) {
        const bool isqk = wave >= 4; const int w3 = wave & 3;
        const int ta = isqk ? (w3 == 2 ? 1 : 0) : (w3 == 0 ? 0 : 1);
        const int tb = isqk ? (w3 == 0 ? 0 : 1) : (w3 == 2 ? 1 : 0);
        const LAS f16* Bm = isqk ? Qn : Kn;
        f32x16 acc = {};
#pragma unroll
        for (int s = 0; s < 8; ++s) {
            const f16x8 a = *(const LAS f16x8*)(Kn + (32 * ta + r32) * 136 + 16 * s + 8 * hi);
            const f16x8 b = *(const LAS f16x8*)(Bm + (32 * tb + r32) * 136 + 16 * s + 8 * hi);
            acc = mfma32(a, b, acc);
        }
        const int cj = 32 * tb + r32;
        const float gj = sG[cj];
        if (!isqk) {
#pragma unroll
            for (int r = 0; r < 16; ++r) { const int i = 32 * ta + crow(r, hi);
                const float v = i > cj ? sBeta[i] * acc[r] * __expf(sG[i] - gj) : 0.f;
                Am[i * 68 + cj] = v;
                if (w3 == 1) Ah[(i - 32) * 40 + cj] = (f16)v; }
        } else {
            f32x16 v;
#pragma unroll
            for (int r = 0; r < 16; ++r) { const int lp = 32 * ta + crow(r, hi);
                v[r] = cj >= lp ? acc[r] * __expf(gj - sG[lp]) : 0.f; }
            f16* qki = (f16*)(img + IMG_QK);
#pragma unroll
            for (int sp = 0; sp < 2; ++sp) *(f16x8*)(qki + ((size_t)(tb * 4 + 2 * ta + sp) * 64 + lane) * 8) = cvt8(v, 8 * sp);
        }
    } else if (wave == 7) {
        f16* qki = (f16*)(img + IMG_QK);
#pragma unroll
        for (int ks = 2; ks < 4; ++ks) *(u32x4*)(qki + ((size_t)(0 * 4 + ks) * 64 + lane) * 8) = (u32x4){0u, 0u, 0u, 0u};
    }
}
__device__ __forceinline__ void d1_s3(Frame& F) {
    const int rtb = 0; D1Task T; T.unit = 0; D1_LOCALS;
    if (wave == 0) {
        const int hb = lane >> 5, c = lane & 31;
        const LAS float* Ab = Am + (32 * hb) * 68 + 32 * hb; asm volatile("" : "+v"(Ab));
        float t[32];
#pragma unroll
        for (int i = 0; i < 32; ++i) t[i] = 0.f;
        f32x4 cur[8];
#pragma unroll
        for (int i = 0; i < 32; ++i) {
            f32x4 nxt[8];
            if (i + 1 < 32) {
                const LAS float* Ar = Ab;
                if (i > 0) asm volatile("" : "+v"(Ar) : "v"(t[i - 1]));
#pragma unroll
                for (int g = 0; g < (i + 4) / 4; ++g) nxt[g] = *(const LAS f32x4*)(Ar + (i + 1) * 68 + 4 * g);
            }
            float a0 = (i == c) ? 1.f : 0.f, a1 = 0.f, a2 = 0.f, a3 = 0.f;
#pragma unroll
            for (int g = 0; g < (i + 3) / 4; ++g) { a0 -= cur[g][0] * t[4 * g]; a1 -= cur[g][1] * t[4 * g + 1]; a2 -= cur[g][2] * t[4 * g + 2]; a3 -= cur[g][3] * t[4 * g + 3]; }
            t[i] = (a0 + a1) + (a2 + a3);
#pragma unroll
            for (int g = 0; g < 8; ++g) cur[g] = nxt[g];
        }
#pragma unroll
        for (int i = 0; i < 32; ++i) Tm[(32 * hb + i) * 72 + 32 * hb + c] = (f16)t[i];
        f32x16 P = {};
#pragma unroll
        for (int s = 0; s < 2; ++s) {
            float bv[8];
#pragma unroll
            for (int e = 0; e < 8; ++e) { const float x = __shfl(t[16 * s + 8 + e], c); bv[e] = hb ? x : t[16 * s + e]; }
            const u32x4 bw = {pk2h(bv[0], bv[1]), pk2h(bv[2], bv[3]), pk2h(bv[4], bv[5]), pk2h(bv[6], bv[7])};
            const f16x8 af = *(const LAS f16x8*)(Ah + c * 40 + 16 * s + 8 * hb);
            P = mfma32(af, __builtin_bit_cast(f16x8, bw), P);
        }
        f32x16 Q = {};
#pragma unroll
        for (int s = 0; s < 2; ++s) {
            const LAS f16* tp = Tm + (32 + c) * 72 + 32 + 16 * s + 4 * hb;
            const f16x4 lo = *(const LAS f16x4*)tp, h4 = *(const LAS f16x4*)(tp + 8);
            Q = mfma32((f16x8){lo[0], lo[1], lo[2], lo[3], h4[0], h4[1], h4[2], h4[3]}, cvt8(P, 8 * s), Q);
        }
#pragma unroll
        for (int r = 0; r < 16; ++r) Tm[(32 + crow(r, hb)) * 72 + c] = (f16)(-Q[r]);
    }
}
__device__ __forceinline__ void d1_s4(Frame& F, const D1Task& T, int rtb) {
    D1_LOCALS;
    {
        const int rt = wave & 1, tq = wave >> 1;
        f32x16 au = {}, aw = {};
        const int ns = rt == 0 ? 2 : 4;
#pragma unroll
        for (int s = 0; s < 4; ++s) if (s < ns) {
            const f16x8 tf = *(const LAS f16x8*)(Tm + (32 * rt + r32) * 72 + 16 * s + 8 * hi);
            const f16x8 bv = *(const LAS f16x8*)(RT + (32 * tq + r32) * 72 + 16 * s + 8 * hi);
            const f16x8 ak = *(const LAS f16x8*)(RT + (128 + 32 * tq + r32) * 72 + 16 * s + 8 * hi);
            au = mfma32(tf, bv, au);
            aw = mfma32(ak, tf, aw);
        }
        f16* uvi = (f16*)(img + IMG_UV) + ((size_t)(tq * 2 + rt) * 64 + lane) * 16;
        *(f16x8*)uvi = cvt8(au, 0); *(f16x8*)(uvi + 8) = cvt8(au, 8);
        f16* wki = (f16*)(img + IMG_WK);
#pragma unroll
        for (int sp = 0; sp < 2; ++sp) *(f16x8*)(wki + ((size_t)(rt * 8 + 2 * tq + sp) * 64 + lane) * 8) = cvt8(aw, 8 * sp);
    }
}

constexpr int SC_BUF = 57344, SC_OB = 2 * SC_BUF, SC_OBB = 16384;
__device__ __forceinline__ int vswz(int row, int ch) { return row * 256 + ((ch ^ (((row & 3) << 2) | ((row >> 2) & 3))) << 4); }
__device__ __forceinline__ f16x4 tr_read(const LAS unsigned char* p) { return __builtin_bit_cast(f16x4, __builtin_amdgcn_ds_read_tr16_b64_v4i16((LAS v4i16_t*)p)); }
struct TrAddr { int a[2][4]; };
__device__ __forceinline__ TrAddr tr_addr(int lane) {
    const int g = lane >> 4, i = lane & 15, q = i >> 2, p = i & 3, hi = g >> 1; TrAddr t;
#pragma unroll
    for (int sec = 0; sec < 2; ++sec)
#pragma unroll
        for (int cb = 0; cb < 4; ++cb)
            t.a[sec][cb] = (4 * hi + q + 8 * sec) * 256 + (((((cb ^ q) << 2) | ((((g & 1) << 1) | (p >> 1)) ^ ((hi + 2 * sec) & 3)))) << 4) + 8 * (p & 1);
    return t;
}
__device__ __forceinline__ f16x8 tr_frag(const LAS unsigned char* base, const TrAddr& t, int k0, int cb) {
    const f16x4 lo = tr_read(base + t.a[0][cb] + k0 * 256);
    const f16x4 hh = tr_read(base + t.a[1][cb] + k0 * 256);
    return (f16x8){lo[0], lo[1], lo[2], lo[3], hh[0], hh[1], hh[2], hh[3]};
}

__device__ __forceinline__ void scan_task(Frame& F, bool samp, int b, int h, int layer, unsigned* qh) {
    LAS unsigned char* L = F.lds;
    int lane = hw_lane(), wave = F.wave; asm volatile("" : "+s"(wave));
    const int tid = wave * 64 + lane, r32 = lane & 31, hi = lane >> 5;
    const bool cwv = wave < 4; const int w = wave & 3;
    const TrAddr TA = tr_addr(lane);
    const int nch = samp ? 1 : 32, unit0 = samp ? NB * NH * 32 + b * NH + h : (b * NH + h) * 32;
    const int row00 = samp ? MP + b * SSEQ : b * SEQ, nvalid = samp ? SSEQ : 64;
    const unsigned char* img0 = F.ws + WS_DIMG + (size_t)unit0 * DIMG_BYTES;
    const float* glast = (const float*)(F.ws + WS_MISC) + 4096 + unit0;
    f32x16 S[4];
#pragma unroll
    for (int t = 0; t < 4; ++t) S[t] = f32x16{};
    if (samp && cwv) {
        const float* sd = inp(F, I_SDELTA) + ((size_t)(layer * NSB + b) * NH + h) * DK * DK;
#pragma unroll
        for (int t = 0; t < 4; ++t)
#pragma unroll
            for (int r = 0; r < 16; ++r) S[t][r] = sd[(32 * t + crow(r, hi)) * DK + 32 * w + r32];
    }
    const int st0 = tid - 256;
    int st = st0;
#define SC_STAGE_LOAD(nn, RG) do { const unsigned char* im_ = img0 + (size_t)(nn) * DIMG_BYTES; \
        _Pragma("unroll") for (int i_ = 0; i_ < 14; ++i_) RG[i_] = *(const u32x4*)(im_ + (size_t)(st + 256 * i_) * 16); } while (0)
#define SC_STAGE_STORE(bufo, RG) do { _Pragma("unroll") for (int i_ = 0; i_ < 14; ++i_) { const int c_ = st + 256 * i_; \
            const int o_ = c_ < (IMG_KT / 16) ? c_ * 16 : IMG_KT + vswz((c_ - IMG_KT / 16) >> 4, (c_ - IMG_KT / 16) & 15); \
            *(LAS u32x4*)(L + (bufo) + o_) = RG[i_]; } } while (0)
#define SC_ZLOAD(nn, Z_) do { const int l_ = st >> 2, part_ = st & 3; \
        const size_t row_ = (size_t)row00 + 64 * (nn) + (l_ < nvalid ? l_ : 0); \
        const f16* zp_ = (const f16*)(F.ws + WS_Z) + row_ * D + h * 128 + 32 * part_;      \
        _Pragma("unroll") for (int q_ = 0; q_ < 4; ++q_) Z_[q_] = *(const f16x8*)(zp_ + 8 * q_); } while (0)
#define SC_EPI(nn, z_, live_) do { const int l_ = st >> 2, part_ = st & 3; \
        const LAS f16* ob_ = (const LAS f16*)(L + SC_OB + ((nn) & 1) * SC_OBB) + l_ * 128 + 32 * part_; \
        const size_t row_ = (size_t)row00 + 64 * (nn) + (l_ < nvalid ? l_ : 0); const int c_ = h * 128 + 32 * part_; \
        float ss_ = 0.f; \
        _Pragma("unroll") for (int q_ = 0; q_ < 4; ++q_) { const f16x8 a1_ = *(const LAS f16x8*)(ob_ + 8 * q_); _Pragma("unroll") for (int e_ = 0; e_ < 8; ++e_) { const float v_ = (float)a1_[e_]; ss_ += v_ * v_; } } \
        const LAS f16* ob2_ = ob_; asm volatile("" : "+v"(ob2_));        \
        ss_ += __shfl_xor(ss_, 1); ss_ += __shfl_xor(ss_, 2); \
        const float rstd_ = rsqrtf(ss_ * (1.0f / 128.0f) + LN_EPS); \
        const LAS f32x4* na_ = (const LAS f32x4*)(L + LDSCTL_OFF + 1024 + 4 * 132) + 8 * part_;     \
        f16* op_ = (live_) ? (f16*)(F.ws + WS_MAB) + row_ * 2048 + c_ : (f16*)(F.ws + WS_PART) + st * 32;     \
        _Pragma("unroll") for (int q_ = 0; q_ < 4; ++q_) { float r_[8]; const f32x4 n0_ = na_[2 * q_], n1_ = na_[2 * q_ + 1]; const f16x8 a2_ = *(const LAS f16x8*)(ob2_ + 8 * q_); \
            _Pragma("unroll") for (int e_ = 0; e_ < 8; ++e_) r_[e_] = (float)a2_[e_] * rstd_ * (e_ < 4 ? n0_[e_ & 3] : n1_[e_ & 3]) * (float)z_[q_][e_]; \
            if (!samp || l_ < nvalid) *(u32x4*)(op_ + 8 * q_) = (u32x4){pk2h(r_[0], r_[1]), pk2h(r_[2], r_[3]), pk2h(r_[4], r_[5]), pk2h(r_[6], r_[7])}; } } while (0)
    f16x8 uvn[2][2] = {}; float gln = 0.f;
    u32x4 rga[14], rgb[14];
    if (!cwv) { SC_STAGE_LOAD(0, rga); SC_STAGE_STORE(0, rga); SC_STAGE_LOAD(nch > 1 ? 1 : 0, rgb); }
    else {
        const f16* uvp = (const f16*)(img0 + IMG_UV);
#pragma unroll
        for (int rt = 0; rt < 2; ++rt) { const f16* p = uvp + ((size_t)(w * 2 + rt) * 64 + lane) * 16; uvn[rt][0] = *(const f16x8*)p; uvn[rt][1] = *(const f16x8*)(p + 8); }
        gln = glast[0];
    }
    __syncthreads();
    if (cwv) {
        for (int n = 0; n < nch; ++n) {
            const int bo = (n & 1) * SC_BUF;
            const LAS unsigned char* B = L + bo;
            f16x8 uv[2][2];
#pragma unroll
            for (int rt = 0; rt < 2; ++rt) { uv[rt][0] = uvn[rt][0]; uv[rt][1] = uvn[rt][1]; }
            const float gl = gln;
            f32x16 up[2] = {f32x16{}, f32x16{}}, o[2] = {f32x16{}, f32x16{}};
#define SB() __builtin_amdgcn_sched_barrier(0)
#define SC_REQ1(ks, W) do { _Pragma("unroll") for (int rt = 0; rt < 2; ++rt) { wkf[W][rt] = *(const LAS f16x8*)(B + IMG_WK + ((rt * 8 + (ks)) * 64 + lane) * 16); qgf[W][rt] = *(const LAS f16x8*)(B + IMG_QG + ((rt * 8 + (ks)) * 64 + lane) * 16); } } while (0)
#define SC_MMA1(ks, W) do { const f16x8 bf = cvt8(S[(ks) >> 1], 8 * ((ks) & 1)); _Pragma("unroll") for (int rt = 0; rt < 2; ++rt) { up[rt] = mfma32(wkf[W][rt], bf, up[rt]); o[rt] = mfma32(qgf[W][rt], bf, o[rt]); } } while (0)
            {
                f16x8 wkf[1][2], qgf[1][2];
#pragma unroll
                for (int ks = 0; ks < 8; ++ks) { SC_REQ1(ks, 0); SB(); SC_MMA1(ks, 0); SB(); }
            }
#pragma unroll
            for (int rt = 0; rt < 2; ++rt)
#pragma unroll
                for (int r = 0; r < 16; ++r) up[rt][r] = (float)uv[rt][r >> 3][r & 7] - up[rt][r];
#pragma unroll
            for (int t = 0; t < 4; ++t) S[t] = S[t] * gl;
            if (n + 1 < nch) {
                const f16* uvp = (const f16*)(img0 + (size_t)(n + 1) * DIMG_BYTES + IMG_UV);
#pragma unroll
                for (int rt = 0; rt < 2; ++rt) { const f16* p = uvp + ((size_t)(w * 2 + rt) * 64 + lane) * 16; uvn[rt][0] = *(const f16x8*)p; uvn[rt][1] = *(const f16x8*)(p + 8); }
                gln = glast[n + 1];
            }
#define SC_REQ2(ks, W) do { qk1[W] = *(const LAS f16x8*)(B + IMG_QK + ((1 * 4 + (ks)) * 64 + lane) * 16); if ((ks) < 2) qk0[W] = *(const LAS f16x8*)(B + IMG_QK + ((0 * 4 + (ks)) * 64 + lane) * 16); \
        _Pragma("unroll") for (int t = 0; t < 4; ++t) { ktl[W][t] = tr_read(B + IMG_KT + TA.a[0][t] + (16 * (ks)) * 256); kth[W][t] = tr_read(B + IMG_KT + TA.a[1][t] + (16 * (ks)) * 256); } } while (0)
#define SC_MMA2(ks, W) do { const f16x8 bf = cvt8(up[(ks) >> 1], 8 * ((ks) & 1)); o[1] = mfma32(qk1[W], bf, o[1]); if ((ks) < 2) o[0] = mfma32(qk0[W], bf, o[0]); \
        _Pragma("unroll") for (int t = 0; t < 4; ++t) S[t] = mfma32((f16x8){ktl[W][t][0], ktl[W][t][1], ktl[W][t][2], ktl[W][t][3], kth[W][t][0], kth[W][t][1], kth[W][t][2], kth[W][t][3]}, bf, S[t]); } while (0)
            {
                f16x8 qk1[1], qk0[1]; f16x4 ktl[1][4], kth[1][4];
#pragma unroll
                for (int ks = 0; ks < 4; ++ks) { SC_REQ2(ks, 0); SB(); SC_MMA2(ks, 0); SB(); }
            }
#undef SC_REQ1
#undef SC_MMA1
#undef SC_REQ2
#undef SC_MMA2
#undef SB
            LAS f16* ob = (LAS f16*)(L + SC_OB + (n & 1) * SC_OBB);
#pragma unroll
            for (int rt = 0; rt < 2; ++rt)
#pragma unroll
                for (int r = 0; r < 16; ++r) ob[(32 * rt + crow(r, hi)) * 128 + 32 * w + r32] = (f16)o[rt][r];
            LDS_BARRIER();
        }
        {
        float* od = F.out + (samp ? OUT_DS + ((size_t)(layer * NSB + b) * NH + h) * DK * DK : OUT_DP + ((size_t)(layer * NB + b) * NH + h) * DK * DK);
#pragma unroll
        for (int t = 0; t < 4; ++t)
#pragma unroll
            for (int r = 0; r < 16; ++r) od[(32 * t + crow(r, hi)) * DK + 32 * w + r32] = S[t][r];
        }
    } else {
        const int nl = nch - 1;
        f16x8 zg[4] = {};
        for (int n = 0; n < nch; n += 2) {
            st = st0; asm volatile("" : "+v"(st));
            SC_STAGE_LOAD(n + 2 < nl ? n + 2 : nl, rga);
            SC_EPI(n > 0 ? n - 1 : 0, zg, n > 0);
            SC_ZLOAD(n, zg);
            if (n + 1 < nch) SC_STAGE_STORE(SC_BUF, rgb);
            LDS_BARRIER();
            if (n + 1 >= nch) break;
            st = st0; asm volatile("" : "+v"(st));
            SC_STAGE_LOAD(n + 3 < nl ? n + 3 : nl, rgb);
            SC_EPI(n, zg, true);
            SC_ZLOAD(n + 1, zg);
            if (n + 2 < nch) SC_STAGE_STORE(0, rga);
            LDS_BARRIER();
        }
        st = st0; asm volatile("" : "+v"(st));
        SC_EPI(nch - 1, zg, true);
    }
#undef SC_STAGE_LOAD
#undef SC_STAGE_STORE
#undef SC_EPI
#undef SC_ZLOAD
    if (wave == 0 && lane == 0) F.MISC[0] = __hip_atomic_fetch_add(qh, 1u, __ATOMIC_RELAXED, __HIP_MEMORY_SCOPE_AGENT);
    __syncthreads();
}

constexpr int AT_K0 = 0, AT_V0 = 32768, AT_XCH = 65536, AT_BT = 147456;
struct AttnTask { const f16* Q; const f16* K; const f16* V; const f16* G; f16* O; float* OK; float* OV; int q0, nqw, nkeys, ntiles, h, wr0; };

__device__ __forceinline__ float max3f_(float a, float b, float c) { return __builtin_fmaxf(__builtin_fmaxf(a, b), c); }
constexpr float AT_THR = 4.0f;
__device__ __forceinline__ void attn_task(Frame& F, const AttnTask& T, int layer, unsigned* qh) {
    LAS unsigned char* L = F.lds;
    int lane = hw_lane(), wave = F.wave; asm volatile("" : "+s"(wave));
    const int tid = wave * 64 + lane, r32 = lane & 31, hi = lane >> 5;
    const int map = wave >> 2, wq = wave & 3;
    const TrAddr TA = tr_addr(lane);
    const bool active = wq < T.nqw;
    const int qbase = T.q0 + 32 * wq, qpos = qbase + r32, cwv = qbase >> 6;
    const float* misc = (const float*)(F.ws + WS_MISC);
    const LAS float* BT = (const LAS float*)(L + AT_BT) + T.h * 256;
    float cfar = BT[0];
    const LAS float* PT = (const LAS float*)(L + LDSCTL_OFF + 3072) + 96;
    f16x8 qf[4];
#pragma unroll
    for (int s = 0; s < 4; ++s) qf[s] = active ? *(const f16x8*)(T.Q + (size_t)qpos * D + map * 64 + 16 * s + 8 * hi) : f16x8{};
    int kadr[4];
#pragma unroll
    for (int s = 0; s < 4; ++s) kadr[s] = r32 * 256 + (((map * 8 + 2 * s + hi) ^ (r32 & 15)) << 4);
    const int srow0 = tid >> 4, srow1 = srow0 + 32, sch = tid & 15;
    const int kdo0 = srow0 * 256 + ((sch ^ (srow0 & 15)) << 4), kdo1 = srow1 * 256 + ((sch ^ (srow1 & 15)) << 4);
    const int vdo0 = vswz(srow0, sch), vdo1 = vswz(srow1, sch);
    u32x4 ka0, ka1, va0, va1, kb0, kb1, vb0, vb1;
#define AT_LOAD(j, S) do { const size_t o0_ = ((size_t)(64 * (j) + srow0)) * D + sch * 8, o1_ = o0_ + (size_t)32 * D; \
        k##S##0 = *(const u32x4*)(T.K + o0_); k##S##1 = *(const u32x4*)(T.K + o1_); v##S##0 = *(const u32x4*)(T.V + o0_); v##S##1 = *(const u32x4*)(T.V + o1_); } while (0)
#define AT_OUT8(P_, W_) do { const f16x8 h_ = __builtin_bit_cast(f16x8, W_); \
        __builtin_nontemporal_store((f32x4){(float)h_[0], (float)h_[1], (float)h_[2], (float)h_[3]}, (f32x4*)(P_)); __builtin_nontemporal_store((f32x4){(float)h_[4], (float)h_[5], (float)h_[6], (float)h_[7]}, (f32x4*)((P_) + 4)); } while (0)
#define AT_STORE(bo, S, jt) do { *(LAS u32x4*)(L + AT_K0 + (bo) + kdo0) = k##S##0; *(LAS u32x4*)(L + AT_K0 + (bo) + kdo1) = k##S##1; \
        *(LAS u32x4*)(L + AT_V0 + (bo) + vdo0) = v##S##0; *(LAS u32x4*)(L + AT_V0 + (bo) + vdo1) = v##S##1; \
        if ((jt) >= T.wr0) {                                       \
            const size_t q0_ = ((size_t)(64 * (jt) + srow0)) * D + sch * 8, q1_ = q0_ + (size_t)32 * D; \
            AT_OUT8(T.OK + q0_, k##S##0); AT_OUT8(T.OK + q1_, k##S##1); AT_OUT8(T.OV + q0_, v##S##0); AT_OUT8(T.OV + q1_, v##S##1); } } while (0)
    AT_LOAD(0, a); AT_STORE(0, a, 0);
    asm volatile("s_waitcnt vmcnt(0)" ::: "memory");
    asm volatile("" : "+v"(qf[0]), "+v"(qf[1]), "+v"(qf[2]), "+v"(qf[3]), "+v"(cfar));
    const int jlast = T.ntiles - 1;
    AT_LOAD(jlast < 1 ? jlast : 1, b);
    LDS_BARRIER();
    float m = 0.f, lsum = 0.f;
    bool firstt = true;
    f32x16 o[4];
#pragma unroll
    for (int d = 0; d < 4; ++d) o[d] = f32x16{};
#define SB() __builtin_amdgcn_sched_barrier(0)
#define AT_VREQ(g, W) do { _Pragma("unroll") for (int d = 0; d < 4; ++d) { vl[W][d] = tr_read(vb + TA.a[0][d] + (16 * (g)) * 256); vh[W][d] = tr_read(vb + TA.a[1][d] + (16 * (g)) * 256); } } while (0)
#define AT_PV(g, W) do { const f16x8 pf = cvt8((g) < 2 ? p0 : p1, 8 * ((g) & 1)); \
        _Pragma("unroll") for (int d = 0; d < 4; ++d) o[d] = mfma32((f16x8){vl[W][d][0], vl[W][d][1], vl[W][d][2], vl[W][d][3], vh[W][d][0], vh[W][d][1], vh[W][d][2], vh[W][d][3]}, pf, o[d]); } while (0)
#define AT_TILE(j, bo) do { if (active && (j) <= cwv) { \
            const LAS unsigned char* kb = L + AT_K0 + (bo); \
            const LAS unsigned char* vb = L + AT_V0 + (bo); \
            f16x8 ka[4], kc[4]; f16x4 vl[2][4], vh[2][4]; \
            _Pragma("unroll") for (int s = 0; s < 2; ++s) { ka[s] = *(const LAS f16x8*)(kb + kadr[s]); kc[s] = *(const LAS f16x8*)(kb + kadr[s] + 8192); } \
            SB(); \
            _Pragma("unroll") for (int s = 2; s < 4; ++s) { ka[s] = *(const LAS f16x8*)(kb + kadr[s]); kc[s] = *(const LAS f16x8*)(kb + kadr[s] + 8192); } \
            f32x16 p0 = f32x16{}, p1 = f32x16{}; \
            _Pragma("unroll") for (int s = 0; s < 2; ++s) { p0 = mfma32(ka[s], qf[s], p0); p1 = mfma32(kc[s], qf[s], p1); } \
            SB(); \
            AT_VREQ(0, 0); \
            _Pragma("unroll") for (int s = 2; s < 4; ++s) { p0 = mfma32(ka[s], qf[s], p0); p1 = mfma32(kc[s], qf[s], p1); } \
            SB(); \
            const bool near_ = 64 * (j) + 191 > qbase; \
            float cm = (near_ ? 0.f : cfar) - m;                   \
            if (near_) {                                           \
                int ib = 64 * (j) - qpos + 128 + 4 * hi; asm volatile("" : "+v"(ib));        \
                const bool tail = 64 * (j) + 64 > T.nkeys; const int klim = T.nkeys - 64 * (j) - 4 * hi;        \
                _Pragma("unroll") for (int hb = 0; hb < 4; ++hb) { float b0[4], b1[4]; \
                    _Pragma("unroll") for (int r8 = 0; r8 < 4; ++r8) { const int r = 4 * hb + r8; const int i0 = ib + (r & 3) + 8 * (r >> 2), i1 = i0 + 32; b0[r8] = PT[i0]; b1[r8] = PT[i1]; } \
                    SB(); \
                    _Pragma("unroll") for (int r8 = 0; r8 < 4; ++r8) { const int r = 4 * hb + r8; const int i0 = ib + (r & 3) + 8 * (r >> 2), i1 = i0 + 32; \
                        p0[r] += b0[r8]; p1[r] += b1[r8]; \
                        if (tail) { if ((r & 3) + 8 * (r >> 2) >= klim) p0[r] = -INFINITY; if ((r & 3) + 8 * (r >> 2) + 32 >= klim) p1[r] = -INFINITY; } } \
                    SB(); } } \
            float mx = max3f_(p0[0], p0[1], p1[0]); mx = max3f_(mx, p1[1], p0[2]); \
            _Pragma("unroll") for (int r = 2; r < 16; r += 2) { mx = max3f_(mx, p0[r], p0[r + 1]); mx = max3f_(mx, p1[r], p1[r + 1]); } \
            mx = __builtin_fmaxf(mx, __shfl_xor(mx, 32)) + cm; \
            if (firstt || __any(mx > AT_THR)) {                    \
                const float dl = firstt ? mx : __builtin_fmaxf(mx, 0.f); \
                const float alpha = firstt ? 1.0f : __builtin_amdgcn_exp2f(-dl); \
                m += dl; lsum *= alpha; cm -= dl; \
                _Pragma("unroll") for (int d = 0; d < 4; ++d) o[d] = o[d] * alpha; \
                firstt = false; } \
            f32x2 ps2 = {0.f, 0.f}; const f32x2 cm2 = {cm, cm}; \
            _Pragma("unroll") for (int r = 0; r < 16; r += 2) { \
                const f32x2 x0 = (f32x2){p0[r], p0[r + 1]} + cm2, x1 = (f32x2){p1[r], p1[r + 1]} + cm2; \
                p0[r] = __builtin_amdgcn_exp2f(x0[0]); p0[r + 1] = __builtin_amdgcn_exp2f(x0[1]); p1[r] = __builtin_amdgcn_exp2f(x1[0]); p1[r + 1] = __builtin_amdgcn_exp2f(x1[1]); \
                ps2 += (f32x2){p0[r], p0[r + 1]}; ps2 += (f32x2){p1[r], p1[r + 1]}; } \
            lsum += ps2[0] + ps2[1]; \
            SB(); AT_VREQ(1, 1); SB(); AT_PV(0, 0); SB(); AT_VREQ(2, 0); SB(); AT_PV(1, 1); SB(); AT_VREQ(3, 1); SB(); AT_PV(2, 0); SB(); AT_PV(3, 1); SB(); \
        } } while (0)
    for (int j = 0; j < T.ntiles; j += 2) {
        AT_LOAD(j + 2 < jlast ? j + 2 : jlast, a);
        AT_TILE(j, 0);
        if (j + 1 < T.ntiles) AT_STORE(16384, b, j + 1);
        LDS_BARRIER();
        if (j + 1 >= T.ntiles) break;
        AT_LOAD(j + 3 < jlast ? j + 3 : jlast, b);
        AT_TILE(j + 1, 16384);
        if (j + 2 < T.ntiles) AT_STORE(0, a, j + 2);
        LDS_BARRIER();
    }
#undef AT_LOAD
#undef AT_STORE
#undef AT_OUT8
#undef AT_TILE
#undef AT_VREQ
#undef AT_PV
#undef SB
    unsigned tk = 0;
    const bool qlead = wave == 0 && lane == 0;
    if (qlead) tk = __hip_atomic_fetch_add(qh, 1u, __ATOMIC_RELAXED, __HIP_MEMORY_SCOPE_AGENT);
    lsum += __shfl_xor(lsum, 32);
    const LAS float* PC = (const LAS float*)(L + LDSCTL_OFF + 1024);
    const float lam = PC[0];
    const float scl = (map == 0 ? 1.0f : lam) / lsum;
    LAS float* XC = (LAS float*)(L + AT_XCH) + wq * 4096;
    f16x4 gg[4][4];
    if (active && map == 0) {
        const f16* gp = T.G + (size_t)qpos * D;
#pragma unroll
        for (int d = 0; d < 4; ++d)
#pragma unroll
            for (int g4 = 0; g4 < 4; ++g4) gg[d][g4] = *(const f16x4*)(gp + 32 * d + 8 * g4 + 4 * hi);
    }
    if (active && map == 1) {
#pragma unroll
        for (int d = 0; d < 4; ++d)
#pragma unroll
            for (int r = 0; r < 16; ++r) XC[(d * 16 + r) * 64 + lane] = o[d][r] * scl;
    }
    LDS_BARRIER();
    if (active && map == 0) {
        float ss = 0.f;
#pragma unroll
        for (int d = 0; d < 4; ++d)
#pragma unroll
            for (int r = 0; r < 16; ++r) { const float v = o[d][r] * scl - XC[(d * 16 + r) * 64 + lane]; o[d][r] = v; ss += v * v; }
        ss += __shfl_xor(ss, 32);
        const float rs = rsqrtf(ss * (1.0f / 128.0f) + LN_EPS) * PC[1];
        f16* op = T.O + (size_t)qpos * 2048;
#pragma unroll
        for (int d = 0; d < 4; ++d)
#pragma unroll
            for (int g4 = 0; g4 < 4; ++g4) {
                const int dv = 32 * d + 8 * g4 + 4 * hi;
                const f32x4 s4 = *(const LAS f32x4*)(PC + 4 + dv);
                u32x2 wv; wv.x = pk2h(o[d][4 * g4] * rs * s4[0] * (float)gg[d][g4][0], o[d][4 * g4 + 1] * rs * s4[1] * (float)gg[d][g4][1]);
                wv.y = pk2h(o[d][4 * g4 + 2] * rs * s4[2] * (float)gg[d][g4][2], o[d][4 * g4 + 3] * rs * s4[3] * (float)gg[d][g4][3]);
                *(u32x2*)(op + dv) = wv;
            }
    }
    if (qlead) F.MISC[0] = tk;
    LDS_BARRIER();
}

#ifndef MK_PER_PHASE
#define MK_PER_PHASE 0
#endif
constexpr int N_PHASES = 2 + 8 * DEPTH;
constexpr int QN_SCANP = 2 * NH, QN_ATTS = NH, QN_ATTP = 2 * NH * 16, QN_SCANS = NH, QN_TOTAL = QN_SCANP + QN_ATTS + QN_ATTP + QN_SCANS;
static_assert(NB == 16 && NSB == 8, "queue partition");
struct Args { const float* in[27]; float* out; unsigned char* ws; int ph_lo, ph_hi; };

__global__ void __launch_bounds__(NWAVES * 64, 2) mk_fwd(Args args) {
    extern __shared__ __attribute__((aligned(16))) unsigned char lds[];
    Frame F;
    F.lds = (LAS unsigned char*)lds;
    F.MISC = (volatile LAS unsigned*)(F.lds + LDSCTL_OFF);
    F.tid = threadIdx.x; F.lane = F.tid & 63; F.wave = __builtin_amdgcn_readfirstlane(F.tid >> 6);
    F.G = gridDim.x; F.bx = blockIdx.x; { const int bx = blockIdx.x; F.vcu = (F.G % 8 == 0) ? (bx % 8) * (F.G / 8) + bx / 8 : bx; }
    F.out = args.out; F.ws = args.ws; F.ctl = (unsigned*)(args.ws + WS_CTL);
    for (int u = F.tid; u < 64; u += NWAVES * 64) ((LAS unsigned*)(F.lds + LDSCTL_OFF))[u] = 0u;
    if (F.tid < 27) ((LAS unsigned long long*)(F.lds + LDS_INP_OFF))[F.tid] = (unsigned long long)args.in[F.tid];
    __syncthreads();
    XcdBarrier bar; bar.bar = F.ctl + CW_BAR; bar.x = 0; bar.st = nullptr;
    if (!MK_PER_PHASE) bar = xcd_barrier_post(F.ctl + CW_BAR, F.MISC + 8);
    const int lo = args.ph_lo, hi = args.ph_hi;
#define IN(k) (lo <= (k) && (k) < hi)
#ifndef PROBE_PHASE
#define PROBE_PHASE -1
#endif
#define PROBE_T0() const unsigned long long pt0_ = (PROBE_PHASE >= 0) ? __builtin_amdgcn_s_memrealtime() : 0ull
#define PROBE_T1(k) do { if (PROBE_PHASE == (k)) { const unsigned long long pt1_ = __builtin_amdgcn_s_memrealtime(); while (__builtin_amdgcn_s_memrealtime() - pt1_ < pt1_ - pt0_) __builtin_amdgcn_s_sleep(8); } } while (0)
#define SEAM(k) do { if (!MK_PER_PHASE && IN(k) && IN((k) + 1)) { XcdBarrier b2_ = bar; asm volatile("" : "+s"(b2_.bar)); b2_.bar = as_global(b2_.bar); xcd_barrier(b2_); if (PROBE_PHASE == 30) xcd_barrier(b2_); } } while (0)

    if (IN(0)) { PROBE_T0();
#ifndef DIS_P0A
 { PHASE_FRAME(P); p0a_prologue(P); }
#endif
 PROBE_T1(8); }
    SEAM(0);
    if (IN(1)) { PROBE_T0(); PHASE_FRAME(P); ln_phase(P, true, false, inp(P, I_LNG), inp(P, I_LNB), (const float*)(P.ws + WS_MOD), 0, 1024); PROBE_T1(9); }
    SEAM(1);

    for (int l = 0; l < DEPTH; ++l) {
        const int p = 2 + 8 * l;
        if (IN(p)) { asm volatile("; PHASE_MARK P1"); PROBE_T0(); PHASE_FRAME(P);
            pg8::Gemm g{(const pg8::bf16_t*)(P.ws + WS_H), (const pg8::bf16_t*)(P.ws + WS_WIN) + (size_t)l * NPROJ * D, M, NPROJ, D};
            pg8::StaticOrder S; S.init(M, NPROJ, P.G, P.bx); S.rot = 33;
            EpiProj E{(f16*)(P.ws + WS_QKVA), (f16*)(P.ws + WS_Z), (f16*)(P.ws + WS_QB), (f16*)(P.ws + WS_KB), (f16*)(P.ws + WS_VB), (f16*)(P.ws + WS_GAB), (float*)(P.ws + WS_BG),
                      (f16*)(P.ws + WS_KS) + (size_t)l * NSB * KSROWS * D, (f16*)(P.ws + WS_VS) + (size_t)l * NSB * KSROWS * D, P.out, l};

#ifndef DIS_G1
 pg8::gemm_phase<EpiProj, pg8::StaticOrder, true, true>(P.lds, g, S, E, P.tid);
#endif

        PROBE_T1(0); }
        SEAM(p);
        if (IN(p + 1)) { asm volatile("; PHASE_MARK P2"); PROBE_T0(); PHASE_FRAME(P);
            float xq[16], xk[16]; float beta = 0.f, eg = 0.f, egl = 0.f;
#pragma unroll
            for (int e = 0; e < 16; ++e) { xq[e] = 0.f; xk[e] = 0.f; }
            D1Task Tc, Tn; int hn = 0, rtb = 0; bool cur = false;
            Tc.row0 = 0; Tc.nvalid = 0; Tc.n = 0; Tc.unit = 0; Tc.hist = nullptr; Tn = Tc;
            if (P.vcu < N_DUNITS) { float w3[3]; d1_wload(P, P.vcu < NB * NH * 32 ? (P.vcu >> 5) & 7 : (P.vcu - NB * NH * 32) & 7, l, w3); d1_wstore(P, w3); }
            LDS_BARRIER();
            for (int uu = P.vcu; ; uu += P.G) {
                int u = uu; asm volatile("" : "+s"(u));
                const bool nxt = u < N_DUNITS;
                if (!cur && !nxt) break;
                const int kstep = (uu - P.vcu) / P.G;
                const bool cvt = kstep < 16 && P.G == 256;
                if (nxt) {
                    if (u < NB * NH * 32) { const int n = u & 31, bh = u >> 5; hn = bh & 7; const int b = bh >> 3; Tn.row0 = b * SEQ + 64 * n; Tn.nvalid = 64; Tn.n = n; Tn.unit = u; Tn.hist = nullptr; }
                    else { const int v = u - NB * NH * 32, sb = v >> 3; hn = v & 7; Tn.row0 = MP + sb * SSEQ; Tn.nvalid = SSEQ; Tn.n = 0; Tn.unit = u; Tn.hist = inp(P, I_SCONV) + (size_t)(l * NSB + sb) * 3 * CONVC; }
                }
#ifndef DIS_D1
#define D1_PROBE(k, BODY) do { const unsigned long long d0_ = (PROBE_PHASE == (k)) ? __builtin_amdgcn_s_memrealtime() : 0ull; BODY; \
        if (PROBE_PHASE == (k)) { const unsigned long long d1_ = __builtin_amdgcn_s_memrealtime(); while (__builtin_amdgcn_s_memrealtime() - d1_ < d1_ - d0_) __builtin_amdgcn_s_sleep(4); } } while (0)
                D1_PROBE(20, if (cur) d1_s3(P));
                D1_PROBE(21, if (nxt) d1_s1(P, Tn, hn, l, rtb ^ 1, xq, xk, beta, eg, egl));
                LDS_BARRIER();
                D1_PROBE(22, if (cur) d1_s4(P, Tc, rtb));
                D1_PROBE(23, if (nxt) d1_s1b(P, Tn, hn, rtb ^ 1, xq, xk, beta, eg, egl));
                LDS_BARRIER();
                { const int u2 = u + P.G; const bool nn = u2 < N_DUNITS; float w3[3] = {0.f, 0.f, 0.f}; f32x4 cv[4] = {f32x4{}, f32x4{}, f32x4{}, f32x4{}};
                  if (nn) d1_wload(P, u2 < NB * NH * 32 ? (u2 >> 5) & 7 : (u2 - NB * NH * 32) & 7, l, w3);
                  if (cvt) cache_slice_load(P, l, kstep, cv);
                  D1_PROBE(24, if (nxt) d1_s2(P, Tn));
                  if (nn) d1_wstore(P, w3);
                  if (cvt) cache_slice_store(P, l, kstep, cv); }
                LDS_BARRIER();
#endif
                Tc = Tn; cur = nxt; rtb ^= 1;
            }
                PROBE_T1(1); }
        SEAM(p + 1);
        if (IN(p + 2)) { asm volatile("; PHASE_MARK P3"); PROBE_T0(); PHASE_FRAME(P);
            const int qx = P.bx & 7;
            unsigned* qh = P.ctl + CW_Q + 1024 + (l * 8 + qx) * 32;
            { LAS float* bt = (LAS float*)(P.lds + AT_BT); const float* misc = (const float*)(P.ws + WS_MISC);
#pragma unroll
              for (int i = 0; i < 4; ++i) bt[P.tid + 512 * i] = misc[64 + P.tid + 512 * i];
              LAS float* pc = (LAS float*)(P.lds + LDSCTL_OFF + 1024);
              if (P.tid == 0) { pc[0] = misc[l]; pc[1] = misc[8 + l]; }
              if (P.tid < 128) { pc[4 + P.tid] = inp(P, I_SUBLN)[l * 128 + P.tid]; pc[132 + P.tid] = inp(P, I_NORMA)[l * 128 + P.tid]; } }
            if (P.wave == 0 && hw_lane() == 0) P.MISC[0] = __hip_atomic_fetch_add(qh, 1u, __ATOMIC_RELAXED, __HIP_MEMORY_SCOPE_AGENT);
            __syncthreads();
            for (;;) {
                const int t = (int)P.MISC[0];
                if (t >= QN_TOTAL) break;
                if (t < QN_SCANP) { asm volatile("; PHASE_MARK SCANP");
#ifndef DIS_SCAN
 { const unsigned long long q0_ = (PROBE_PHASE == 10) ? __builtin_amdgcn_s_memrealtime() : 0ull; scan_task(P, false, 2 * qx + (t >> 3), t & 7, l, qh); if (PROBE_PHASE == 10) { const unsigned long long q1_ = __builtin_amdgcn_s_memrealtime(); while (__builtin_amdgcn_s_memrealtime() - q1_ < q1_ - q0_) __builtin_amdgcn_s_sleep(8); } }
#endif
 }
                else if (t < QN_SCANP + QN_ATTS + QN_ATTP) {
                    asm volatile("; PHASE_MARK ATTN"); AttnTask A; const int t2 = t - QN_SCANP;
                    if (t2 < QN_ATTS) { const int sb = qx, h = t2 & 7;
                        A.Q = (const f16*)(P.ws + WS_QB) + ((ptrdiff_t)(MP + sb * SSEQ) - PAST) * D + h * 128;
                        A.K = (const f16*)(P.ws + WS_KS) + ((size_t)(l * NSB + sb) * KSROWS) * D + h * 128; A.V = (const f16*)(P.ws + WS_VS) + ((size_t)(l * NSB + sb) * KSROWS) * D + h * 128;
                        A.G = (const f16*)(P.ws + WS_GAB) + ((ptrdiff_t)(MP + sb * SSEQ) - PAST) * D + h * 128; A.O = (f16*)(P.ws + WS_MAB) + ((ptrdiff_t)(MP + sb * SSEQ) - PAST) * 2048 + 1024 + h * 128;
                        A.q0 = PAST; A.nqw = 1; A.nkeys = PAST + SSEQ; A.ntiles = 33; A.h = h; A.OK = nullptr; A.OV = nullptr; A.wr0 = 1 << 20; }
                    else { const int t3 = t2 - QN_ATTS, r = t3 & 63, qb = 4 * (3 - (t3 >> 6)) + 3 - (r & 3), bhl = r >> 2, b = 2 * qx + (bhl >> 3), h = bhl & 7;
                        A.Q = (const f16*)(P.ws + WS_QB) + (size_t)b * SEQ * D + h * 128; A.K = (const f16*)(P.ws + WS_KB) + (size_t)b * SEQ * D + h * 128; A.V = (const f16*)(P.ws + WS_VB) + (size_t)b * SEQ * D + h * 128;
                        A.G = (const f16*)(P.ws + WS_GAB) + (size_t)b * SEQ * D + h * 128; A.O = (f16*)(P.ws + WS_MAB) + (size_t)b * SEQ * 2048 + 1024 + h * 128;
                        A.q0 = 128 * qb; A.nqw = 4; A.nkeys = SEQ; A.ntiles = 2 * qb + 2; A.h = h; A.wr0 = 2 * qb;
                        A.OK = P.out + OUT_KP + ((size_t)(l * NB + b) * SEQ) * D + h * 128; A.OV = P.out + OUT_VP + ((size_t)(l * NB + b) * SEQ) * D + h * 128; }

                    if (P.wave < 6) { const int ti = P.wave * 64 + hw_lane(), pi = ti - 96;
                        ((LAS float*)(P.lds + LDSCTL_OFF + 3072))[ti] = ((const LAS float*)(P.lds + AT_BT))[A.h * 256 + (pi < 0 ? 0 : pi > 255 ? 255 : pi)]; }
#ifndef DIS_ATT
 attn_task(P, A, l, qh);
#endif

                } else { const int t2 = t - (QN_SCANP + QN_ATTS + QN_ATTP);
#ifndef DIS_SCAN
 scan_task(P, true, qx, t2 & 7, l, qh);
#endif
 }
            }
        PROBE_T1(2); }
        SEAM(p + 2);
        if (IN(p + 3)) { asm volatile("; PHASE_MARK P4"); PROBE_T0(); PHASE_FRAME(P);
            pg8::Gemm g{(const pg8::bf16_t*)(P.ws + WS_MAB), (const pg8::bf16_t*)(P.ws + WS_WO2) + (size_t)l * D * 2048, MP, D, 2048};
            pg8::StaticOrder S; S.init(MP, D, P.G, P.bx);
            thin_gemm<16>(P, (const f16*)(P.ws + WS_MAB) + (size_t)MP * 2048, 2048, (const f16*)(P.ws + WS_WO2) + (size_t)l * D * 2048, 2048);
            EpiRes E{(f16*)(P.ws + WS_X), (const float*)(P.ws + WS_MOD) + (size_t)l * NBB * 6144 + 2048};

#ifndef DIS_G2
 pg8::gemm_phase<EpiRes, pg8::StaticOrder, true, true>(P.lds, g, S, E, P.tid);
#endif

        PROBE_T1(3); }
        SEAM(p + 3);
        if (IN(p + 4)) { asm volatile("; PHASE_MARK P5"); PROBE_T0(); PHASE_FRAME(P); ln_phase(P, false, false, inp(P, I_LN1G) + l * D, inp(P, I_LN1B) + l * D, (const float*)(P.ws + WS_MOD) + (size_t)l * NBB * 6144, 3072, 4096, (const float*)(P.ws + WS_MOD) + (size_t)l * NBB * 6144 + 2048); PROBE_T1(4); }
        SEAM(p + 4);
        if (IN(p + 5)) { asm volatile("; PHASE_MARK P6"); PROBE_T0(); PHASE_FRAME(P);
            pg8::Gemm g{(const pg8::bf16_t*)(P.ws + WS_H), (const pg8::bf16_t*)(P.ws + WS_WFI) + (size_t)l * 2 * DFF * D, M, 2 * DFF, D};
            pg8::StaticOrder S; S.init(M, 2 * DFF, P.G, P.bx);
            EpiSwiGLU E{(f16*)(P.ws + WS_ACT)};

#ifndef DIS_G3
 pg8::gemm_phase<EpiSwiGLU, pg8::StaticOrder, true, true>(P.lds, g, S, E, P.tid);
#endif

        PROBE_T1(5); }
        SEAM(p + 5);
        if (IN(p + 6)) { asm volatile("; PHASE_MARK P7"); PROBE_T0(); PHASE_FRAME(P);
            pg8::Gemm g{(const pg8::bf16_t*)(P.ws + WS_ACT), (const pg8::bf16_t*)(P.ws + WS_WFO) + (size_t)l * D * DFF, MP, D, DFF};
            pg8::StaticOrder S; S.init(MP, D, P.G, P.bx);
            thin_gemm<22>(P, (const f16*)(P.ws + WS_ACT) + (size_t)MP * DFF, DFF, (const f16*)(P.ws + WS_WFO) + (size_t)l * D * DFF, DFF);
            EpiRes E{(f16*)(P.ws + WS_X), (const float*)(P.ws + WS_MOD) + (size_t)l * NBB * 6144 + 5120};

#ifndef DIS_G2
 pg8::gemm_phase<EpiRes, pg8::StaticOrder, true, true>(P.lds, g, S, E, P.tid);
#endif

        PROBE_T1(6); }
        SEAM(p + 6);
        if (IN(p + 7)) { asm volatile("; PHASE_MARK P8"); PROBE_T0(); PHASE_FRAME(P); ln_phase(P, false, l == DEPTH - 1, inp(P, I_LN2G) + l * D, inp(P, I_LN2B) + l * D, (const float*)(P.ws + WS_MOD) + (size_t)(l == DEPTH - 1 ? l : l + 1) * NBB * 6144, 0, 1024, (const float*)(P.ws + WS_MOD) + (size_t)l * NBB * 6144 + 5120); PROBE_T1(7); }
        SEAM(p + 7);
    }
#undef IN
#undef SEAM
}

extern "C" void kernel_launch(void* const* d_in, const int* in_sizes, int n_in, void* d_out, int out_size, void* d_ws, size_t ws_size, hipStream_t stream) {
    static int grid = 0;
    if (grid == 0) {
        if (n_in != 27 || (size_t)out_size != OUT_END || ws_size < WS_END) { fprintf(stderr, "kernel_launch: unexpected shapes (n_in %d, out %d, ws %zu)\n", n_in, out_size, ws_size); grid = -1; return; }
        int dev = 0, cus = 0, per_cu = 0;
        if (hipGetDevice(&dev) != hipSuccess || hipDeviceGetAttribute(&cus, hipDeviceAttributeMultiprocessorCount, dev) != hipSuccess) { grid = -1; return; }
        if (hipFuncSetAttribute((const void*)mk_fwd, hipFuncAttributeMaxDynamicSharedMemorySize, LDS_BYTES) != hipSuccess) { fprintf(stderr, "kernel_launch: hipFuncSetAttribute failed\n"); grid = -1; return; }
        if (hipOccupancyMaxActiveBlocksPerMultiprocessor(&per_cu, (const void*)mk_fwd, NWAVES * 64, LDS_BYTES) != hipSuccess || per_cu < 1) { fprintf(stderr, "kernel_launch: occupancy query reports %d\n", per_cu); }
        (void)hipGetLastError();
        grid = cus;
    }
    if (grid < 0) return;
    if (hipMemsetAsync((char*)d_ws + WS_CTL, 0, CTL_ZERO_BYTES, stream) != hipSuccess) return;
    Args a{};
    for (int i = 0; i < 27; ++i) a.in[i] = (const float*)d_in[i];
    a.out = (float*)d_out; a.ws = (unsigned char*)d_ws;
#if MK_PER_PHASE
    for (int p = 0; p < N_PHASES; ++p) { a.ph_lo = p; a.ph_hi = p + 1; hipLaunchKernelGGL(mk_fwd, dim3(grid), dim3(NWAVES * 64), LDS_BYTES, stream, a); }
#else
    a.ph_lo = 0; a.ph_hi = N_PHASES;
    hipLaunchKernelGGL(mk_fwd, dim3(grid), dim3(NWAVES * 64), LDS_BYTES, stream, a);
#endif
}
```
